# Optimizing an MI355X kernel written in HIP

```python
import math
import jax, jax.numpy as jnp
from jax import lax
import numpy as np

D_MODEL = 2048
BATCH = 2
SEQ = 4096
DEPTH = 1

HEAD_DIM = 128
A_Q_HEADS = 8
A_KV_HEADS = 2
A_GROUP = A_Q_HEADS // A_KV_HEADS
A_HALF_WINDOW = 128
B_PATTERNS = ((128, 1), (512, 4), (2048, 16))
B_GROUPS = 3
B_HEADS_PER_GROUP = 4
B_HEADS = B_GROUPS * B_HEADS_PER_GROUP
B_HALF_SPAN = 64
N_BUCKETS = 32
MAX_DISTANCE = 1024
N_ATTN_HEADS = A_Q_HEADS + B_HEADS
PEER_HEADS = 8
PEER_NKEYS = 128
PEER_EXPERTS = PEER_NKEYS * PEER_NKEYS
PEER_QDIM = 256
PEER_TOPK = 16
PEER_TOKEN_BLOCK = 128
EPS = 1e-6
A_Q_W = A_Q_HEADS * HEAD_DIM
A_KV_W = A_KV_HEADS * HEAD_DIM
B_W = B_HEADS * HEAD_DIM
B_OUT_W = B_HEADS_PER_GROUP * HEAD_DIM
IN_WIDTH = A_Q_W + 2 * A_KV_W + 3 * B_W + 2 * D_MODEL

kernel_name = "hybrid_gated_swa_dilated_peer"


def rms_norm(x, g):
    xf = x.astype(jnp.float32)
    y = xf * lax.rsqrt(jnp.mean(xf * xf, axis=-1, keepdims=True) + EPS)
    return (y * g.astype(jnp.float32)).astype(x.dtype)


def t5_bucket(rel):
    half = N_BUCKETS // 2
    max_exact = half // 2
    ret = jnp.where(rel > 0, half, 0)
    n = jnp.abs(rel)
    nf = jnp.maximum(n, 1).astype(jnp.float32)
    large = max_exact + (jnp.log(nf / max_exact) / math.log(MAX_DISTANCE / max_exact) * (half - max_exact)).astype(jnp.int32)
    large = jnp.minimum(large, half - 1)
    return ret + jnp.where(n < max_exact, n, large)


def banded_attention(q, k, v, half_w, dist_scale, bias_table, sink, with_lse):
    dt = q.dtype
    n, hk, g, l, hd = q.shape
    blk = half_w
    nb = -(-l // blk)
    pad = nb * blk - l
    q = jnp.pad(q, ((0, 0), (0, 0), (0, 0), (0, pad), (0, 0)))
    kp = jnp.pad(k, ((0, 0), (0, 0), (blk, blk + pad), (0, 0))).reshape(n, hk, nb + 2, blk, hd)
    vp = jnp.pad(v, ((0, 0), (0, 0), (blk, blk + pad), (0, 0))).reshape(n, hk, nb + 2, blk, hd)
    kb = jnp.concatenate([kp[:, :, :-2], kp[:, :, 1:-1], kp[:, :, 2:]], axis=3)
    vb = jnp.concatenate([vp[:, :, :-2], vp[:, :, 1:-1], vp[:, :, 2:]], axis=3)
    qb = q.reshape(n, hk, g, nb, blk, hd)
    s = jnp.einsum('nhgbqd,nhbkd->nhgbqk', qb, kb, preferred_element_type=jnp.float32) * (hd ** -0.5)
    delta = jnp.arange(3 * blk)[None, :] - blk - jnp.arange(blk)[:, None]
    bias = bias_table[t5_bucket(delta * dist_scale)].astype(jnp.float32)
    bias = jnp.transpose(bias, (2, 3, 0, 1))[:, :, None]
    kpos = jnp.arange(nb)[:, None] * blk - blk + jnp.arange(3 * blk)[None, :]
    valid = (jnp.abs(delta) <= half_w)[None] & ((kpos >= 0) & (kpos < l))[:, None, :]
    s = jnp.where(valid, s + bias, -jnp.inf)
    m = jnp.max(s, axis=-1)
    if sink is not None:
        sk = sink.astype(jnp.float32)[None, :, :, None, None]
        m = jnp.maximum(m, sk)
    p = jnp.exp(s - m[..., None])
    denom = jnp.sum(p, axis=-1)
    if sink is not None:
        denom = denom + jnp.exp(sk - m)
    o = jnp.einsum('nhgbqk,nhbkd->nhgbqd', p, vb.astype(jnp.float32)) / denom[..., None]
    o = o.reshape(n, hk, g, nb * blk, hd)[:, :, :, :l].astype(dt)
    if with_lse:
        lse = (m + jnp.log(denom)).reshape(n, hk, g, nb * blk)[..., :l]
        return o, lse
    return o, None


def to_strided(t, d):
    b, s, h, hd = t.shape
    return t.reshape(b, s // d, d, h, hd).transpose(0, 2, 3, 1, 4).reshape(b * d, h, s // d, hd)


def from_strided(t, b, d):
    _, h, l, hd = t.shape
    return t.reshape(b, d, h, l, hd).transpose(0, 3, 1, 2, 4).reshape(b, l * d, h, hd)


def mixer_windowed_gqa(q, k, v, bias_a, sink):
    b, s, _ = q.shape
    qh = q.reshape(b, s, A_KV_HEADS, A_GROUP, HEAD_DIM).transpose(0, 2, 3, 1, 4)
    kh = k.reshape(b, s, A_KV_HEADS, HEAD_DIM).transpose(0, 2, 1, 3)
    vh = v.reshape(b, s, A_KV_HEADS, HEAD_DIM).transpose(0, 2, 1, 3)
    o, _ = banded_attention(qh, kh, vh, A_HALF_WINDOW, 1,
                            bias_a.reshape(N_BUCKETS, A_KV_HEADS, A_GROUP),
                            sink.reshape(A_KV_HEADS, A_GROUP), False)
    return o.transpose(0, 3, 1, 2, 4).reshape(b, s, A_Q_W)


def mixer_dilated(q, k, v, bias_b):
    b, s, _ = q.shape
    gw = B_HEADS_PER_GROUP * HEAD_DIM
    outs, lses = [], []
    for gi in range(B_GROUPS):
        d = B_PATTERNS[gi][1]
        sl = slice(gi * gw, (gi + 1) * gw)
        qg = to_strided(q[..., sl].reshape(b, s, B_HEADS_PER_GROUP, HEAD_DIM), d)[:, :, None]
        kg = to_strided(k[..., sl].reshape(b, s, B_HEADS_PER_GROUP, HEAD_DIM), d)
        vg = to_strided(v[..., sl].reshape(b, s, B_HEADS_PER_GROUP, HEAD_DIM), d)
        tb = bias_b[:, gi * B_HEADS_PER_GROUP:(gi + 1) * B_HEADS_PER_GROUP][:, :, None]
        o, lse = banded_attention(qg, kg, vg, B_HALF_SPAN, d, tb, None, True)
        outs.append(from_strided(o[:, :, 0], b, d).astype(jnp.float32))
        lses.append(lse[:, :, 0].reshape(b, d, B_HEADS_PER_GROUP, s // d).transpose(0, 3, 1, 2).reshape(b, s, B_HEADS_PER_GROUP))
    w = jax.nn.softmax(jnp.stack(lses, axis=0), axis=0)
    o = jnp.sum(w[..., None] * jnp.stack(outs, axis=0), axis=0)
    return o.reshape(b, s, B_OUT_W).astype(q.dtype)


def peer_ffn(h, w_pq, sub_keys, expert_u, expert_v):
    b, s, d = h.shape
    t = h.reshape(b * s, d)
    n_tok = b * s
    q = (t @ w_pq).reshape(n_tok, PEER_HEADS, 2, PEER_QDIM // 2)
    sc = jnp.einsum('thcd,hckd->thck', q, sub_keys, preferred_element_type=jnp.float32)
    top_s, top_i = lax.top_k(sc, PEER_TOPK)
    cand_s = (top_s[:, :, 0, :, None] + top_s[:, :, 1, None, :]).reshape(n_tok, PEER_HEADS, PEER_TOPK * PEER_TOPK)
    cand_i = (top_i[:, :, 0, :, None] * PEER_NKEYS + top_i[:, :, 1, None, :]).reshape(n_tok, PEER_HEADS, PEER_TOPK * PEER_TOPK)
    best_s, best_j = lax.top_k(cand_s, PEER_TOPK)
    expert_idx = jnp.take_along_axis(cand_i, best_j, axis=-1)
    gate = jax.nn.softmax(best_s, axis=-1)
    nblk = n_tok // PEER_TOKEN_BLOCK

    def block_fn(args):
        tb, ib, gb = args
        u = expert_u[ib]
        a = jax.nn.gelu(jnp.einsum('thkd,td->thk', u, tb, preferred_element_type=jnp.float32), approximate=False)
        vv = expert_v[ib]
        return jnp.einsum('thk,thkd->td', (gb * a).astype(vv.dtype), vv)

    out = lax.map(block_fn, (t.reshape(nblk, PEER_TOKEN_BLOCK, d),
                             expert_idx.reshape(nblk, PEER_TOKEN_BLOCK, PEER_HEADS, PEER_TOPK),
                             gate.reshape(nblk, PEER_TOKEN_BLOCK, PEER_HEADS, PEER_TOPK)))
    return out.reshape(b, s, d).astype(h.dtype)


def setup_inputs(seed: int = 0) -> dict:
    key = jax.random.key(seed)
    ks = jax.random.split(key, 16)
    f32 = jnp.float32
    nrm = lambda k, shape, scale: jax.random.normal(k, shape, f32) * scale
    return {
        "x": nrm(ks[0], (BATCH, SEQ, D_MODEL), 1.0),
        "rel_bias": nrm(ks[1], (N_BUCKETS, N_ATTN_HEADS), 0.5),
        "norm_mix_g": 1.0 + nrm(ks[2], (DEPTH, D_MODEL), 0.01),
        "w_in": nrm(ks[3], (DEPTH, D_MODEL, IN_WIDTH), D_MODEL ** -0.5),
        "sink_a": nrm(ks[4], (DEPTH, A_Q_HEADS), 0.5),
        "w_oa": nrm(ks[5], (DEPTH, A_Q_W, D_MODEL), A_Q_W ** -0.5),
        "w_ob": nrm(ks[6], (DEPTH, B_OUT_W, D_MODEL), B_OUT_W ** -0.5),
        "w_out": nrm(ks[7], (DEPTH, D_MODEL, D_MODEL), D_MODEL ** -0.5),
        "norm_ffn_g": 1.0 + nrm(ks[8], (DEPTH, D_MODEL), 0.01),
        "peer_wq": nrm(ks[9], (DEPTH, D_MODEL, PEER_HEADS * PEER_QDIM), D_MODEL ** -0.5),
        "peer_keys": nrm(ks[10], (DEPTH, PEER_HEADS, 2, PEER_NKEYS, PEER_QDIM // 2), (PEER_QDIM // 2) ** -0.5),
        "peer_u": nrm(ks[11], (DEPTH, PEER_EXPERTS, D_MODEL), D_MODEL ** -0.5),
        "peer_v": nrm(ks[12], (DEPTH, PEER_EXPERTS, D_MODEL), PEER_HEADS ** -0.5),
        "norm_final_g": 1.0 + nrm(ks[13], (D_MODEL,), 0.01),
    }


def reference(x, rel_bias, norm_mix_g, w_in, sink_a, w_oa, w_ob, w_out, norm_ffn_g,
              peer_wq, peer_keys, peer_u, peer_v, norm_final_g):
    splits = [A_Q_W, A_KV_W, A_KV_W, B_W, B_W, B_W, D_MODEL, D_MODEL]
    bounds = [int(c) for c in np.cumsum(splits)[:-1]]
    bias_a = rel_bias[:, :A_Q_HEADS]
    bias_b = rel_bias[:, A_Q_HEADS:]
    for layer in range(DEPTH):
        h = rms_norm(x, norm_mix_g[layer])
        proj = jnp.einsum('bsd,de->bse', h, w_in[layer])
        qa, ka, va, qb, kb, vb, ga, gb = jnp.split(proj, bounds, axis=-1)
        ya = mixer_windowed_gqa(qa, ka, va, bias_a, sink_a[layer]) @ w_oa[layer]
        yb = mixer_dilated(qb, kb, vb, bias_b) @ w_ob[layer]
        merged = jax.nn.sigmoid(ga) * ya + jax.nn.sigmoid(gb) * yb
        x = x + merged @ w_out[layer]
        h = rms_norm(x, norm_ffn_g[layer])
        x = x + peer_ffn(h, peer_wq[layer], peer_keys[layer], peer_u[layer], peer_v[layer])
    return rms_norm(x, norm_final_g)
```

```cpp
#include <hip/hip_runtime.h>
#include <cstdio>
#include <cstdint>
namespace pg8 {
#define PG8_LAS __attribute__((address_space(3)))
typedef unsigned short bf16_t;
typedef short bf16x8 __attribute__((ext_vector_type(8)));
typedef float f32x4 __attribute__((ext_vector_type(4)));
typedef unsigned u32x4 __attribute__((ext_vector_type(4)));
typedef int v4i_t __attribute__((ext_vector_type(4)));
typedef int v8i_t __attribute__((ext_vector_type(8)));
constexpr int BM = 256, BK = 64, HALF = 128, HTB = HALF * BK * 2  , STAGE_BYTES = 8 * HTB, NXCD = 8, WGM = 8;

__host__ __device__ __forceinline__ int lds_byte(int r, int c) { const int st = (r >> 4) * 2 + (c >> 5), rr = r & 15, cc = c & 31, ob = rr * 64 + cc * 2; return st * 1024 + (ob ^ (((ob >> 9) & 1) << 5)); }
__host__ __device__ __forceinline__ void stage_rc(int b, int& R, int& C) { const int st = b / 1024, sb = b % 1024, swz = sb ^ (((sb >> 9) & 1) << 5); R = (st >> 1) * 16 + swz / 64; C = (st & 1) * 32 + (swz % 64) / 2; }
__host__ __device__ __forceinline__ int perm32(int rho) { const int n = rho >> 4, i = rho & 15; return 8 * (i >> 2) + 4 * n + (i & 3); }

struct Unit { int pm, pn; };
struct Gemm { const bf16_t* A; const bf16_t* Bt; int M, N, K; };

struct StaticOrder {
    int nM, nN, nwg, G, c;
    __host__ __device__ void init(int M, int N, int G_, int c_) { nM = M / BM; nN = N / BM; nwg = nM * nN; G = G_; c = c_; }
    __host__ __device__ bool next(int i, Unit& u) const {
        const long L = (long)i * G + c; if (L >= nwg) return false;
        int wgid = (int)L; { const int q = nwg / NXCD, r = nwg % NXCD, xcd = wgid % NXCD, off = wgid / NXCD; wgid = (xcd < r ? xcd * (q + 1) : r * (q + 1) + (xcd - r) * q) + off; }
        const int nig = WGM * nN, gid = wgid / nig, fm = gid * WGM, gsz = (nM - fm) < WGM ? (nM - fm) : WGM;
        u.pm = fm + ((wgid % nig) % gsz); u.pn = (wgid % nig) / gsz; return true;
    }
    __device__ __forceinline__ void a_ready(const Unit&) const {}
    __device__ __forceinline__ void done(const Unit&) const {}
};

typedef unsigned u32x2 __attribute__((ext_vector_type(2)));
__device__ __forceinline__ unsigned cvt_pk_bf16(float lo, float hi) { unsigned r; asm volatile("v_cvt_pk_bf16_f32 %0, %1, %2" : "=v"(r) : "v"(lo), "v"(hi)); return r; }
__device__ __forceinline__ float sigm(float v) { return __builtin_amdgcn_rcpf(1.0f + __builtin_amdgcn_exp2f(-1.4426950408889634f * v)); }
__device__ __forceinline__ float bflo(unsigned w) { return __builtin_bit_cast(float, w << 16); }
__device__ __forceinline__ float bfhi(unsigned w) { return __builtin_bit_cast(float, w & 0xffff0000u); }

struct EpiProj {
    static constexpr bool PERM = true, AFTER_DRAIN = false;
    bf16_t* O; int ldc; int gate_pn; float osc;
    __device__ __forceinline__ void operator()(const f32x4 (&acc)[2][2][4][2], const Unit& u, int wr, int wc, int fr_, int fq_) const {
        (void)fr_; (void)fq_; int ln_ = (int)__builtin_amdgcn_mbcnt_hi(~0u, __builtin_amdgcn_mbcnt_lo(~0u, 0u)); asm volatile("" : "+v"(ln_));
        const int fr = ln_ & 15, fq = ln_ >> 4;
        const int row0 = u.pm * BM + wr * 64 + fr, col0 = u.pn * BM + wc * 32 + 8 * fq; const bool gate = u.pn >= gate_pn;
#pragma unroll
        for (int ai = 0; ai < 2; ++ai)
#pragma unroll
            for (int m = 0; m < 4; ++m) { bf16_t* rowp = O + (size_t)(row0 + ai * HALF + m * 16) * ldc + col0;
#pragma unroll
                for (int bj = 0; bj < 2; ++bj) { f32x4 v0 = acc[ai][bj][m][0] * osc, v1 = acc[ai][bj][m][1] * osc;
                    if (gate) {
#pragma unroll
                        for (int j = 0; j < 4; ++j) { v0[j] = sigm(v0[j]); v1[j] = sigm(v1[j]); } }
                    u32x4 w; w.x = cvt_pk_bf16(v0[0], v0[1]); w.y = cvt_pk_bf16(v0[2], v0[3]); w.z = cvt_pk_bf16(v1[0], v1[1]); w.w = cvt_pk_bf16(v1[2], v1[3]);
                    *(u32x4*)(rowp + bj * HALF) = w; } }
    }
};
template <bool ACCUM> struct EpiGate {
    static constexpr bool PERM = true, AFTER_DRAIN = false;
    const bf16_t* G; int ldg; bf16_t* O; int ldc;
    __device__ __forceinline__ void operator()(const f32x4 (&acc)[2][2][4][2], const Unit& u, int wr, int wc, int fr_, int fq_) const {
        (void)fr_; (void)fq_; int ln_ = (int)__builtin_amdgcn_mbcnt_hi(~0u, __builtin_amdgcn_mbcnt_lo(~0u, 0u)); asm volatile("" : "+v"(ln_));
        const int fr = ln_ & 15, fq = ln_ >> 4;
        const int row0 = u.pm * BM + wr * 64 + fr, col0 = u.pn * BM + wc * 32 + 8 * fq;
#pragma unroll
        for (int ai = 0; ai < 2; ++ai)
#pragma unroll
            for (int m = 0; m < 4; ++m) { const int row = row0 + ai * HALF + m * 16; const bf16_t* gp = G + (size_t)row * ldg + col0; bf16_t* op = O + (size_t)row * ldc + col0;
#pragma unroll
                for (int bj = 0; bj < 2; ++bj) { const u32x4 gw = *(const u32x4*)(gp + bj * HALF);
                    f32x4 v0 = acc[ai][bj][m][0], v1 = acc[ai][bj][m][1];
                    v0[0] *= bflo(gw.x); v0[1] *= bfhi(gw.x); v0[2] *= bflo(gw.y); v0[3] *= bfhi(gw.y);
                    v1[0] *= bflo(gw.z); v1[1] *= bfhi(gw.z); v1[2] *= bflo(gw.w); v1[3] *= bfhi(gw.w);
                    if (ACCUM) { const u32x4 mw = *(const u32x4*)(op + bj * HALF);
                        v0[0] += bflo(mw.x); v0[1] += bfhi(mw.x); v0[2] += bflo(mw.y); v0[3] += bfhi(mw.y);
                        v1[0] += bflo(mw.z); v1[1] += bfhi(mw.z); v1[2] += bflo(mw.w); v1[3] += bfhi(mw.w); }
                    u32x4 w; w.x = cvt_pk_bf16(v0[0], v0[1]); w.y = cvt_pk_bf16(v0[2], v0[3]); w.z = cvt_pk_bf16(v1[0], v1[1]); w.w = cvt_pk_bf16(v1[2], v1[3]);
                    *(u32x4*)(op + bj * HALF) = w; } }
    }
};
__device__ __forceinline__ unsigned pk4_fp8e(float a, float b, float c, float d) { int p = __builtin_amdgcn_cvt_pk_fp8_f32(fminf(fmaxf(a, -448.f), 448.f), fminf(fmaxf(b, -448.f), 448.f), 0, false);
    return (unsigned)__builtin_amdgcn_cvt_pk_fp8_f32(fminf(fmaxf(c, -448.f), 448.f), fminf(fmaxf(d, -448.f), 448.f), p, true); }
struct EpiGateF8 {
    static constexpr bool PERM = true, AFTER_DRAIN = false;
    const bf16_t* G; int ldg; const bf16_t* M1; int ldm; unsigned char* O8; int ldc; float oscale;
    __device__ __forceinline__ void operator()(const f32x4 (&acc)[2][2][4][2], const Unit& u, int wr, int wc, int fr_, int fq_) const {
        (void)fr_; (void)fq_; int ln_ = (int)__builtin_amdgcn_mbcnt_hi(~0u, __builtin_amdgcn_mbcnt_lo(~0u, 0u)); asm volatile("" : "+v"(ln_));
        const int fr = ln_ & 15, fq = ln_ >> 4;
        const int row0 = u.pm * BM + wr * 64 + fr, col0 = u.pn * BM + wc * 32 + 8 * fq;
#pragma unroll
        for (int ai = 0; ai < 2; ++ai)
#pragma unroll
            for (int m = 0; m < 4; ++m) { const int row = row0 + ai * HALF + m * 16; const bf16_t* gp = G + (size_t)row * ldg + col0; const bf16_t* mp = M1 + (size_t)row * ldm + col0; unsigned char* op = O8 + (size_t)row * ldc + col0;
#pragma unroll
                for (int bj = 0; bj < 2; ++bj) { const u32x4 gw = *(const u32x4*)(gp + bj * HALF), mw = *(const u32x4*)(mp + bj * HALF);
                    f32x4 v0 = acc[ai][bj][m][0], v1 = acc[ai][bj][m][1];
                    v0[0] = (v0[0] * bflo(gw.x) + bflo(mw.x)) * oscale; v0[1] = (v0[1] * bfhi(gw.x) + bfhi(mw.x)) * oscale; v0[2] = (v0[2] * bflo(gw.y) + bflo(mw.y)) * oscale; v0[3] = (v0[3] * bfhi(gw.y) + bfhi(mw.y)) * oscale;
                    v1[0] = (v1[0] * bflo(gw.z) + bflo(mw.z)) * oscale; v1[1] = (v1[1] * bfhi(gw.z) + bfhi(mw.z)) * oscale; v1[2] = (v1[2] * bflo(gw.w) + bflo(mw.w)) * oscale; v1[3] = (v1[3] * bfhi(gw.w) + bfhi(mw.w)) * oscale;
                    u32x2 w; w.x = pk4_fp8e(v0[0], v0[1], v0[2], v0[3]); w.y = pk4_fp8e(v1[0], v1[1], v1[2], v1[3]);
                    *(u32x2*)(op + bj * HALF) = w; } }
    }
};

struct EpiResid {
    static constexpr bool PERM = false, AFTER_DRAIN = false;
    const float* X; bf16_t* X1b; float* part; int ld; float osc;
    __device__ __forceinline__ void operator()(const f32x4 (&acc)[2][2][4][2], const Unit& u, int wr, int wc, int fr_, int fq_) const {
        (void)fr_; (void)fq_; int ln_ = (int)__builtin_amdgcn_mbcnt_hi(~0u, __builtin_amdgcn_mbcnt_lo(~0u, 0u)); asm volatile("" : "+v"(ln_));
        const int fr = ln_ & 15, fq = ln_ >> 4;
        const int row0 = u.pm * BM + wr * 64 + fr, col0 = u.pn * BM + wc * 32 + 4 * fq;
#pragma unroll
        for (int ai = 0; ai < 2; ++ai)
#pragma unroll
            for (int m = 0; m < 4; ++m) { const int row = row0 + ai * HALF + m * 16; float ss = 0.f;
#pragma unroll
                for (int bj = 0; bj < 2; ++bj)
#pragma unroll
                    for (int n = 0; n < 2; ++n) { const size_t off = (size_t)row * ld + col0 + bj * HALF + n * 16;
                        const f32x4 x = *(const f32x4*)(X + off); const f32x4 v = x + acc[ai][bj][m][n] * osc;
                        u32x2 w; w.x = cvt_pk_bf16(v[0], v[1]); w.y = cvt_pk_bf16(v[2], v[3]); *(u32x2*)(X1b + off) = w;
                        ss += (v[0] * v[0] + v[1] * v[1]) + (v[2] * v[2] + v[3] * v[3]); }
                ss += __shfl_xor(ss, 16); ss += __shfl_xor(ss, 32);
                if (fq == 0) part[(size_t)row * 32 + u.pn * 4 + wc] = ss; }
    }
};
__device__ __forceinline__ int tk_enc(float s) { const int b = __builtin_bit_cast(int, s); return b ^ ((b >> 31) & 0x7fffffff); }
__device__ __forceinline__ float tk_dec(int k) { return __builtin_bit_cast(float, k ^ ((k >> 31) & 0x7fffffff)); }
#define TK_INS16(Lst, X) do { int x_ = (X); _Pragma("unroll") for (int i_ = 0; i_ < 16; ++i_) { const int h_ = Lst[i_] > x_ ? Lst[i_] : x_; x_ = Lst[i_] > x_ ? x_ : Lst[i_]; Lst[i_] = h_; } } while (0)
__device__ __forceinline__ void tk_sort16(int (&v)[16]) {
#pragma unroll
    for (int k = 2; k <= 16; k <<= 1)
#pragma unroll
        for (int j = k >> 1; j > 0; j >>= 1)
#pragma unroll
            for (int i = 0; i < 16; ++i) { const int l = i ^ j; if (l > i) { const int a = v[i], b = v[l]; const int hi = a > b ? a : b, lo = a > b ? b : a; const bool desc = (i & k) == 0; v[i] = desc ? hi : lo; v[l] = desc ? lo : hi; } }
}
__device__ __forceinline__ void tk_merge16(int (&a)[16], const int (&b)[16]) {
#pragma unroll
    for (int i = 0; i < 16; ++i) a[i] = a[i] > b[15 - i] ? a[i] : b[15 - i];
#pragma unroll
    for (int j = 8; j > 0; j >>= 1)
#pragma unroll
        for (int i = 0; i < 16; ++i) { const int l = i ^ j; if (l > i) { const int x = a[i], y = a[l]; a[i] = x > y ? x : y; a[l] = x > y ? y : x; } }
}
#define TK_BAR() do { asm volatile("s_waitcnt lgkmcnt(0)" ::: "memory"); __builtin_amdgcn_s_barrier(); asm volatile("" ::: "memory"); } while (0)
struct EpiTopk {
    static constexpr bool PERM = false, AFTER_DRAIN = true;
    const PG8_LAS float* rs; int* tki; float* tkg; int nheads; float* S; int ld;
    __device__ __forceinline__ void fused(f32x4 (&acc)[2][2][4][2], const Unit& u, int wr, int wc, int fr_, int fq_, PG8_LAS unsigned char* lds, int wid, int lane_) const {
        (void)fr_; (void)fq_; (void)lane_; int lane = (int)__builtin_amdgcn_mbcnt_hi(~0u, __builtin_amdgcn_mbcnt_lo(~0u, 0u)); asm volatile("" : "+v"(lane));
        const int fr = lane & 15, fq = lane >> 4;
        PG8_LAS float* img = (PG8_LAS float*)lds;
        PG8_LAS int* lst = (PG8_LAS int*)lds;
        PG8_LAS int* mrg = (PG8_LAS int*)(lds + 32768);
#pragma unroll
        for (int ai = 0; ai < 2; ++ai)
#pragma unroll
            for (int m = 0; m < 4; ++m) { const int row = ai * HALF + wr * 64 + m * 16 + fr; const float s = rs[row]; float* rowp = S + (size_t)(u.pm * BM + row) * ld + u.pn * BM + wc * 32 + 4 * fq;
#pragma unroll
                for (int bj = 0; bj < 2; ++bj)
#pragma unroll
                    for (int n = 0; n < 2; ++n) *(f32x4*)(rowp + bj * HALF + n * 16) = acc[ai][bj][m][n] * s; }
        asm volatile("s_waitcnt vmcnt(0)" ::: "memory");
        TK_BAR();
#ifndef TK_REP
#define TK_REP 0
#endif
#pragma unroll 1
        for (int ai_ = 0; ai_ < 2 * (1 + TK_REP); ++ai_) { const int ai = ai_ & 1;
            asm volatile("" : "+v"(lane) :: "memory");
            const int tid = wid * 64 + lane;
            { const float* src = S + (size_t)(u.pm * BM + ai * HALF) * ld + u.pn * BM;
#pragma unroll 4
              for (int i = 0; i < 16; ++i) { const int idx = tid + 512 * i, row = idx >> 6, q = idx & 63; *(PG8_LAS f32x4*)(img + row * 256 + ((q ^ (row & 63)) << 2)) = *(const f32x4*)(src + (size_t)row * ld + 4 * q); } }
            TK_BAR();
            const int row = tid & 127, c = (tid >> 7) & 1, kh = tid >> 8;
            int Lk[16];
#pragma unroll 1
            for (int g = 0; g < 4; ++g) {
                int Nk[16];
#pragma unroll
                for (int i = 0; i < 4; ++i) { const int q = 32 * c + 16 * kh + 4 * g + i; const f32x4 v = *(const PG8_LAS f32x4*)(img + row * 256 + ((q ^ (row & 63)) << 2));
#pragma unroll
                    for (int e = 0; e < 4; ++e) Nk[4 * i + e] = (tk_enc(v[e]) & ~127) | (127 - (64 * kh + 16 * g + 4 * i + e)); }
                tk_sort16(Nk);
                if (g == 0) {
#pragma unroll
                    for (int i = 0; i < 16; ++i) Lk[i] = Nk[i]; }
                else tk_merge16(Lk, Nk);
            }
            TK_BAR();
            { PG8_LAS int* d = lst + ((row * 2 + c) * 2 + kh) * 16;
#pragma unroll
              for (int i = 0; i < 4; ++i) *(PG8_LAS v4i_t*)(d + 4 * i) = (v4i_t){Lk[4 * i], Lk[4 * i + 1], Lk[4 * i + 2], Lk[4 * i + 3]}; }
            TK_BAR();
            if (kh == 0) {
                const PG8_LAS int* o = lst + ((row * 2 + c) * 2 + 1) * 16; int Ok[16];
#pragma unroll
                for (int i = 0; i < 4; ++i) { const v4i_t w = *(const PG8_LAS v4i_t*)(o + 4 * i); Ok[4 * i] = w[0]; Ok[4 * i + 1] = w[1]; Ok[4 * i + 2] = w[2]; Ok[4 * i + 3] = w[3]; }
                tk_merge16(Lk, Ok);
                PG8_LAS int* d = mrg + (row * 2 + c) * 16;
#pragma unroll
                for (int i = 0; i < 4; ++i) *(PG8_LAS v4i_t*)(d + 4 * i) = (v4i_t){Lk[4 * i], Lk[4 * i + 1], Lk[4 * i + 2], Lk[4 * i + 3]};
            }
            TK_BAR();
            if (tid < 128) {
                const PG8_LAS int* A = mrg + (tid * 2 + 0) * 16; const PG8_LAS int* B = mrg + (tid * 2 + 1) * 16;
                float s0[16], s1[16];
#pragma unroll
                for (int i = 0; i < 4; ++i) { const v4i_t a = *(const PG8_LAS v4i_t*)(A + 4 * i), b = *(const PG8_LAS v4i_t*)(B + 4 * i);
#pragma unroll
                    for (int e = 0; e < 4; ++e) { s0[4 * i + e] = tk_dec(a[e] & ~127); s1[4 * i + e] = tk_dec(b[e] & ~127); } }
                int Mk[16], Ck[16];
                int cnt = 0;
#pragma unroll
                for (int i = 0; i < 16; ++i)
#pragma unroll
                    for (int j = 0; j < 16; ++j) if ((i + 1) * (j + 1) <= 16) {
                        Ck[cnt & 15] = (tk_enc(s0[i] + s1[j]) & ~255) | (i << 4) | j; ++cnt;
                        if ((cnt & 15) == 0 || cnt == 50) {
                            if (cnt == 50) {
#pragma unroll
                                for (int z = 2; z < 16; ++z) Ck[z] = (int)0x80000000; }
                            tk_sort16(Ck);
                            if (cnt == 16) {
#pragma unroll
                                for (int z = 0; z < 16; ++z) Mk[z] = Ck[z]; }
                            else tk_merge16(Mk, Ck);
                        } }
                const float smax = tk_dec(Mk[0] & ~255); float ev[16], den = 0.f;
#pragma unroll
                for (int q = 0; q < 16; ++q) { ev[q] = __expf(tk_dec(Mk[q] & ~255) - smax); den += ev[q]; }
                const float inv = 1.f / den; const size_t ob = ((size_t)(u.pm * BM + ai * HALF + tid) * nheads + u.pn) * 16;
#pragma unroll
                for (int q4 = 0; q4 < 4; ++q4) { v4i_t ei; f32x4 gv;
#pragma unroll
                    for (int e = 0; e < 4; ++e) { const int k = Mk[4 * q4 + e]; ei[e] = (127 - (A[(k >> 4) & 15] & 127)) * 128 + (127 - (B[k & 15] & 127)); gv[e] = ev[4 * q4 + e] * inv; }
                    *(v4i_t*)(tki + ob + 4 * q4) = ei; *(f32x4*)(tkg + ob + 4 * q4) = gv; }
            }
            TK_BAR();
        }
    }
};

template <class Epi, class Sched, bool ALIGN_EPI = false, bool SP2 = false, bool F8 = false>
__device__ __forceinline__ void gemm_phase(PG8_LAS unsigned char* lds, const Gemm g, const Sched& S, const Epi& E) {
    int tid_ = threadIdx.x; asm volatile("" : "+v"(tid_));
    const int tid = tid_, wid = __builtin_amdgcn_readfirstlane(tid >> 6), lane = tid & 63, wr = wid >> 2, wc = wid & 3, fr = lane & 15, fq = lane >> 4;
    const int K = g.K, nt = K / BK;
    unsigned voffA[2], voffB[2];
#pragma unroll
    for (int i = 0; i < 2; ++i) { int R, C; stage_rc(tid * 16 + i * 8192, R, C); const int Rb = Epi::PERM ? ((R & ~31) + perm32(R & 31)) : R;
        voffA[i] = (unsigned)(R * K + C) * 2u; voffB[i] = (unsigned)(Rb * K + C) * 2u; }
    const size_t kstep = (size_t)(BK * 2);
    const size_t hstep = (size_t)HALF * K * 2;
    const size_t tstep = 2 * hstep;
    const unsigned ldsw = (unsigned)__builtin_amdgcn_readfirstlane((int)((unsigned)(__SIZE_TYPE__)lds + (unsigned)wid * 1024u));
    const int aoff = lds_byte(wr * 64 + fr, fq * 8), boff = lds_byte(wc * 32 + fr, fq * 8);
#define PG8_SA(b, h) (((b) * 2 + (h)) * HTB)
#define PG8_SB(b, h) ((4 + (b) * 2 + (h)) * HTB)
#define PG8_STAGE(bufoff, gbase, voff) do { _Pragma("unroll") for (int _i = 0; _i < 2; ++_i) \
        __builtin_amdgcn_global_load_lds((const unsigned*)((const char*)(gbase) + (voff)[_i]), (PG8_LAS unsigned*)(__SIZE_TYPE__)(ldsw + (unsigned)((bufoff) + _i * 8192)), 16, 0, 0); } while (0)
    PG8_LAS unsigned char* ldsA = lds + aoff; PG8_LAS unsigned char* ldsB = lds + 4 * HTB + boff; asm volatile("" : "+v"(ldsA), "+v"(ldsB));
#define PG8_LD8(p) __builtin_shufflevector(*(const PG8_LAS v4i_t*)(p), *(const PG8_LAS v4i_t*)((p) + 1024), 0, 1, 2, 3, 4, 5, 6, 7)
#define PG8_LDA(dst, b, h) do { _Pragma("unroll") for (int m = 0; m < 4; ++m) dst[m] = PG8_LD8(ldsA + ((b) * 2 + (h)) * HTB + m * 2048); } while (0)
#define PG8_LDB(dst, b, h) do { _Pragma("unroll") for (int n = 0; n < 2; ++n) dst[n] = PG8_LD8(ldsB + ((b) * 2 + (h)) * HTB + n * 2048); } while (0)
#define PG8_H(X, k) __builtin_bit_cast(bf16x8, __builtin_shufflevector(X, X, 4 * (k), 4 * (k) + 1, 4 * (k) + 2, 4 * (k) + 3))
#define PG8_MMA(ai, bj, At, Bt) do { __builtin_amdgcn_s_setprio(1); _Pragma("unroll") for (int m = 0; m < 4; ++m) _Pragma("unroll") for (int n = 0; n < 2; ++n) { \
        if constexpr (F8) asm volatile("v_mfma_scale_f32_16x16x128_f8f6f4 %0, %1, %2, %0, %3, %3 op_sel_hi:[0,0,0]" : "+v"(acc[ai][bj][m][n]) : "v"(Bt[n]), "v"(At[m]), "v"(mxs));   \
        else { acc[ai][bj][m][n] = __builtin_amdgcn_mfma_f32_16x16x32_bf16(PG8_H(Bt[n], 0), PG8_H(At[m], 0), acc[ai][bj][m][n], 0, 0, 0); \
               acc[ai][bj][m][n] = __builtin_amdgcn_mfma_f32_16x16x32_bf16(PG8_H(Bt[n], 1), PG8_H(At[m], 1), acc[ai][bj][m][n], 0, 0, 0); } } __builtin_amdgcn_s_setprio(0); } while (0)
#define PG8_WAIT_V(n) asm volatile("s_waitcnt vmcnt(" #n ")" ::: "memory")
#define PG8_WAIT_L(n) asm volatile("s_waitcnt lgkmcnt(" #n ")" ::: "memory")
#define PG8_BAR __builtin_amdgcn_s_barrier()
#define PG8_SCHED __builtin_amdgcn_sched_barrier(0)
    Unit cur, nxt; int ui = 0;
    if (!S.next(0, cur)) return;
    f32x4 acc[2][2][4][2];
#pragma unroll
    for (int a = 0; a < 2; ++a)
#pragma unroll
        for (int b = 0; b < 2; ++b)
#pragma unroll
            for (int m = 0; m < 4; ++m)
#pragma unroll
                for (int n = 0; n < 2; ++n) acc[a][b][m][n] = (f32x4){0.f, 0.f, 0.f, 0.f};
    int mxs = 0x7f7f7f7f; asm volatile("" : "+v"(mxs));
    v8i_t At[4], B0[2], B1[2];
    const char* cA = (const char*)g.A + (size_t)cur.pm * tstep; const char* cB = (const char*)g.Bt + (size_t)cur.pn * tstep;
    S.a_ready(cur);
    if constexpr (SP2) {
        PG8_STAGE(PG8_SB(0, 0), cB, voffB); PG8_STAGE(PG8_SB(0, 1), cB + hstep, voffB); PG8_STAGE(PG8_SA(0, 0), cA, voffA); PG8_STAGE(PG8_SA(0, 1), cA + hstep, voffA);
        if (wr == 1) PG8_BAR;
        PG8_WAIT_V(2); PG8_BAR;
        PG8_STAGE(PG8_SB(1, 0), cB + kstep, voffB); PG8_STAGE(PG8_SA(1, 0), cA + kstep, voffA); PG8_STAGE(PG8_SB(1, 1), cB + hstep + kstep, voffB);
        PG8_WAIT_V(6); PG8_BAR;
    } else {
        PG8_STAGE(PG8_SB(0, 0), cB, voffB); PG8_STAGE(PG8_SA(0, 0), cA, voffA); PG8_STAGE(PG8_SB(0, 1), cB + hstep, voffB); PG8_STAGE(PG8_SA(0, 1), cA + hstep, voffA);
        if (wr == 1) PG8_BAR;
        PG8_WAIT_V(4); PG8_BAR;
        PG8_STAGE(PG8_SB(1, 0), cB + kstep, voffB); PG8_STAGE(PG8_SA(1, 0), cA + kstep, voffA); PG8_STAGE(PG8_SB(1, 1), cB + hstep + kstep, voffB);
        PG8_WAIT_V(6); PG8_BAR;
    }
    for (;;) {
        const bool has_next = S.next(ui + 1, nxt);
        const char* nA = has_next ? (const char*)g.A + (size_t)nxt.pm * tstep : cA; const char* nB = has_next ? (const char*)g.Bt + (size_t)nxt.pn * tstep : cB;
        for (int t = 0; t < nt; t += 2) {
            const bool last = (t == nt - 2);
            const char* a1 = cA + (size_t)(t + 1) * kstep;
            const char* a2 = last ? nA : cA + (size_t)(t + 2) * kstep; const char* b2 = last ? nB : cB + (size_t)(t + 2) * kstep;
            const char* a3 = a2 + kstep; const char* b3 = b2 + kstep;
            if (last && has_next) S.a_ready(nxt);
            if constexpr (SP2) {
            PG8_LDB(B0, 0, 0); PG8_LDB(B1, 0, 1); PG8_SCHED; PG8_LDA(At, 0, 0); PG8_STAGE(PG8_SA(1, 1), a1 + hstep, voffA);
            PG8_WAIT_V(8); PG8_WAIT_L(0); PG8_BAR; PG8_MMA(0, 0, At, B0); PG8_MMA(0, 1, At, B1); PG8_BAR; PG8_SCHED;
            PG8_LDA(At, 0, 1); PG8_STAGE(PG8_SB(0, 0), b2, voffB); PG8_STAGE(PG8_SB(0, 1), b2 + hstep, voffB); PG8_STAGE(PG8_SA(0, 0), a2, voffA);
            PG8_WAIT_V(8); PG8_WAIT_L(0); PG8_BAR; PG8_MMA(1, 0, At, B0); PG8_MMA(1, 1, At, B1); PG8_BAR; PG8_SCHED;
            PG8_LDB(B0, 1, 0); PG8_LDB(B1, 1, 1); PG8_SCHED; PG8_LDA(At, 1, 0); PG8_STAGE(PG8_SA(0, 1), a2 + hstep, voffA);
            PG8_WAIT_V(8); PG8_WAIT_L(0); PG8_BAR; PG8_MMA(0, 0, At, B0); PG8_MMA(0, 1, At, B1); PG8_BAR; PG8_SCHED;
            PG8_LDA(At, 1, 1); PG8_STAGE(PG8_SB(1, 0), b3, voffB); PG8_STAGE(PG8_SB(1, 1), b3 + hstep, voffB); PG8_STAGE(PG8_SA(1, 0), a3, voffA);
            PG8_WAIT_V(8); PG8_WAIT_L(0); PG8_BAR; PG8_MMA(1, 0, At, B0); PG8_MMA(1, 1, At, B1); PG8_BAR; PG8_SCHED;
            } else {
            PG8_LDB(B0, 0, 0); PG8_SCHED; PG8_LDA(At, 0, 0); PG8_STAGE(PG8_SA(1, 1), a1 + hstep, voffA);
            PG8_WAIT_L(8); PG8_BAR; PG8_WAIT_L(0); PG8_MMA(0, 0, At, B0); PG8_BAR; PG8_SCHED;
            PG8_LDB(B1, 0, 1); PG8_STAGE(PG8_SB(0, 0), b2, voffB);
            PG8_BAR; PG8_WAIT_L(0); PG8_MMA(0, 1, At, B1); PG8_BAR;
            PG8_LDA(At, 0, 1); PG8_STAGE(PG8_SA(0, 0), a2, voffA);
            PG8_BAR; PG8_WAIT_L(0); PG8_MMA(1, 0, At, B0); PG8_BAR; PG8_SCHED;
            PG8_STAGE(PG8_SB(0, 1), b2 + hstep, voffB);
            PG8_WAIT_V(6); PG8_BAR; PG8_MMA(1, 1, At, B1); PG8_BAR;
            PG8_LDB(B0, 1, 0); PG8_SCHED; PG8_LDA(At, 1, 0); PG8_STAGE(PG8_SA(0, 1), a2 + hstep, voffA);
            PG8_WAIT_L(8); PG8_BAR; PG8_WAIT_L(0); PG8_MMA(0, 0, At, B0); PG8_BAR; PG8_SCHED;
            PG8_LDB(B1, 1, 1); PG8_STAGE(PG8_SB(1, 0), b3, voffB);
            PG8_BAR; PG8_WAIT_L(0); PG8_MMA(0, 1, At, B1); PG8_BAR;
            PG8_LDA(At, 1, 1); PG8_STAGE(PG8_SA(1, 0), a3, voffA);
            PG8_BAR; PG8_WAIT_L(0); PG8_MMA(1, 0, At, B0); PG8_BAR; PG8_SCHED;
            PG8_STAGE(PG8_SB(1, 1), b3 + hstep, voffB);
            PG8_WAIT_V(6); PG8_BAR; PG8_MMA(1, 1, At, B1); PG8_BAR;
            }
        }
        if constexpr (F8) asm volatile("s_nop 15\n\ts_nop 7" ::: "memory");
        if constexpr (ALIGN_EPI) { if (wr == 0) PG8_BAR; }
        if constexpr (!Epi::AFTER_DRAIN) { E(acc, cur, wr, wc, fr, fq); S.done(cur); }
        if (!has_next) break;
#pragma unroll
        for (int a = 0; a < 2; ++a)
#pragma unroll
            for (int b = 0; b < 2; ++b)
#pragma unroll
                for (int m = 0; m < 4; ++m)
#pragma unroll
                    for (int n = 0; n < 2; ++n) acc[a][b][m][n] = (f32x4){0.f, 0.f, 0.f, 0.f};
        cur = nxt; cA = nA; cB = nB; ++ui;
        if constexpr (ALIGN_EPI) { if (wr == 1) PG8_BAR; }
    }
    PG8_WAIT_V(0);
    if constexpr (!ALIGN_EPI) { if (wr == 0) PG8_BAR; }
    PG8_BAR;
    if constexpr (Epi::AFTER_DRAIN) { E.fused(acc, cur, wr, wc, fr, fq, lds, wid, lane); S.done(cur); }
#undef PG8_SA
#undef PG8_SB
#undef PG8_STAGE
#undef PG8_LDA
#undef PG8_LDB
#undef PG8_MMA
#undef PG8_H
#undef PG8_LD8
#undef PG8_WAIT_V
#undef PG8_WAIT_L
#undef PG8_BAR
#undef PG8_SCHED
}
}
#define GAS __attribute__((address_space(1)))
#define LAS __attribute__((address_space(3)))
#define XB_TMO      128
#define XB_XCNT(j)  (256  + 64 * (j))
#define XB_XSUB(j)  (1280 + 64 * (j))
#define XB_XGEN(j)  (2304 + 64 * (j))
#define XB_TOP      3328
#define XB_TOPGEN   3392
#define XCD_BAR_WORDS 3456
#define XB_SPIN_CAP (1u << 18)

__device__ __forceinline__ unsigned xb_ld(unsigned* p)              { return __hip_atomic_load(p, __ATOMIC_RELAXED, __HIP_MEMORY_SCOPE_AGENT); }
__device__ __forceinline__ unsigned xb_add(unsigned* p, unsigned v) { return __hip_atomic_fetch_add(p, v, __ATOMIC_RELAXED, __HIP_MEMORY_SCOPE_AGENT); }
__device__ __forceinline__ unsigned xb_xcc_id() { return (unsigned)__builtin_amdgcn_s_getreg((3 << 11) | 20) & 0xFu; }
#define XB_SPIN(cond, bar) do { unsigned _sp = 0; while (cond) { __builtin_amdgcn_s_sleep(1); \
    if ((++_sp & 255u) == 0u) { if (xb_ld(&(bar)[XB_TMO])) break; if (_sp > XB_SPIN_CAP) { atomicAdd(&(bar)[XB_TMO], 1u); break; } } } } while (0)

struct XcdBarrier {
    unsigned* bar; unsigned x;
    volatile LAS unsigned* st;
};

__device__ __forceinline__ XcdBarrier xcd_barrier_post(unsigned* bar, volatile LAS unsigned* st) {
    XcdBarrier b; b.bar = bar; b.x = xb_xcc_id(); b.st = st;
    if (threadIdx.x == 0) (void)xb_add(&bar[XB_XCNT(b.x)], 1u);
    return b;
}
__device__ __forceinline__ void xcd_barrier_complete(unsigned* bar, unsigned x, unsigned& nloc, unsigned& nx) {
    const unsigned G = gridDim.x * gridDim.y * gridDim.z;
    unsigned sum, cnt, mine, sp = 0u;
    for (;;) {
        sum = 0u; cnt = 0u; mine = 0u;
#pragma unroll
        for (unsigned j = 0; j < 16; ++j) { const unsigned c = xb_ld(&bar[XB_XCNT(j)]); sum += c; cnt += (c > 0u) ? 1u : 0u; mine = (j == x) ? c : mine; }
        if (sum == G) break;
        __builtin_amdgcn_s_sleep(1);
        if ((++sp & 255u) == 0u) { if (xb_ld(&bar[XB_TMO])) break; if (sp > XB_SPIN_CAP) { atomicAdd(&bar[XB_TMO], 1u); break; } }
    }
    nloc = mine > 0u ? mine : 1u; nx = cnt > 0u ? cnt : 1u;
}

__device__ __forceinline__ void xcd_barrier(const XcdBarrier& b) {
    asm volatile("s_waitcnt vmcnt(0)" ::: "memory");
    __syncthreads();
    if (threadIdx.x == 0) {
        unsigned* bar = b.bar;
        __builtin_amdgcn_s_waitcnt(0);
        unsigned nloc = b.st[0], nx = b.st[1];
        if (nloc == 0u) { xcd_barrier_complete(bar, b.x, nloc, nx); b.st[0] = nloc; b.st[1] = nx; }
        const unsigned old = xb_add(&bar[XB_XSUB(b.x)], 1u);
        const unsigned gen = old / nloc;
        if (old + 1u == (gen + 1u) * nloc) {
            __builtin_amdgcn_fence(__ATOMIC_RELEASE, "agent");
            asm volatile("s_waitcnt vmcnt(0)" ::: "memory");
            const unsigned og = xb_add(&bar[XB_TOP], 1u);
            const unsigned tg = og / nx;
            if (og + 1u == (tg + 1u) * nx) xb_add(&bar[XB_TOPGEN], 1u);
            else XB_SPIN(xb_ld(&bar[XB_TOPGEN]) == tg, bar);
            __builtin_amdgcn_fence(__ATOMIC_ACQUIRE, "agent");
            xb_add(&bar[XB_XGEN(b.x)], 1u);
            asm volatile("s_waitcnt vmcnt(0)" ::: "memory");
        } else {
            XB_SPIN(xb_ld(&bar[XB_XGEN(b.x)]) == gen, bar);
            __builtin_amdgcn_fence(__ATOMIC_ACQUIRE, "agent");
            asm volatile("s_waitcnt vmcnt(0)" ::: "memory");
        }
    }
    __syncthreads();
}

#ifndef MK_SPLIT
#define MK_SPLIT 0
#endif
#ifndef P8_NP
#define P8_NP 4
#endif
constexpr int NWAVES = 8;
constexpr int NB = 2, SEQ = 4096, DM = 2048, T = NB * SEQ, HD = 128;
constexpr int INW = 10240;
constexpr int C_QA = 0, C_KA = 1024, C_VA = 1280, C_QB = 1536, C_KB = 3072, C_VB = 4608, C_GA = 6144, C_GB = 8192;
constexpr int AQW = 1024, BOW = 512;
constexpr int NEXP = 16384, PHEADS = 8, NKEYS = 128, TOPK = 16;
constexpr int NBIAS = 20;
constexpr float EPS = 1e-6f;
constexpr float SM_SCALE = 0.088388347648318440f;
constexpr float LOG2E = 1.4426950408889634f;
constexpr float M_SCALE = 64.f;
constexpr float W_SCALE = 512.f;

constexpr size_t MiB = 1u << 20;
constexpr size_t WS_CTL = 0, CTL_ZERO_BYTES = 16384;
constexpr size_t WS_WIN = 1 * MiB;
constexpr size_t WS_WOA = 41 * MiB;
constexpr size_t WS_WOB = 45 * MiB;
constexpr size_t WS_WOUT = 47 * MiB;
constexpr size_t WS_W2 = 55 * MiB;
constexpr size_t WS_U = 63 * MiB;
constexpr size_t WS_V = 95 * MiB;
constexpr size_t WS_ESC = 127 * MiB;
constexpr size_t WS_PROJ = 191 * MiB;
constexpr size_t WS_SC = WS_PROJ;
constexpr size_t WS_H = 351 * MiB;
constexpr size_t WS_MRG = WS_H;
constexpr size_t WS_ATTA = 383 * MiB;
constexpr size_t WS_OB = 399 * MiB;
constexpr size_t WS_X1B = WS_ATTA;
constexpr size_t WS_ATTB = 423 * MiB;
constexpr size_t WS_LSE = 431 * MiB;
constexpr size_t WS_PART = 432 * MiB;
constexpr size_t WS_TKI = 433 * MiB;
constexpr size_t WS_TKG = 437 * MiB;
constexpr size_t WS_MRG8 = 441 * MiB;
constexpr size_t WS_END = 457 * MiB;
constexpr int CW_BAR = 0;

constexpr int RING_OFF = 0, RING_BYTES = 131072;
constexpr int LDSCTL_OFF = RING_BYTES, MISC_OFF = LDSCTL_OFF + 320;
constexpr int RSTD_OFF = RING_BYTES + 1024;
constexpr int LDS_BYTES = 147456;
static_assert(RSTD_OFF + 1024 <= LDS_BYTES && XCD_BAR_WORDS * 4 <= (int)CTL_ZERO_BYTES, "maps");

typedef unsigned short bf16;
typedef unsigned v4u __attribute__((ext_vector_type(4)));
typedef unsigned v2u __attribute__((ext_vector_type(2)));
typedef float f32x4 __attribute__((ext_vector_type(4)));
typedef float f32x16 __attribute__((ext_vector_type(16)));
typedef short bf16x8 __attribute__((ext_vector_type(8)));
typedef short s16x4 __attribute__((ext_vector_type(4)));
typedef __bf16 bf16x2 __attribute__((ext_vector_type(2)));
#define LDS_WAIT() asm volatile("s_waitcnt lgkmcnt(0)" ::: "memory")
#define VM_WAIT() asm volatile("s_waitcnt vmcnt(0)" ::: "memory")
#define SBAR() __builtin_amdgcn_sched_barrier(0)
__device__ __forceinline__ unsigned cvtpk(float lo, float hi) { unsigned r; asm volatile("v_cvt_pk_bf16_f32 %0, %1, %2" : "=v"(r) : "v"(lo), "v"(hi)); return r; }
__device__ __forceinline__ float bflo(unsigned w) { return __builtin_bit_cast(float, w << 16); }
__device__ __forceinline__ float bfhi(unsigned w) { return __builtin_bit_cast(float, w & 0xffff0000u); }
__device__ __forceinline__ float dot2_bf16(unsigned w, unsigned x, float acc) { return __builtin_amdgcn_fdot2_f32_bf16(__builtin_bit_cast(bf16x2, w), __builtin_bit_cast(bf16x2, x), acc, false); }
__device__ __forceinline__ float wave_sum(float v) {
#pragma unroll
    for (int o = 1; o < 64; o <<= 1) v += __shfl_xor(v, o);
    return v;
}

struct Lane { int tid, lane, wave, gw; };
__device__ __forceinline__ Lane lane_state() { int t = threadIdx.x; asm volatile("" : "+v"(t)); Lane L; L.tid = t; L.lane = t & 63; L.wave = __builtin_amdgcn_readfirstlane(t >> 6); L.gw = blockIdx.x * 8 + L.wave; return L; }
struct Frame {
    LAS unsigned char* lds; char* ldsg;
    int G, NGW;
    const float *x, *rel_bias, *g_mix, *w_in, *sink_a, *w_oa, *w_ob, *w_out, *g_ffn, *w_pq, *keys, *eu, *ev, *g_fin;
    float* out; unsigned char* ws;
};

__device__ __forceinline__ unsigned pk4_fp8(float a, float b, float c, float d) { int p = __builtin_amdgcn_cvt_pk_fp8_f32(fminf(fmaxf(a, -448.f), 448.f), fminf(fmaxf(b, -448.f), 448.f), 0, false);
    return (unsigned)__builtin_amdgcn_cvt_pk_fp8_f32(fminf(fmaxf(c, -448.f), 448.f), fminf(fmaxf(d, -448.f), 448.f), p, true); }
__device__ __forceinline__ void p0_transpose_item_f8(const float* W, int K, int N, unsigned char* WT, float scale, LAS float* scr, int item, int lane) {
    const int nblk = N / 32, kb = item / nblk, nb = item % nblk, k0 = 64 * kb, n0 = 32 * nb;
    { f32x4 v[8];
#pragma unroll
      for (int i = 0; i < 8; ++i) v[i] = *(const f32x4*)(W + (size_t)(k0 + 8 * i + (lane >> 3)) * N + n0 + 4 * (lane & 7));
#pragma unroll
      for (int i = 0; i < 8; ++i) { LAS float* d = scr + (8 * i + (lane >> 3)) * 33 + 4 * (lane & 7); d[0] = v[i][0] * scale; d[1] = v[i][1] * scale; d[2] = v[i][2] * scale; d[3] = v[i][3] * scale; } }
    LDS_WAIT(); asm volatile("" ::: "memory");
    const int c = lane & 7;
#pragma unroll
    for (int j = 0; j < 4; ++j) { const int n = (lane >> 3) + 8 * j; const LAS float* s = scr + (8 * c) * 33 + n;
        v2u o; o.x = pk4_fp8(s[0 * 33], s[1 * 33], s[2 * 33], s[3 * 33]); o.y = pk4_fp8(s[4 * 33], s[5 * 33], s[6 * 33], s[7 * 33]);
        *(v2u*)(WT + (size_t)(n0 + n) * K + k0 + 8 * c) = o; }
    LDS_WAIT(); asm volatile("" ::: "memory");
}
__device__ __forceinline__ void p0_transpose_item(const float* W, int K, int N, bf16* WT, LAS float* scr, int item, int lane) {
    const int nblk = N / 32, kb = item / nblk, nb = item % nblk, k0 = 64 * kb, n0 = 32 * nb;
    { f32x4 v[8];
#pragma unroll
      for (int i = 0; i < 8; ++i) v[i] = *(const f32x4*)(W + (size_t)(k0 + 8 * i + (lane >> 3)) * N + n0 + 4 * (lane & 7));
#pragma unroll
      for (int i = 0; i < 8; ++i) { LAS float* d = scr + (8 * i + (lane >> 3)) * 33 + 4 * (lane & 7); d[0] = v[i][0]; d[1] = v[i][1]; d[2] = v[i][2]; d[3] = v[i][3]; } }
    LDS_WAIT(); asm volatile("" ::: "memory");
    const int c = lane & 7;
#pragma unroll
    for (int j = 0; j < 4; ++j) { const int n = (lane >> 3) + 8 * j; const LAS float* s = scr + (8 * c) * 33 + n;
        v4u o; o.x = cvtpk(s[0 * 33], s[1 * 33]); o.y = cvtpk(s[2 * 33], s[3 * 33]); o.z = cvtpk(s[4 * 33], s[5 * 33]); o.w = cvtpk(s[6 * 33], s[7 * 33]);
        *(v4u*)(WT + (size_t)(n0 + n) * K + k0 + 8 * c) = o; }
    LDS_WAIT(); asm volatile("" ::: "memory");
}
__device__ __forceinline__ void p0_w2_item(Frame& F, bf16* W2T, int item, int tid) {
    const int hc = item >> 5, j0 = (item & 31) * 64;
    LAS float* Ks = (LAS float*)F.lds; LAS float* Ws = Ks + 128 * 129;
    const f32x4* kp = (const f32x4*)(F.keys + (size_t)hc * 16384);
#pragma unroll
    for (int q = 0; q < 8; ++q) { const int idx = tid + 512 * q, row = idx >> 5, c4 = idx & 31; const f32x4 v = kp[idx];
        LAS float* d = Ks + row * 129 + c4 * 4; d[0] = v[0]; d[1] = v[1]; d[2] = v[2]; d[3] = v[3]; }
#pragma unroll
    for (int q = 0; q < 4; ++q) { const int idx = tid + 512 * q, row = idx >> 5, c4 = idx & 31; const f32x4 v = *(const f32x4*)(F.w_pq + (size_t)(j0 + row) * DM + hc * 128 + c4 * 4);
        LAS float* d = Ws + row * 129 + c4 * 4; d[0] = v[0]; d[1] = v[1]; d[2] = v[2]; d[3] = v[3]; }
    __syncthreads();
    { const int wv = tid >> 6, ln = tid & 63, kt = wv & 3, jt = wv >> 2, r = ln & 31, h2 = ln >> 5;
      const LAS float* ap = Ks + (kt * 32 + r) * 129 + h2; const LAS float* bp = Ws + (jt * 32 + r) * 129 + h2;
      f32x16 acc = {};
#pragma unroll 8
      for (int d0 = 0; d0 < 128; d0 += 2) acc = __builtin_amdgcn_mfma_f32_32x32x2f32(ap[d0], bp[d0], acc, 0, 0, 0);
      const int j = j0 + jt * 32 + r; const float g = F.g_ffn[j];
#pragma unroll
      for (int q = 0; q < 16; ++q) { const int k = kt * 32 + (q & 3) + 8 * (q >> 2) + 4 * h2; const float v = acc[q] * g;
          W2T[(size_t)(hc * 128 + k) * DM + j] = (bf16)(cvtpk(v, v) & 0xffffu); } }
    __syncthreads();
}
__device__ __forceinline__ void p0_prologue(Frame& F) {
    const Lane Ls = lane_state();
    LAS float* scr = (LAS float*)(F.lds + RING_OFF + Ls.wave * 16384);
    bf16* WinT = (bf16*)(F.ws + WS_WIN); bf16* WoaT = (bf16*)(F.ws + WS_WOA); bf16* WobT = (bf16*)(F.ws + WS_WOB); bf16* WoutT = (bf16*)(F.ws + WS_WOUT);
    constexpr int I_IN = (DM / 64) * (INW / 32), I_OA = (AQW / 64) * (DM / 32), I_OB = (BOW / 64) * (DM / 32), I_OUT = (DM / 64) * (DM / 32);
    constexpr int NITEMS = I_IN + I_OA + I_OB + I_OUT;
    for (int it = Ls.gw; it < NITEMS; it += F.NGW) {
        int r = it;
        if (r < I_IN) { p0_transpose_item_f8(F.w_in, DM, INW, (unsigned char*)WinT, W_SCALE, scr, r, Ls.lane); continue; } r -= I_IN;
        if (r < I_OA) { p0_transpose_item(F.w_oa, AQW, DM, WoaT, scr, r, Ls.lane); continue; } r -= I_OA;
        if (r < I_OB) { p0_transpose_item(F.w_ob, BOW, DM, WobT, scr, r, Ls.lane); continue; } r -= I_OB;
        p0_transpose_item_f8(F.w_out, DM, DM, (unsigned char*)WoutT, W_SCALE, scr, r, Ls.lane);
    }
    __syncthreads();
    for (int it = blockIdx.x; it < 512; it += F.G) p0_w2_item(F, (bf16*)(F.ws + WS_W2), it, Ls.tid);
    { unsigned char* U8 = F.ws + WS_U; float* esc = (float*)(F.ws + WS_ESC);
      static_assert(WS_V == WS_U + (size_t)NEXP * DM, "table map");
      for (int row = Ls.gw; row < 2 * NEXP; row += F.NGW) {
          const float* src = row < NEXP ? F.eu + (size_t)row * DM : F.ev + (size_t)(row - NEXP) * DM;
          f32x4 v[8]; float am = 0.f;
#pragma unroll
          for (int jj = 0; jj < 2; ++jj)
#pragma unroll
              for (int q = 0; q < 4; ++q) { v[4 * jj + q] = *(const f32x4*)(src + 1024 * jj + 16 * Ls.lane + 4 * q);
                  am = fmaxf(am, fmaxf(fmaxf(fabsf(v[4 * jj + q][0]), fabsf(v[4 * jj + q][1])), fmaxf(fabsf(v[4 * jj + q][2]), fabsf(v[4 * jj + q][3])))); }
#pragma unroll
          for (int o = 1; o < 64; o <<= 1) am = fmaxf(am, __shfl_xor(am, o));
          const float inv = am > 0.f ? 400.f / am : 0.f;
#pragma unroll
          for (int jj = 0; jj < 2; ++jj) { v4u w;
#pragma unroll
              for (int q = 0; q < 4; ++q) { const f32x4 t = v[4 * jj + q] * inv; int pk = __builtin_amdgcn_cvt_pk_fp8_f32(t[0], t[1], 0, false); pk = __builtin_amdgcn_cvt_pk_fp8_f32(t[2], t[3], pk, true); w[q] = (unsigned)pk; }
              { const int d0 = 1024 * jj + 16 * Ls.lane, P8_PBc = 2048 / P8_NP;
                *(v4u*)(U8 + (size_t)(row >= NEXP) * ((size_t)NEXP * DM) + (size_t)(d0 / P8_PBc) * ((size_t)NEXP * P8_PBc) + (size_t)(row & (NEXP - 1)) * P8_PBc + (d0 % P8_PBc)) = w; } }
          if (Ls.lane == 0) esc[row] = am * (1.f / 400.f);
      } }
    { bf16* Hb = (bf16*)(F.ws + WS_H);
      for (int m = Ls.gw; m < T; m += F.NGW) {
          const f32x4* xr = (const f32x4*)(F.x + (size_t)m * DM) + Ls.lane; f32x4 v[8]; float s = 0.f;
#pragma unroll
          for (int j = 0; j < 8; ++j) { v[j] = xr[64 * j]; s += (v[j][0] * v[j][0] + v[j][1] * v[j][1]) + (v[j][2] * v[j][2] + v[j][3] * v[j][3]); }
          const float rstd = rsqrtf(wave_sum(s) * (1.f / DM) + EPS);
          unsigned* o4 = (unsigned*)((unsigned char*)Hb + (size_t)m * DM) + Ls.lane;
#pragma unroll
          for (int j = 0; j < 8; ++j) { const f32x4 g = ((const f32x4*)F.g_mix)[Ls.lane + 64 * j];
              o4[64 * j] = pk4_fp8(v[j][0] * rstd * g[0], v[j][1] * rstd * g[1], v[j][2] * rstd * g[2], v[j][3] * rstd * g[3]); } } }
}

namespace att {
#define KSWZ(row, colB) ((row) * 256 + ((colB) ^ (((row) & 7) << 4)))
__device__ __forceinline__ int crow(int r, int hi) { return (r & 3) + 8 * (r >> 2) + 4 * hi; }
__device__ __forceinline__ void qkt(f32x16& p0, f32x16& p1, const char* Ks, const bf16x8* qr, int r32, int hi) {
    p0 = f32x16{}; p1 = f32x16{};
#pragma unroll
    for (int d0 = 0; d0 < 8; ++d0) { const int cb = (d0 * 16 + hi * 8) * 2;
        const bf16x8 b0 = *reinterpret_cast<const bf16x8*>(Ks + KSWZ(r32, cb));
        const bf16x8 b1 = *reinterpret_cast<const bf16x8*>(Ks + KSWZ(32 + r32, cb));
        p0 = __builtin_amdgcn_mfma_f32_32x32x16_bf16(b0, qr[d0], p0, 0, 0, 0);
        p1 = __builtin_amdgcn_mfma_f32_32x32x16_bf16(b1, qr[d0], p1, 0, 0, 0); }
}
__device__ __forceinline__ int v_st(int k, int c) { const int kk = (k & ~0xC) | ((k & 4) << 1) | ((k & 8) >> 1); return ((kk >> 3) * 4 + (c >> 5)) * 512 + ((kk & 7) * 32 + (c & 31)) * 2; }
__device__ __forceinline__ int v_rd_base(int lane) { return ((lane & 3) << 3) | (((lane >> 2) & 3) << 6) | (((lane >> 4) & 1) << 5) | (((lane >> 5) & 1) << 8); }
constexpr int v_rd_off(int d0, int ks, int half) { return d0 * 512 + ks * 4096 + half * 2048; }
template <int OFF> __device__ __forceinline__ s16x4 tr_read(int vb) {
    s16x4 r; asm volatile("ds_read_b64_tr_b16 %0, %1 offset:%2" : "=&v"(r) : "v"(vb), "i"(OFF) : "memory"); return r;
}
template <int D0> __device__ __forceinline__ void pv_one(f32x16& od, int vb, bf16x8 pa0, bf16x8 pa1, bf16x8 pa2, bf16x8 pa3) {
    const s16x4 l0 = tr_read<v_rd_off(D0, 0, 0)>(vb), h0 = tr_read<v_rd_off(D0, 0, 1)>(vb), l1 = tr_read<v_rd_off(D0, 1, 0)>(vb), h1 = tr_read<v_rd_off(D0, 1, 1)>(vb);
    const s16x4 l2 = tr_read<v_rd_off(D0, 2, 0)>(vb), h2 = tr_read<v_rd_off(D0, 2, 1)>(vb), l3 = tr_read<v_rd_off(D0, 3, 0)>(vb), h3 = tr_read<v_rd_off(D0, 3, 1)>(vb);
    asm volatile("s_waitcnt lgkmcnt(0)" ::: "memory"); SBAR();
#define PK(L, H) (bf16x8){L[0], L[1], L[2], L[3], H[0], H[1], H[2], H[3]}
    od = __builtin_amdgcn_mfma_f32_32x32x16_bf16(pa0, PK(l0, h0), od, 0, 0, 0);
    od = __builtin_amdgcn_mfma_f32_32x32x16_bf16(pa1, PK(l1, h1), od, 0, 0, 0);
    od = __builtin_amdgcn_mfma_f32_32x32x16_bf16(pa2, PK(l2, h2), od, 0, 0, 0);
    od = __builtin_amdgcn_mfma_f32_32x32x16_bf16(pa3, PK(l3, h3), od, 0, 0, 0);
#undef PK
}
__device__ __forceinline__ void pv_d0(f32x16* o, int vb, bf16x8 pa0, bf16x8 pa1, bf16x8 pa2, bf16x8 pa3) {
    pv_one<0>(o[0], vb, pa0, pa1, pa2, pa3); pv_one<1>(o[1], vb, pa0, pa1, pa2, pa3); pv_one<2>(o[2], vb, pa0, pa1, pa2, pa3); pv_one<3>(o[3], vb, pa0, pa1, pa2, pa3);
}
__device__ __forceinline__ int t5_bucket(int rel) {
    const int n = rel < 0 ? -rel : rel; int b;
    if (n < 8) b = n; else { b = 8 + (n >= 15) + (n >= 27) + (n >= 50) + (n >= 91) + (n >= 166) + (n >= 305) + (n >= 559); b = b > 15 ? 15 : b; }
    return b + (rel > 0 ? 16 : 0);
}
constexpr int ATT_WS_OFF = RSTD_OFF + 1024, ATT_BT_OFF = ATT_WS_OFF + 2048;
static_assert(ATT_BT_OFF + 2 * 1040 <= LDS_BYTES, "attention scratch above the stage region");
template <int W, bool SINK>
__device__ __forceinline__ void attn_unit(char* lds, const bf16* proj, int b, int qcol, int kcol, int vcol, int d, int r, int m0u,
                                          const float* bias_col, float sinkv, bf16* O, int ldo, int ocol, float* lse, int lse_j) {
    int tid_ = threadIdx.x; asm volatile("" : "+v"(tid_));
    const int tid = tid_, wid = __builtin_amdgcn_readfirstlane(tid >> 6), lane = tid & 63, r32 = lane & 31, hi = lane >> 5;
    const int hh = wid >> 2, wq = wid & 3, htid = tid & 255;
    constexpr int NT = (128 + 2 * W) / 64;
    const int L = SEQ / d, m0 = m0u + 128 * hh;
    char* hbase = lds + hh * 65536;
    float* ws = (float*)(lds + ATT_WS_OFF) + wid * 64; float* li_l = ws; float* al_l = ws + 32;
    float* btab = (float*)(lds + ATT_BT_OFF + hh * 1040);
    __syncthreads();
    for (int i = htid; i <= 2 * W; i += 256) btab[i] = bias_col[t5_bucket((i - W) * d) * NBIAS];
    const int qm = m0 + wq * 32 + r32;
    const size_t tok0 = (size_t)b * SEQ + r;
    bf16x8 qr[8];
    { const bf16* Qw = proj + (tok0 + (size_t)qm * d) * INW + qcol + hi * 8;
#pragma unroll
      for (int d0 = 0; d0 < 8; ++d0) qr[d0] = *reinterpret_cast<const bf16x8*>(Qw + d0 * 16); }
    float m_run = SINK ? sinkv : -1e29f, l_run = SINK ? 1.f : 0.f;
    f32x16 o[4] = {};
    const int sr = htid >> 4, sc = (htid & 15) * 8;
    const int t_lo = wq >> 1, t_hi = (32 * wq + 31 + 2 * W) >> 6;
    bf16x8 vs[4], ks[4];
#define SLOAD(t) do { const int tm = m0 - W + 64 * (t); if (tm + 63 >= 0 && tm < L) { _Pragma("unroll") for (int i_ = 0; i_ < 4; ++i_) { int k_ = tm + sr + 16 * i_; k_ = k_ < 0 ? 0 : (k_ > L - 1 ? L - 1 : k_); \
        const bf16* p_ = proj + (tok0 + (size_t)k_ * d) * INW + sc; vs[i_] = *reinterpret_cast<const bf16x8*>(p_ + vcol); ks[i_] = *reinterpret_cast<const bf16x8*>(p_ + kcol); } } } while (0)
#define SWRITE(t) do { const int tm = m0 - W + 64 * (t); if (tm + 63 >= 0 && tm < L) { char* vb_ = hbase + ((t) & 1) * 32768; char* kb_ = vb_ + 16384; _Pragma("unroll") for (int i_ = 0; i_ < 4; ++i_) { \
        *(bf16x8*)(vb_ + v_st(sr + 16 * i_, sc)) = vs[i_]; *(bf16x8*)(kb_ + KSWZ(sr + 16 * i_, sc * 2)) = ks[i_]; } } } while (0)
    SLOAD(0);
#pragma unroll 1
    for (int t = 0; t < NT; ++t) {
        SWRITE(t);
        __syncthreads();
        if (t + 1 < NT) SLOAD(t + 1);
        const int tm0 = m0 - W + 64 * t;
        if (t >= t_lo && t <= t_hi && tm0 + 63 >= 0 && tm0 < L) {
            const char* V_lds = hbase + (t & 1) * 32768; const char* K_lds = V_lds + 16384;
            const int vb0 = (int)(uintptr_t)V_lds + v_rd_base(lane);
            f32x16 p0, p1; qkt(p0, p1, K_lds, qr, r32, hi);
            const int base = tm0 - qm + W;
            float pmax = -1e30f;
#pragma unroll
            for (int q = 0; q < 16; ++q) { const int key = crow(q, hi), idx = base + key, km = tm0 + key;
                const bool ok = (unsigned)idx <= (unsigned)(2 * W) && (unsigned)km < (unsigned)L;
                const float bv = btab[ok ? idx : 0]; const float s = ok ? fmaf(p0[q], SM_SCALE, bv) : -1e30f; p0[q] = s; pmax = fmaxf(pmax, s); }
#pragma unroll
            for (int q = 0; q < 16; ++q) { const int key = 32 + crow(q, hi), idx = base + key, km = tm0 + key;
                const bool ok = (unsigned)idx <= (unsigned)(2 * W) && (unsigned)km < (unsigned)L;
                const float bv = btab[ok ? idx : 0]; const float s = ok ? fmaf(p1[q], SM_SCALE, bv) : -1e30f; p1[q] = s; pmax = fmaxf(pmax, s); }
            { auto rr = __builtin_amdgcn_permlane32_swap(__float_as_uint(pmax), __float_as_uint(pmax), false, false);
              pmax = fmaxf(__uint_as_float(rr[0]), __uint_as_float(rr[1])); }
            const float mn = fmaxf(m_run, pmax), alpha = __builtin_amdgcn_exp2f((m_run - mn) * LOG2E); m_run = mn;
            const float mnc = -mn * LOG2E; float ps = 0.f;
#pragma unroll
            for (int q = 0; q < 16; ++q) { p0[q] = __builtin_amdgcn_exp2f(fmaf(p0[q], LOG2E, mnc)); ps += p0[q]; }
#pragma unroll
            for (int q = 0; q < 16; ++q) { p1[q] = __builtin_amdgcn_exp2f(fmaf(p1[q], LOG2E, mnc)); ps += p1[q]; }
            { auto rr = __builtin_amdgcn_permlane32_swap(__float_as_uint(ps), __float_as_uint(ps), false, false);
              ps = __uint_as_float(rr[0]) + __uint_as_float(rr[1]); }
            l_run = l_run * alpha + ps;
            if (__any(alpha < 1.f)) { if (hi == 0) al_l[r32] = alpha; asm volatile("s_waitcnt lgkmcnt(0)" ::: "memory");
#pragma unroll
                for (int dd = 0; dd < 4; ++dd)
#pragma unroll
                    for (int q = 0; q < 16; ++q) o[dd][q] *= al_l[crow(q, hi)]; }
            bf16x8 pa0, pa1, pa2, pa3;
#define PK4(P, BASE, OUT) do { unsigned a0 = cvtpk(P[BASE + 0], P[BASE + 1]), a1 = cvtpk(P[BASE + 2], P[BASE + 3]);   \
    unsigned b0 = cvtpk(P[BASE + 4], P[BASE + 5]), b1 = cvtpk(P[BASE + 6], P[BASE + 7]);                              \
    auto r0 = __builtin_amdgcn_permlane32_swap(a0, b0, false, false); auto r1 = __builtin_amdgcn_permlane32_swap(a1, b1, false, false); \
    v4u w = {r0[0], r1[0], r0[1], r1[1]}; OUT = *reinterpret_cast<bf16x8*>(&w); } while (0)
            PK4(p0, 0, pa0); PK4(p0, 8, pa1); PK4(p1, 0, pa2); PK4(p1, 8, pa3);
#undef PK4
            pv_d0(o, vb0, pa0, pa1, pa2, pa3);
        }
    }
#undef SLOAD
#undef SWRITE
    if (hi == 0) li_l[r32] = l_run; asm volatile("s_waitcnt lgkmcnt(0)" ::: "memory");
    if (!SINK && hi == 0) lse[(tok0 + (size_t)qm * d) * 4 + lse_j] = m_run + __logf(l_run);
    __syncthreads();
    { char* ost = lds + wid * 8704;
#pragma unroll
      for (int q = 0; q < 16; ++q) { const float rl = __builtin_amdgcn_rcpf(li_l[crow(q, hi)]); unsigned short* orow = (unsigned short*)(ost + crow(q, hi) * 272) + r32;
#pragma unroll
          for (int dd = 0; dd < 4; ++dd) { const float v = o[dd][q] * rl; orow[dd * 32] = (unsigned short)(cvtpk(v, v) & 0xffffu); } }
      asm volatile("s_waitcnt lgkmcnt(0)" ::: "memory");
      const int rr = lane >> 4, cc = lane & 15;
#pragma unroll
      for (int k = 0; k < 8; ++k) { const int row = rr + 4 * k; const v4u w = *(const v4u*)(ost + row * 272 + cc * 16);
          *(v4u*)(O + (tok0 + (size_t)(m0 + wq * 32 + row) * d) * ldo + ocol + cc * 8) = w; } }
}
}

__device__ __forceinline__ void p2_attention(Frame& F) {
    const bf16* proj = (const bf16*)(F.ws + WS_PROJ);
    bf16* attA = (bf16*)(F.ws + WS_ATTA); bf16* oB = (bf16*)(F.ws + WS_OB); float* lseB = (float*)(F.ws + WS_LSE);
    const int vcu = (F.G & 7) ? (int)blockIdx.x : (int)(blockIdx.x & 7) * (F.G >> 3) + (int)(blockIdx.x >> 3);
    for (int uid = vcu; uid < 640; uid += F.G) {
        if (uid < 256) {
            const int b = uid >> 7, rem = uid & 127, blk = rem >> 3, hq = rem & 7, kvh = hq >> 2;
            att::attn_unit<128, true>(F.ldsg, proj, b, C_QA + hq * HD, C_KA + kvh * HD, C_VA + kvh * HD, 1, 0, blk * 256,
                                      F.rel_bias + hq, F.sink_a[hq], attA, AQW, hq * HD, nullptr, 0);
        } else {
            const int u2 = uid - 256, gi = u2 >> 7, rem = u2 & 127, b = rem >> 6, blk = (rem >> 2) & 15, j = rem & 3;
            const int d = gi == 0 ? 1 : (gi == 1 ? 4 : 16), nbr = 16 / d, r = blk / nbr, m0 = (blk % nbr) * 256, hb = gi * 4 + j;
            att::attn_unit<64, false>(F.ldsg, proj, b, C_QB + hb * HD, C_KB + hb * HD, C_VB + hb * HD, d, r, m0,
                                      F.rel_bias + 8 + hb, 0.f, oB + (size_t)gi * T * BOW, BOW, j * HD, lseB + (size_t)gi * T * 4, j);
        }
    }
}
__device__ __forceinline__ void p3_combine(Frame& F) {
    const Lane Ls = lane_state();
    const bf16* oB = (const bf16*)(F.ws + WS_OB); const float* lseB = (const float*)(F.ws + WS_LSE); bf16* attB = (bf16*)(F.ws + WS_ATTB);
    for (int t = Ls.gw; t < T; t += F.NGW) {
        const int j = Ls.lane >> 4;
        const float l0 = lseB[(size_t)t * 4 + j], l1 = lseB[(size_t)(T + t) * 4 + j], l2 = lseB[(size_t)(2 * T + t) * 4 + j];
        const float mx = fmaxf(l0, fmaxf(l1, l2)); const float e0 = __expf(l0 - mx), e1 = __expf(l1 - mx), e2 = __expf(l2 - mx); const float inv = 1.f / (e0 + e1 + e2);
        const float w0 = e0 * inv, w1 = e1 * inv, w2 = e2 * inv;
        const v4u a = *(const v4u*)(oB + (size_t)t * BOW + Ls.lane * 8), bq = *(const v4u*)(oB + ((size_t)T + t) * BOW + Ls.lane * 8), c = *(const v4u*)(oB + ((size_t)2 * T + t) * BOW + Ls.lane * 8);
        v4u o;
#pragma unroll
        for (int k = 0; k < 4; ++k) { const float lo = w0 * bflo(a[k]) + w1 * bflo(bq[k]) + w2 * bflo(c[k]), hi = w0 * bfhi(a[k]) + w1 * bfhi(bq[k]) + w2 * bfhi(c[k]); o[k] = cvtpk(lo, hi); }
        *(v4u*)(attB + (size_t)t * BOW + Ls.lane * 8) = o;
    }
}

__device__ __forceinline__ float gelu_erf(float v) {
    const float av = fabsf(v), t = __builtin_amdgcn_rcpf(fmaf(av, 0.2316418882f, 1.0f));
    float q = fmaf(t, 0.5307027145f, -0.7265760135f); q = fmaf(q, t, 0.7107068705f); q = fmaf(q, t, -0.142248368f); q = fmaf(q, t, 0.127414796f); q = q * t;
    const float e = __builtin_amdgcn_exp2f(v * v * -0.72134752044f);
    const float m = v * (q * e);
    return v < 0.f ? m : v - m;
}
typedef float f32x2 __attribute__((ext_vector_type(2)));
#define PIN16(A, B) asm volatile("" : "+v"(A[(B) + 0]), "+v"(A[(B) + 1]), "+v"(A[(B) + 2]), "+v"(A[(B) + 3]), "+v"(A[(B) + 4]), "+v"(A[(B) + 5]), "+v"(A[(B) + 6]), "+v"(A[(B) + 7]), \
    "+v"(A[(B) + 8]), "+v"(A[(B) + 9]), "+v"(A[(B) + 10]), "+v"(A[(B) + 11]), "+v"(A[(B) + 12]), "+v"(A[(B) + 13]), "+v"(A[(B) + 14]), "+v"(A[(B) + 15]) :: "memory")
#ifndef P8_DU
#define P8_DU 4
#endif
#ifndef P8_DV
#define P8_DV 8
#endif
constexpr int P8_CH = 8 / P8_NP;
constexpr int P8_ST = 16 * P8_CH;
constexpr int P8_PB = 256 * P8_CH;
template <int D> __device__ __forceinline__ void issue_part(v4u (&buf)[P8_CH], const unsigned char* tab, unsigned e, int gl) {
    const unsigned char* p = tab + (size_t)e * P8_PB + 16 * gl;
#pragma unroll
    for (int jj = 0; jj < P8_CH; ++jj) buf[jj] = *(const v4u*)(p + 256 * jj);
}
template <int D> __device__ __forceinline__ void sweep_u(const unsigned char* tab, const LAS unsigned* entg, LAS float* awg, int gl, int part, const float (&hv)[P8_ST]) {
    static_assert(128 % D == 0 && D % 4 == 0 && D <= 16, "block size");
    v4u buf[D][P8_CH];
    tab += (size_t)part * ((size_t)NEXP * P8_PB);
    { v4u e4[D / 4];
#pragma unroll
      for (int q = 0; q < D / 4; ++q) e4[q] = *(const LAS v4u*)(entg + 4 * q);
#pragma unroll
      for (int j = 0; j < D; ++j) issue_part<D>(buf[j], tab, e4[j >> 2][j & 3], gl); }
#pragma unroll 1
    for (int k0 = 0; k0 < 128; k0 += D) {
        v4u e4[D / 4]; const int kb = (k0 + D < 128) ? k0 + D : 128 - D;
#pragma unroll
        for (int q = 0; q < D / 4; ++q) e4[q] = *(const LAS v4u*)(entg + kb + 4 * q);
#pragma unroll
        for (int q = 0; q < D / 4; ++q) asm volatile("" : "+v"(e4[q]));
        float racc[D];
#pragma unroll
        for (int j = 0; j < D; ++j) {
            float a0 = 0.f, a1 = 0.f;
#pragma unroll
            for (int jj = 0; jj < P8_CH; ++jj)
#pragma unroll
                for (int c = 0; c < 4; ++c) { const f32x2 lo = __builtin_amdgcn_cvt_pk_f32_fp8((int)buf[j][jj][c], false), hi = __builtin_amdgcn_cvt_pk_f32_fp8((int)buf[j][jj][c], true);
                    a0 = fmaf(lo.x, hv[16 * jj + 4 * c + 0], a0); a1 = fmaf(lo.y, hv[16 * jj + 4 * c + 1], a1); a0 = fmaf(hi.x, hv[16 * jj + 4 * c + 2], a0); a1 = fmaf(hi.y, hv[16 * jj + 4 * c + 3], a1); }
            racc[j] = a0 + a1; asm volatile("" : "+v"(racc[j]) :: "memory");
            issue_part<D>(buf[j], tab, e4[j >> 2][j & 3], gl);
        }
#pragma unroll
        for (int st = D / 2; st >= 1; st >>= 1) { const bool up_ = (gl & st) != 0;
#pragma unroll
            for (int i = 0; i < st; ++i) { const float keep = up_ ? racc[i + st] : racc[i], send = up_ ? racc[i] : racc[i + st]; racc[i] = keep + __shfl_xor(send, st); } }
        float r = racc[0];
#pragma unroll
        for (int st = D; st < 16; st <<= 1) r += __shfl_xor(r, st);
        if (gl < D) awg[part * 512 + k0 + gl] = r;
    }
}
template <int D> __device__ __forceinline__ void sweep_v(const unsigned char* tab, const LAS unsigned* entg, const LAS float* awg, int gl, int part, float (&po)[P8_ST]) {
    static_assert(128 % D == 0 && D % 4 == 0 && D <= 16, "block size");
    v4u buf[D][P8_CH];
    tab += (size_t)part * ((size_t)NEXP * P8_PB);
    { v4u e4[D / 4];
#pragma unroll
      for (int q = 0; q < D / 4; ++q) e4[q] = *(const LAS v4u*)(entg + 4 * q);
#pragma unroll
      for (int j = 0; j < D; ++j) issue_part<D>(buf[j], tab, e4[j >> 2][j & 3], gl); }
#pragma unroll 1
    for (int k0 = 0; k0 < 128; k0 += D) {
        v4u e4[D / 4]; f32x4 w4[D / 4]; const int kb = (k0 + D < 128) ? k0 + D : 128 - D;
#pragma unroll
        for (int q = 0; q < D / 4; ++q) { e4[q] = *(const LAS v4u*)(entg + kb + 4 * q); w4[q] = *(const LAS f32x4*)(awg + k0 + 4 * q); }
#pragma unroll
        for (int q = 0; q < D / 4; ++q) asm volatile("" : "+v"(e4[q]), "+v"(w4[q]));
#pragma unroll
        for (int j = 0; j < D; ++j) {
            const float wk = w4[j >> 2][j & 3];
#pragma unroll
            for (int jj = 0; jj < P8_CH; ++jj)
#pragma unroll
                for (int c = 0; c < 4; ++c) { const f32x2 lo = __builtin_amdgcn_cvt_pk_f32_fp8((int)buf[j][jj][c], false), hi = __builtin_amdgcn_cvt_pk_f32_fp8((int)buf[j][jj][c], true);
                    po[16 * jj + 4 * c + 0] = fmaf(wk, lo.x, po[16 * jj + 4 * c + 0]); po[16 * jj + 4 * c + 1] = fmaf(wk, lo.y, po[16 * jj + 4 * c + 1]);
                    po[16 * jj + 4 * c + 2] = fmaf(wk, hi.x, po[16 * jj + 4 * c + 2]); po[16 * jj + 4 * c + 3] = fmaf(wk, hi.y, po[16 * jj + 4 * c + 3]); }
#pragma unroll
            for (int jj = 0; jj < P8_CH; ++jj) PIN16(po, 16 * jj);
            issue_part<D>(buf[j], tab, e4[j >> 2][j & 3], gl);
        }
    }
}
__device__ __forceinline__ void p8_expert(Frame& F) {
    const Lane Ls = lane_state();
    const unsigned char* U8 = F.ws + WS_U; const unsigned char* V8 = F.ws + WS_V; const float* esc = (const float*)(F.ws + WS_ESC);
    const float* part = (const float*)(F.ws + WS_PART); const int* tki = (const int*)(F.ws + WS_TKI); const float* tkg = (const float*)(F.ws + WS_TKG);
    bf16* X1b = (bf16*)(F.ws + WS_X1B);
    LAS unsigned* key = (LAS unsigned*)(F.lds + RING_OFF + Ls.wave * 16384); LAS unsigned* ent = key + 512; LAS float* gsv = (LAS float*)(ent + 512); LAS float* sus = gsv + 512; LAS float* aw = sus + 512;
    const int vw0 = ((int)(blockIdx.x & 7) * (F.G >> 3) + (int)(blockIdx.x >> 3)) * NWAVES + Ls.wave;
    for (int v = (F.G & 7) ? Ls.gw : vw0; v < T / 4; v += F.NGW) {
        unsigned zz = 0u; asm volatile("" : "+s"(zz));
        int lane = (int)__builtin_amdgcn_mbcnt_hi(~0u, __builtin_amdgcn_mbcnt_lo(~0u, zz)); asm volatile("" : "+v"(lane));
        const int sg = lane >> 4, gl = lane & 15, tok = 4 * v + sg;
        LAS unsigned* keyg = key + sg * 128; LAS unsigned* entg = ent + sg * 128; LAS float* gsvg = gsv + sg * 128; LAS float* susg = sus + sg * 128; LAS float* awg = aw + sg * 128;
        { unsigned mk[8]; float mg[8];
#pragma unroll
          for (int q = 0; q < 8; ++q) { const int j = gl + 16 * q; const int e = tki[(size_t)tok * 128 + j]; mg[q] = tkg[(size_t)tok * 128 + j]; mk[q] = ((unsigned)e << 7) | (unsigned)j; keyg[j] = mk[q]; }
          asm volatile("s_waitcnt lgkmcnt(0)" ::: "memory");
          int rk[8];
#pragma unroll
          for (int q = 0; q < 8; ++q) rk[q] = 0;
#pragma unroll 4
          for (int jj = 0; jj < 32; ++jj) { const v4u kk = *(const LAS v4u*)(keyg + 4 * jj);
#pragma unroll
              for (int c = 0; c < 4; ++c)
#pragma unroll
                  for (int q = 0; q < 8; ++q) rk[q] += (kk[c] < mk[q]) ? 1 : 0; }
#pragma unroll
          for (int q = 0; q < 8; ++q) { const int e = (int)(mk[q] >> 7); entg[rk[q]] = (unsigned)e; gsvg[rk[q]] = mg[q] * esc[NEXP + e]; susg[rk[q]] = esc[e]; }
          asm volatile("s_waitcnt lgkmcnt(0)" ::: "memory"); }
        float rstd;
        { float ps = part[(size_t)tok * 32 + gl] + part[(size_t)tok * 32 + 16 + gl];
          ps += __shfl_xor(ps, 1); ps += __shfl_xor(ps, 2); ps += __shfl_xor(ps, 4); ps += __shfl_xor(ps, 8);
          rstd = rsqrtf(ps * (1.f / DM) + EPS); }
#pragma unroll
        for (int pt = 0; pt < P8_NP; ++pt) {
            float hv[P8_ST];
            { int tok2 = tok; asm volatile("" : "+v"(tok2)); const bf16* xr = X1b + (size_t)tok2 * DM + P8_PB * pt + 16 * gl; const float* gp = F.g_ffn + P8_PB * pt + 16 * gl;
#pragma unroll
              for (int jj = 0; jj < P8_CH; ++jj) { const v4u a0 = *(const v4u*)(xr + 256 * jj), a1 = *(const v4u*)(xr + 256 * jj + 8);
#pragma unroll
                  for (int q = 0; q < 4; ++q) { const f32x4 g = *(const f32x4*)(gp + 256 * jj + 4 * q); const unsigned w0 = q < 2 ? a0[2 * q] : a1[2 * q - 4], w1 = q < 2 ? a0[2 * q + 1] : a1[2 * q - 3];
                      hv[16 * jj + 4 * q + 0] = bflo(w0) * rstd * g[0]; hv[16 * jj + 4 * q + 1] = bfhi(w0) * rstd * g[1]; hv[16 * jj + 4 * q + 2] = bflo(w1) * rstd * g[2]; hv[16 * jj + 4 * q + 3] = bfhi(w1) * rstd * g[3]; }
                  PIN16(hv, 16 * jj); } }
            sweep_u<P8_DU>(U8, entg, awg, gl, pt, hv);
            asm volatile("s_waitcnt lgkmcnt(0)" ::: "memory");
        }
#pragma unroll
        for (int q = 0; q < 8; ++q) { const int j = gl + 16 * q; const float x = ((awg[j] + awg[512 + j]) + (awg[1024 + j] + awg[1536 + j])) * susg[j]; awg[j] = gsvg[j] * gelu_erf(x); }
        asm volatile("s_waitcnt lgkmcnt(0)" ::: "memory");
        float s2 = 0.f;
#pragma unroll
        for (int pt = 0; pt < P8_NP; ++pt) {
            float po[P8_ST];
#pragma unroll
            for (int q = 0; q < P8_ST; ++q) po[q] = 0.f;
            sweep_v<P8_DV>(V8, entg, awg, gl, pt, po);
            { int tok2 = tok; asm volatile("" : "+v"(tok2)); bf16* xb = X1b + (size_t)tok2 * DM + P8_PB * pt + 16 * gl;
#pragma unroll
              for (int jj = 0; jj < P8_CH; ++jj) { const v4u a0 = *(const v4u*)(xb + 256 * jj), a1 = *(const v4u*)(xb + 256 * jj + 8); v4u o0, o1;
#pragma unroll
                  for (int q = 0; q < 4; ++q) { const unsigned w0 = q < 2 ? a0[2 * q] : a1[2 * q - 4], w1 = q < 2 ? a0[2 * q + 1] : a1[2 * q - 3]; f32x4 o;
                      o[0] = bflo(w0) + po[16 * jj + 4 * q + 0]; o[1] = bfhi(w0) + po[16 * jj + 4 * q + 1]; o[2] = bflo(w1) + po[16 * jj + 4 * q + 2]; o[3] = bfhi(w1) + po[16 * jj + 4 * q + 3];
#pragma unroll
                      for (int e = 0; e < 4; ++e) s2 = fmaf(o[e], o[e], s2);
                      const unsigned p0 = cvtpk(o[0], o[1]), p1 = cvtpk(o[2], o[3]);
                      if (q < 2) { o0[2 * q] = p0; o0[2 * q + 1] = p1; } else { o1[2 * q - 4] = p0; o1[2 * q - 3] = p1; } }
                  *(v4u*)(xb + 256 * jj) = o0; *(v4u*)(xb + 256 * jj + 8) = o1;
                  asm volatile("" : "+v"(s2) :: "memory"); } }
        }
        { s2 += __shfl_xor(s2, 1); s2 += __shfl_xor(s2, 2); s2 += __shfl_xor(s2, 4); s2 += __shfl_xor(s2, 8);
          const float r2 = rsqrtf(s2 * (1.f / DM) + EPS);
          int tok2 = tok; asm volatile("" : "+v"(tok2)); float* xr = F.out + (size_t)tok2 * DM + 16 * gl; const float* gf = F.g_fin + 16 * gl; const bf16* xb = X1b + (size_t)tok2 * DM + 16 * gl;
#pragma unroll
          for (int jj = 0; jj < 8; ++jj) { const v4u a0 = *(const v4u*)(xb + 256 * jj), a1 = *(const v4u*)(xb + 256 * jj + 8);
#pragma unroll
              for (int q = 0; q < 4; ++q) { const f32x4 g = *(const f32x4*)(gf + 256 * jj + 4 * q); const unsigned w0 = q < 2 ? a0[2 * q] : a1[2 * q - 4], w1 = q < 2 ? a0[2 * q + 1] : a1[2 * q - 3];
                  const f32x4 a = {bflo(w0), bfhi(w0), bflo(w1), bfhi(w1)};
                  *(f32x4*)(xr + 256 * jj + 4 * q) = a * r2 * g; }
              asm volatile("" ::: "memory"); } }
    }
}

constexpr int N_PHASES = 9;
struct Args { const float* in[14]; float* out; unsigned char* ws; int ph_lo, ph_hi; };
__global__ void __launch_bounds__(NWAVES * 64, 2) fwd_kernel(Args args) {
    extern __shared__ __attribute__((aligned(16))) unsigned char lds[];
    Frame F;
    F.lds = (LAS unsigned char*)lds; F.ldsg = (char*)lds;
    F.G = gridDim.x; F.NGW = F.G * NWAVES;
    F.x = args.in[0]; F.rel_bias = args.in[1]; F.g_mix = args.in[2]; F.w_in = args.in[3]; F.sink_a = args.in[4]; F.w_oa = args.in[5]; F.w_ob = args.in[6]; F.w_out = args.in[7];
    F.g_ffn = args.in[8]; F.w_pq = args.in[9]; F.keys = args.in[10]; F.eu = args.in[11]; F.ev = args.in[12]; F.g_fin = args.in[13];
    F.out = args.out; F.ws = args.ws;
    volatile LAS unsigned* MISC = (volatile LAS unsigned*)(F.lds + MISC_OFF);
    for (int u = threadIdx.x; u < (LDS_BYTES - LDSCTL_OFF) / 4; u += NWAVES * 64) ((LAS unsigned*)(F.lds + LDSCTL_OFF))[u] = 0u;
    __syncthreads();
    const int lo = args.ph_lo, hi = args.ph_hi;
    const bool multi = !MK_SPLIT || (hi - lo) > 1;
    XcdBarrier bar; bar.bar = (unsigned*)(F.ws + WS_CTL) + CW_BAR; bar.x = 0; bar.st = nullptr;
    if (multi) bar = xcd_barrier_post((unsigned*)(F.ws + WS_CTL) + CW_BAR, MISC + 8);
#ifndef PH_OFF
#define PH_OFF 0
#endif
#if MK_SPLIT
#define IN(k) (lo <= (k) && (k) < hi && !((PH_OFF >> (k)) & 1))
#else
#define IN(k) (!((PH_OFF >> (k)) & 1))
#endif
#define GRID_BAR() do { XcdBarrier b_ = bar; asm volatile("" : "+s"(b_.bar)); xcd_barrier(b_); } while (0)
#define SEAM(k) do { if (IN(k) && IN((k) + 1)) GRID_BAR(); } while (0)
#ifndef PH_REP
#define PH_REP 0
#endif
#define NREP(k) (IN(k) ? 1 + ((PH_REP >> (k)) & 1) : 0)
#define REPEAT(k) _Pragma("unroll") for (int r_ = 0; r_ < NREP(k); ++r_)
#define REBAR() do { if (r_) GRID_BAR(); } while (0)
    bf16* WinT = (bf16*)(F.ws + WS_WIN); bf16* WoaT = (bf16*)(F.ws + WS_WOA); bf16* WobT = (bf16*)(F.ws + WS_WOB); bf16* WoutT = (bf16*)(F.ws + WS_WOUT); bf16* W2T = (bf16*)(F.ws + WS_W2);
    bf16* proj = (bf16*)(F.ws + WS_PROJ); bf16* Hb = (bf16*)(F.ws + WS_H); bf16* mrg = (bf16*)(F.ws + WS_MRG);
    bf16* attA = (bf16*)(F.ws + WS_ATTA); bf16* attB = (bf16*)(F.ws + WS_ATTB); bf16* x1b = (bf16*)(F.ws + WS_X1B);
    float* part = (float*)(F.ws + WS_PART); float* scores = (float*)(F.ws + WS_SC);

    REPEAT(0) { REBAR(); p0_prologue(F); } SEAM(0);
    REPEAT(1) { REBAR();
        pg8::Gemm g{Hb, WinT, T, INW, DM / 2}; pg8::StaticOrder S; S.init(T, INW, F.G, (int)blockIdx.x);
        pg8::EpiProj E{proj, INW, C_GA / 256, 1.f / W_SCALE};
        pg8::gemm_phase<pg8::EpiProj, pg8::StaticOrder, true, true, true>(F.lds + RING_OFF, g, S, E);
    } SEAM(1);
    REPEAT(2) { REBAR(); p2_attention(F); } SEAM(2);
    for (int r34 = 0; r34 < 1 + ((PH_REP >> 3) & 1); ++r34) {
    if (r34) GRID_BAR();
    if (IN(3)) {
        p3_combine(F);
        pg8::Gemm g{attA, WoaT, T, DM, AQW}; pg8::StaticOrder S; S.init(T, DM, F.G, (int)blockIdx.x);
        pg8::EpiGate<false> E{proj + C_GA, INW, mrg, DM};
        pg8::gemm_phase<pg8::EpiGate<false>, pg8::StaticOrder, false, true>(F.lds + RING_OFF, g, S, E);
    } SEAM(3);
    if (IN(4)) {
        pg8::Gemm g{attB, WobT, T, DM, BOW}; pg8::StaticOrder S; S.init(T, DM, F.G, (int)blockIdx.x);
        pg8::EpiGateF8 E{proj + C_GB, INW, mrg, DM, F.ws + WS_MRG8, DM, M_SCALE};
        pg8::gemm_phase<pg8::EpiGateF8, pg8::StaticOrder, false, true>(F.lds + RING_OFF, g, S, E);
    }
    }
    SEAM(4);
    REPEAT(5) { REBAR();
        pg8::Gemm g{(const bf16*)(F.ws + WS_MRG8), WoutT, T, DM, DM / 2}; pg8::StaticOrder S; S.init(T, DM, F.G, (int)blockIdx.x);
        pg8::EpiResid E{F.x, x1b, part, DM, 1.f / (M_SCALE * W_SCALE)};
        pg8::gemm_phase<pg8::EpiResid, pg8::StaticOrder, false, true, true>(F.lds + RING_OFF, g, S, E);
    } SEAM(5);
    REPEAT(6) { REBAR();
        pg8::Gemm g{x1b, W2T, T, DM, DM}; pg8::StaticOrder S; S.init(T, DM, F.G, (int)blockIdx.x);
        LAS float* rs = (LAS float*)(F.lds + RSTD_OFF);
        const Lane Ls = lane_state();
        pg8::Unit u0; if (S.next(0, u0) && Ls.tid < 256) { const f32x4* pp = (const f32x4*)(part + (size_t)(u0.pm * 256 + Ls.tid) * 32); float s = 0.f;
#pragma unroll
            for (int i = 0; i < 8; ++i) { const f32x4 v = pp[i]; s += (v[0] + v[1]) + (v[2] + v[3]); }
            rs[Ls.tid] = rsqrtf(s * (1.f / DM) + EPS); }
        __syncthreads();
        pg8::EpiTopk E{rs, (int*)(F.ws + WS_TKI), (float*)(F.ws + WS_TKG), PHEADS, scores, DM};
        pg8::gemm_phase<pg8::EpiTopk, pg8::StaticOrder, false, true>(F.lds + RING_OFF, g, S, E);
    }
    if (IN(6) && IN(8)) GRID_BAR();
    if (IN(8)) { p8_expert(F); }
#undef IN
#undef SEAM
}

extern "C" void kernel_launch(void* const* d_in, const int* in_sizes, int n_in, void* d_out, int out_size, void* d_ws, size_t ws_size, hipStream_t stream) {
    static int grid = 0;
    if (grid == 0) {
        if (n_in != 14 || in_sizes[0] != T * DM || out_size != T * DM || ws_size < WS_END) {
            fprintf(stderr, "kernel_launch: unexpected shapes: n_in %d in0 %d out %d ws %zu (need >= %zu); nothing launched\n", n_in, n_in > 0 ? in_sizes[0] : -1, out_size, ws_size, (size_t)WS_END); grid = -1; return; }
        int dev = 0, cus = 0, per_cu = 0;
        if (hipGetDevice(&dev) != hipSuccess || hipDeviceGetAttribute(&cus, hipDeviceAttributeMultiprocessorCount, dev) != hipSuccess) { grid = -1; return; }
        if (hipFuncSetAttribute((const void*)fwd_kernel, hipFuncAttributeMaxDynamicSharedMemorySize, LDS_BYTES) != hipSuccess) { fprintf(stderr, "kernel_launch: hipFuncSetAttribute failed\n"); grid = -1; return; }
        if (hipOccupancyMaxActiveBlocksPerMultiprocessor(&per_cu, (const void*)fwd_kernel, NWAVES * 64, LDS_BYTES) != hipSuccess || per_cu < 1)
            fprintf(stderr, "kernel_launch: note: occupancy query reports %d workgroups per CU\n", per_cu);
        (void)hipGetLastError();
        grid = cus;
        if (grid != 256) fprintf(stderr, "kernel_launch: note: %d CUs (built for 256)\n", grid);
    }
    if (grid < 0) return;
    (void)hipMemsetAsync((char*)d_ws + WS_CTL, 0, CTL_ZERO_BYTES, stream);
    Args a{};
    for (int i = 0; i < 14; ++i) a.in[i] = (const float*)d_in[i];
    a.out = (float*)d_out; a.ws = (unsigned char*)d_ws;
#if MK_SPLIT
    for (int p = 0; p < N_PHASES; ++p) { a.ph_lo = p; a.ph_hi = p + 1; hipLaunchKernelGGL(fwd_kernel, dim3(grid), dim3(NWAVES * 64), LDS_BYTES, stream, a); }
#else
    a.ph_lo = 0; a.ph_hi = N_PHASES; hipLaunchKernelGGL(fwd_kernel, dim3(grid), dim3(NWAVES * 64), LDS_BYTES, stream, a);
#endif
    const hipError_t le = hipPeekAtLastError();
    if (le != hipSuccess) fprintf(stderr, "kernel_launch: launch failed: %s\n", hipGetErrorName(le));
}
```

```cpp
#include <hip/hip_runtime.h>
#include <cstdio>
#include <cstdint>
namespace pg8 {
#define PG8_LAS __attribute__((address_space(3)))
typedef unsigned short bf16_t;
typedef short bf16x8 __attribute__((ext_vector_type(8)));
typedef float f32x4 __attribute__((ext_vector_type(4)));
typedef unsigned u32x4 __attribute__((ext_vector_type(4)));
typedef int v4i_t __attribute__((ext_vector_type(4)));
typedef int v8i_t __attribute__((ext_vector_type(8)));
constexpr int BM = 256, BK = 64, HALF = 128, HTB = HALF * BK * 2  , STAGE_BYTES = 8 * HTB, NXCD = 8, WGM = 8;

__host__ __device__ __forceinline__ int lds_byte(int r, int c) { const int st = (r >> 4) * 2 + (c >> 5), rr = r & 15, cc = c & 31, ob = rr * 64 + cc * 2; return st * 1024 + (ob ^ (((ob >> 9) & 1) << 5)); }
__host__ __device__ __forceinline__ void stage_rc(int b, int& R, int& C) { const int st = b / 1024, sb = b % 1024, swz = sb ^ (((sb >> 9) & 1) << 5); R = (st >> 1) * 16 + swz / 64; C = (st & 1) * 32 + (swz % 64) / 2; }
__host__ __device__ __forceinline__ int perm32(int rho) { const int n = rho >> 4, i = rho & 15; return 8 * (i >> 2) + 4 * n + (i & 3); }

struct Unit { int pm, pn; };
struct Gemm { const bf16_t* A; const bf16_t* Bt; int M, N, K; };

struct StaticOrder {
    int nM, nN, nwg, G, c;
    __host__ __device__ void init(int M, int N, int G_, int c_) { nM = M / BM; nN = N / BM; nwg = nM * nN; G = G_; c = c_; }
    __host__ __device__ bool next(int i, Unit& u) const {
        const long L = (long)i * G + c; if (L >= nwg) return false;
        int wgid = (int)L; { const int q = nwg / NXCD, r = nwg % NXCD, xcd = wgid % NXCD, off = wgid / NXCD; wgid = (xcd < r ? xcd * (q + 1) : r * (q + 1) + (xcd - r) * q) + off; }
        const int nig = WGM * nN, gid = wgid / nig, fm = gid * WGM, gsz = (nM - fm) < WGM ? (nM - fm) : WGM;
        u.pm = fm + ((wgid % nig) % gsz); u.pn = (wgid % nig) / gsz; return true;
    }
    __device__ __forceinline__ void a_ready(const Unit&) const {}
    __device__ __forceinline__ void done(const Unit&) const {}
};

typedef unsigned u32x2 __attribute__((ext_vector_type(2)));
__device__ __forceinline__ unsigned cvt_pk_bf16(float lo, float hi) { unsigned r; asm volatile("v_cvt_pk_bf16_f32 %0, %1, %2" : "=v"(r) : "v"(lo), "v"(hi)); return r; }
__device__ __forceinline__ float sigm(float v) { return __builtin_amdgcn_rcpf(1.0f + __builtin_amdgcn_exp2f(-1.4426950408889634f * v)); }
__device__ __forceinline__ float bflo(unsigned w) { return __builtin_bit_cast(float, w << 16); }
__device__ __forceinline__ float bfhi(unsigned w) { return __builtin_bit_cast(float, w & 0xffff0000u); }

struct EpiProj {
    static constexpr bool PERM = true, AFTER_DRAIN = false;
    bf16_t* O; int ldc; int gate_pn; float osc;
    __device__ __forceinline__ void operator()(const f32x4 (&acc)[2][2][4][2], const Unit& u, int wr, int wc, int fr_, int fq_) const {
        (void)fr_; (void)fq_; int ln_ = (int)__builtin_amdgcn_mbcnt_hi(~0u, __builtin_amdgcn_mbcnt_lo(~0u, 0u)); asm volatile("" : "+v"(ln_));
        const int fr = ln_ & 15, fq = ln_ >> 4;
        const int row0 = u.pm * BM + wr * 64 + fr, col0 = u.pn * BM + wc * 32 + 8 * fq; const bool gate = u.pn >= gate_pn;
#pragma unroll
        for (int ai = 0; ai < 2; ++ai)
#pragma unroll
            for (int m = 0; m < 4; ++m) { bf16_t* rowp = O + (size_t)(row0 + ai * HALF + m * 16) * ldc + col0;
#pragma unroll
                for (int bj = 0; bj < 2; ++bj) { f32x4 v0 = acc[ai][bj][m][0] * osc, v1 = acc[ai][bj][m][1] * osc;
                    if (gate) {
#pragma unroll
                        for (int j = 0; j < 4; ++j) { v0[j] = sigm(v0[j]); v1[j] = sigm(v1[j]); } }
                    u32x4 w; w.x = cvt_pk_bf16(v0[0], v0[1]); w.y = cvt_pk_bf16(v0[2], v0[3]); w.z = cvt_pk_bf16(v1[0], v1[1]); w.w = cvt_pk_bf16(v1[2], v1[3]);
                    *(u32x4*)(rowp + bj * HALF) = w; } }
    }
};
template <bool ACCUM> struct EpiGate {
    static constexpr bool PERM = true, AFTER_DRAIN = false;
    const bf16_t* G; int ldg; bf16_t* O; int ldc; float osc;
    __device__ __forceinline__ void operator()(const f32x4 (&acc)[2][2][4][2], const Unit& u, int wr, int wc, int fr_, int fq_) const {
        (void)fr_; (void)fq_; int ln_ = (int)__builtin_amdgcn_mbcnt_hi(~0u, __builtin_amdgcn_mbcnt_lo(~0u, 0u)); asm volatile("" : "+v"(ln_));
        const int fr = ln_ & 15, fq = ln_ >> 4;
        const int row0 = u.pm * BM + wr * 64 + fr, col0 = u.pn * BM + wc * 32 + 8 * fq;
#pragma unroll
        for (int ai = 0; ai < 2; ++ai)
#pragma unroll
            for (int m = 0; m < 4; ++m) { const int row = row0 + ai * HALF + m * 16; const bf16_t* gp = G + (size_t)row * ldg + col0; bf16_t* op = O + (size_t)row * ldc + col0;
#pragma unroll
                for (int bj = 0; bj < 2; ++bj) { const u32x4 gw = *(const u32x4*)(gp + bj * HALF);
                    f32x4 v0 = acc[ai][bj][m][0] * osc, v1 = acc[ai][bj][m][1] * osc;
                    v0[0] *= bflo(gw.x); v0[1] *= bfhi(gw.x); v0[2] *= bflo(gw.y); v0[3] *= bfhi(gw.y);
                    v1[0] *= bflo(gw.z); v1[1] *= bfhi(gw.z); v1[2] *= bflo(gw.w); v1[3] *= bfhi(gw.w);
                    if (ACCUM) { const u32x4 mw = *(const u32x4*)(op + bj * HALF);
                        v0[0] += bflo(mw.x); v0[1] += bfhi(mw.x); v0[2] += bflo(mw.y); v0[3] += bfhi(mw.y);
                        v1[0] += bflo(mw.z); v1[1] += bfhi(mw.z); v1[2] += bflo(mw.w); v1[3] += bfhi(mw.w); }
                    u32x4 w; w.x = cvt_pk_bf16(v0[0], v0[1]); w.y = cvt_pk_bf16(v0[2], v0[3]); w.z = cvt_pk_bf16(v1[0], v1[1]); w.w = cvt_pk_bf16(v1[2], v1[3]);
                    *(u32x4*)(op + bj * HALF) = w; } }
    }
};
__device__ __forceinline__ unsigned pk4_fp8e(float a, float b, float c, float d) { int p = __builtin_amdgcn_cvt_pk_fp8_f32(fminf(fmaxf(a, -448.f), 448.f), fminf(fmaxf(b, -448.f), 448.f), 0, false);
    return (unsigned)__builtin_amdgcn_cvt_pk_fp8_f32(fminf(fmaxf(c, -448.f), 448.f), fminf(fmaxf(d, -448.f), 448.f), p, true); }
struct EpiGateF8 {
    static constexpr bool PERM = true, AFTER_DRAIN = false;
    const bf16_t* G; int ldg; const bf16_t* M1; int ldm; unsigned char* O8; int ldc; float oscale; float osc;
    __device__ __forceinline__ void operator()(const f32x4 (&acc)[2][2][4][2], const Unit& u, int wr, int wc, int fr_, int fq_) const {
        (void)fr_; (void)fq_; int ln_ = (int)__builtin_amdgcn_mbcnt_hi(~0u, __builtin_amdgcn_mbcnt_lo(~0u, 0u)); asm volatile("" : "+v"(ln_));
        const int fr = ln_ & 15, fq = ln_ >> 4;
        const int row0 = u.pm * BM + wr * 64 + fr, col0 = u.pn * BM + wc * 32 + 8 * fq;
#pragma unroll
        for (int ai = 0; ai < 2; ++ai)
#pragma unroll
            for (int m = 0; m < 4; ++m) { const int row = row0 + ai * HALF + m * 16; const bf16_t* gp = G + (size_t)row * ldg + col0; const bf16_t* mp = M1 + (size_t)row * ldm + col0; unsigned char* op = O8 + (size_t)row * ldc + col0;
#pragma unroll
                for (int bj = 0; bj < 2; ++bj) { const u32x4 gw = *(const u32x4*)(gp + bj * HALF), mw = *(const u32x4*)(mp + bj * HALF);
                    f32x4 v0 = acc[ai][bj][m][0] * osc, v1 = acc[ai][bj][m][1] * osc;
                    v0[0] = (v0[0] * bflo(gw.x) + bflo(mw.x)) * oscale; v0[1] = (v0[1] * bfhi(gw.x) + bfhi(mw.x)) * oscale; v0[2] = (v0[2] * bflo(gw.y) + bflo(mw.y)) * oscale; v0[3] = (v0[3] * bfhi(gw.y) + bfhi(mw.y)) * oscale;
                    v1[0] = (v1[0] * bflo(gw.z) + bflo(mw.z)) * oscale; v1[1] = (v1[1] * bfhi(gw.z) + bfhi(mw.z)) * oscale; v1[2] = (v1[2] * bflo(gw.w) + bflo(mw.w)) * oscale; v1[3] = (v1[3] * bfhi(gw.w) + bfhi(mw.w)) * oscale;
                    u32x2 w; w.x = pk4_fp8e(v0[0], v0[1], v0[2], v0[3]); w.y = pk4_fp8e(v1[0], v1[1], v1[2], v1[3]);
                    *(u32x2*)(op + bj * HALF) = w; } }
    }
};

struct EpiResid {
    static constexpr bool PERM = false, AFTER_DRAIN = false;
    const float* X; bf16_t* X1b; float* part; int ld; float osc;
    __device__ __forceinline__ void operator()(const f32x4 (&acc)[2][2][4][2], const Unit& u, int wr, int wc, int fr_, int fq_) const {
        (void)fr_; (void)fq_; int ln_ = (int)__builtin_amdgcn_mbcnt_hi(~0u, __builtin_amdgcn_mbcnt_lo(~0u, 0u)); asm volatile("" : "+v"(ln_));
        const int fr = ln_ & 15, fq = ln_ >> 4;
        const int row0 = u.pm * BM + wr * 64 + fr, col0 = u.pn * BM + wc * 32 + 4 * fq;
#pragma unroll
        for (int ai = 0; ai < 2; ++ai)
#pragma unroll
            for (int m = 0; m < 4; ++m) { const int row = row0 + ai * HALF + m * 16; float ss = 0.f;
#pragma unroll
                for (int bj = 0; bj < 2; ++bj)
#pragma unroll
                    for (int n = 0; n < 2; ++n) { const size_t off = (size_t)row * ld + col0 + bj * HALF + n * 16;
                        const f32x4 x = *(const f32x4*)(X + off); const f32x4 v = x + acc[ai][bj][m][n] * osc;
                        u32x2 w; w.x = cvt_pk_bf16(v[0], v[1]); w.y = cvt_pk_bf16(v[2], v[3]); *(u32x2*)(X1b + off) = w;
                        ss += (v[0] * v[0] + v[1] * v[1]) + (v[2] * v[2] + v[3] * v[3]); }
                ss += __shfl_xor(ss, 16); ss += __shfl_xor(ss, 32);
                if (fq == 0) part[(size_t)row * 32 + u.pn * 4 + wc] = ss; }
    }
};
__device__ __forceinline__ int tk_enc(float s) { const int b = __builtin_bit_cast(int, s); return b ^ ((b >> 31) & 0x7fffffff); }
__device__ __forceinline__ float tk_dec(int k) { return __builtin_bit_cast(float, k ^ ((k >> 31) & 0x7fffffff)); }
#define TK_INS16(Lst, X) do { int x_ = (X); _Pragma("unroll") for (int i_ = 0; i_ < 16; ++i_) { const int h_ = Lst[i_] > x_ ? Lst[i_] : x_; x_ = Lst[i_] > x_ ? x_ : Lst[i_]; Lst[i_] = h_; } } while (0)
__device__ __forceinline__ void tk_sort16(int (&v)[16]) {
#pragma unroll
    for (int k = 2; k <= 16; k <<= 1)
#pragma unroll
        for (int j = k >> 1; j > 0; j >>= 1)
#pragma unroll
            for (int i = 0; i < 16; ++i) { const int l = i ^ j; if (l > i) { const int a = v[i], b = v[l]; const int hi = a > b ? a : b, lo = a > b ? b : a; const bool desc = (i & k) == 0; v[i] = desc ? hi : lo; v[l] = desc ? lo : hi; } }
}
__device__ __forceinline__ void tk_merge16(int (&a)[16], const int (&b)[16]) {
#pragma unroll
    for (int i = 0; i < 16; ++i) a[i] = a[i] > b[15 - i] ? a[i] : b[15 - i];
#pragma unroll
    for (int j = 8; j > 0; j >>= 1)
#pragma unroll
        for (int i = 0; i < 16; ++i) { const int l = i ^ j; if (l > i) { const int x = a[i], y = a[l]; a[i] = x > y ? x : y; a[l] = x > y ? y : x; } }
}
#define TK_BAR() do { asm volatile("s_waitcnt lgkmcnt(0)" ::: "memory"); __builtin_amdgcn_s_barrier(); asm volatile("" ::: "memory"); } while (0)
struct EpiTopk {
    static constexpr bool PERM = false, AFTER_DRAIN = true;
    const PG8_LAS float* rs; int* tki; float* tkg; int nheads; float* S; int ld;
    __device__ __forceinline__ void fused(f32x4 (&acc)[2][2][4][2], const Unit& u, int wr, int wc, int fr_, int fq_, PG8_LAS unsigned char* lds, int wid, int lane_) const {
        (void)fr_; (void)fq_; (void)lane_; int lane = (int)__builtin_amdgcn_mbcnt_hi(~0u, __builtin_amdgcn_mbcnt_lo(~0u, 0u)); asm volatile("" : "+v"(lane));
        const int fr = lane & 15, fq = lane >> 4;
        PG8_LAS float* img = (PG8_LAS float*)lds;
        PG8_LAS int* lst = (PG8_LAS int*)lds;
        PG8_LAS int* mrg = (PG8_LAS int*)(lds + 32768);
#pragma unroll
        for (int ai = 0; ai < 2; ++ai)
#pragma unroll
            for (int m = 0; m < 4; ++m) { const int row = ai * HALF + wr * 64 + m * 16 + fr; const float s = rs[row]; float* rowp = S + (size_t)(u.pm * BM + row) * ld + u.pn * BM + wc * 32 + 4 * fq;
#pragma unroll
                for (int bj = 0; bj < 2; ++bj)
#pragma unroll
                    for (int n = 0; n < 2; ++n) *(f32x4*)(rowp + bj * HALF + n * 16) = acc[ai][bj][m][n] * s; }
        asm volatile("s_waitcnt vmcnt(0)" ::: "memory");
        TK_BAR();
#ifndef TK_REP
#define TK_REP 0
#endif
#pragma unroll 1
        for (int ai_ = 0; ai_ < 2 * (1 + TK_REP); ++ai_) { const int ai = ai_ & 1;
            asm volatile("" : "+v"(lane) :: "memory");
            const int tid = wid * 64 + lane;
            { const float* src = S + (size_t)(u.pm * BM + ai * HALF) * ld + u.pn * BM;
#pragma unroll 4
              for (int i = 0; i < 16; ++i) { const int idx = tid + 512 * i, row = idx >> 6, q = idx & 63; *(PG8_LAS f32x4*)(img + row * 256 + ((q ^ (row & 63)) << 2)) = *(const f32x4*)(src + (size_t)row * ld + 4 * q); } }
            TK_BAR();
            const int row = tid & 127, c = (tid >> 7) & 1, kh = tid >> 8;
            int Lk[16];
#pragma unroll 1
            for (int g = 0; g < 4; ++g) {
                int Nk[16];
#pragma unroll
                for (int i = 0; i < 4; ++i) { const int q = 32 * c + 16 * kh + 4 * g + i; const f32x4 v = *(const PG8_LAS f32x4*)(img + row * 256 + ((q ^ (row & 63)) << 2));
#pragma unroll
                    for (int e = 0; e < 4; ++e) Nk[4 * i + e] = (tk_enc(v[e]) & ~127) | (127 - (64 * kh + 16 * g + 4 * i + e)); }
                tk_sort16(Nk);
                if (g == 0) {
#pragma unroll
                    for (int i = 0; i < 16; ++i) Lk[i] = Nk[i]; }
                else tk_merge16(Lk, Nk);
            }
            TK_BAR();
            { PG8_LAS int* d = lst + ((row * 2 + c) * 2 + kh) * 16;
#pragma unroll
              for (int i = 0; i < 4; ++i) *(PG8_LAS v4i_t*)(d + 4 * i) = (v4i_t){Lk[4 * i], Lk[4 * i + 1], Lk[4 * i + 2], Lk[4 * i + 3]}; }
            TK_BAR();
            if (kh == 0) {
                const PG8_LAS int* o = lst + ((row * 2 + c) * 2 + 1) * 16; int Ok[16];
#pragma unroll
                for (int i = 0; i < 4; ++i) { const v4i_t w = *(const PG8_LAS v4i_t*)(o + 4 * i); Ok[4 * i] = w[0]; Ok[4 * i + 1] = w[1]; Ok[4 * i + 2] = w[2]; Ok[4 * i + 3] = w[3]; }
                tk_merge16(Lk, Ok);
                PG8_LAS int* d = mrg + (row * 2 + c) * 16;
#pragma unroll
                for (int i = 0; i < 4; ++i) *(PG8_LAS v4i_t*)(d + 4 * i) = (v4i_t){Lk[4 * i], Lk[4 * i + 1], Lk[4 * i + 2], Lk[4 * i + 3]};
            }
            TK_BAR();
            if (tid < 128) {
                const PG8_LAS int* A = mrg + (tid * 2 + 0) * 16; const PG8_LAS int* B = mrg + (tid * 2 + 1) * 16;
                float s0[16], s1[16];
#pragma unroll
                for (int i = 0; i < 4; ++i) { const v4i_t a = *(const PG8_LAS v4i_t*)(A + 4 * i), b = *(const PG8_LAS v4i_t*)(B + 4 * i);
#pragma unroll
                    for (int e = 0; e < 4; ++e) { s0[4 * i + e] = tk_dec(a[e] & ~127); s1[4 * i + e] = tk_dec(b[e] & ~127); } }
                int Mk[16], Ck[16];
                int cnt = 0;
#pragma unroll
                for (int i = 0; i < 16; ++i)
#pragma unroll
                    for (int j = 0; j < 16; ++j) if ((i + 1) * (j + 1) <= 16) {
                        Ck[cnt & 15] = (tk_enc(s0[i] + s1[j]) & ~255) | (i << 4) | j; ++cnt;
                        if ((cnt & 15) == 0 || cnt == 50) {
                            if (cnt == 50) {
#pragma unroll
                                for (int z = 2; z < 16; ++z) Ck[z] = (int)0x80000000; }
                            tk_sort16(Ck);
                            if (cnt == 16) {
#pragma unroll
                                for (int z = 0; z < 16; ++z) Mk[z] = Ck[z]; }
                            else tk_merge16(Mk, Ck);
                        } }
                const float smax = tk_dec(Mk[0] & ~255); float ev[16], den = 0.f;
#pragma unroll
                for (int q = 0; q < 16; ++q) { ev[q] = __expf(tk_dec(Mk[q] & ~255) - smax); den += ev[q]; }
                const float inv = 1.f / den; const size_t ob = ((size_t)(u.pm * BM + ai * HALF + tid) * nheads + u.pn) * 16;
#pragma unroll
                for (int q4 = 0; q4 < 4; ++q4) { v4i_t ei; f32x4 gv;
#pragma unroll
                    for (int e = 0; e < 4; ++e) { const int k = Mk[4 * q4 + e]; ei[e] = (127 - (A[(k >> 4) & 15] & 127)) * 128 + (127 - (B[k & 15] & 127)); gv[e] = ev[4 * q4 + e] * inv; }
                    *(v4i_t*)(tki + ob + 4 * q4) = ei; *(f32x4*)(tkg + ob + 4 * q4) = gv; }
            }
            TK_BAR();
        }
    }
};

template <class Epi, class Sched, bool ALIGN_EPI = false, bool SP2 = false, bool F8 = false>
__device__ __forceinline__ void gemm_phase(PG8_LAS unsigned char* lds, const Gemm g, const Sched& S, const Epi& E) {
    int tid_ = threadIdx.x; asm volatile("" : "+v"(tid_));
    const int tid = tid_, wid = __builtin_amdgcn_readfirstlane(tid >> 6), lane = tid & 63, wr = wid >> 2, wc = wid & 3, fr = lane & 15, fq = lane >> 4;
    const int K = g.K, nt = K / BK;
    unsigned voffA[2], voffB[2];
#pragma unroll
    for (int i = 0; i < 2; ++i) { int R, C; stage_rc(tid * 16 + i * 8192, R, C); const int Rb = Epi::PERM ? ((R & ~31) + perm32(R & 31)) : R;
        voffA[i] = (unsigned)(R * K + C) * 2u; voffB[i] = (unsigned)(Rb * K + C) * 2u; }
    const size_t kstep = (size_t)(BK * 2);
    const size_t hstep = (size_t)HALF * K * 2;
    const size_t tstep = 2 * hstep;
    const unsigned ldsw = (unsigned)__builtin_amdgcn_readfirstlane((int)((unsigned)(__SIZE_TYPE__)lds + (unsigned)wid * 1024u));
    const int aoff = lds_byte(wr * 64 + fr, fq * 8), boff = lds_byte(wc * 32 + fr, fq * 8);
#define PG8_SA(b, h) (((b) * 2 + (h)) * HTB)
#define PG8_SB(b, h) ((4 + (b) * 2 + (h)) * HTB)
#define PG8_STAGE(bufoff, gbase, voff) do { _Pragma("unroll") for (int _i = 0; _i < 2; ++_i) \
        __builtin_amdgcn_global_load_lds((const unsigned*)((const char*)(gbase) + (voff)[_i]), (PG8_LAS unsigned*)(__SIZE_TYPE__)(ldsw + (unsigned)((bufoff) + _i * 8192)), 16, 0, 0); } while (0)
    PG8_LAS unsigned char* ldsA = lds + aoff; PG8_LAS unsigned char* ldsB = lds + 4 * HTB + boff; asm volatile("" : "+v"(ldsA), "+v"(ldsB));
#define PG8_LD8(p) __builtin_shufflevector(*(const PG8_LAS v4i_t*)(p), *(const PG8_LAS v4i_t*)((p) + 1024), 0, 1, 2, 3, 4, 5, 6, 7)
#define PG8_LDA(dst, b, h) do { _Pragma("unroll") for (int m = 0; m < 4; ++m) dst[m] = PG8_LD8(ldsA + ((b) * 2 + (h)) * HTB + m * 2048); } while (0)
#define PG8_LDB(dst, b, h) do { _Pragma("unroll") for (int n = 0; n < 2; ++n) dst[n] = PG8_LD8(ldsB + ((b) * 2 + (h)) * HTB + n * 2048); } while (0)
#define PG8_H(X, k) __builtin_bit_cast(bf16x8, __builtin_shufflevector(X, X, 4 * (k), 4 * (k) + 1, 4 * (k) + 2, 4 * (k) + 3))
#define PG8_MMA(ai, bj, At, Bt) do { __builtin_amdgcn_s_setprio(1); _Pragma("unroll") for (int m = 0; m < 4; ++m) _Pragma("unroll") for (int n = 0; n < 2; ++n) { \
        if constexpr (F8) asm volatile("v_mfma_scale_f32_16x16x128_f8f6f4 %0, %1, %2, %0, %3, %3 op_sel_hi:[0,0,0]" : "+v"(acc[ai][bj][m][n]) : "v"(Bt[n]), "v"(At[m]), "v"(mxs));   \
        else { acc[ai][bj][m][n] = __builtin_amdgcn_mfma_f32_16x16x32_bf16(PG8_H(Bt[n], 0), PG8_H(At[m], 0), acc[ai][bj][m][n], 0, 0, 0); \
               acc[ai][bj][m][n] = __builtin_amdgcn_mfma_f32_16x16x32_bf16(PG8_H(Bt[n], 1), PG8_H(At[m], 1), acc[ai][bj][m][n], 0, 0, 0); } } __builtin_amdgcn_s_setprio(0); } while (0)
#define PG8_WAIT_V(n) asm volatile("s_waitcnt vmcnt(" #n ")" ::: "memory")
#define PG8_WAIT_L(n) asm volatile("s_waitcnt lgkmcnt(" #n ")" ::: "memory")
#define PG8_BAR __builtin_amdgcn_s_barrier()
#define PG8_SCHED __builtin_amdgcn_sched_barrier(0)
    Unit cur, nxt; int ui = 0;
    if (!S.next(0, cur)) return;
    f32x4 acc[2][2][4][2];
#pragma unroll
    for (int a = 0; a < 2; ++a)
#pragma unroll
        for (int b = 0; b < 2; ++b)
#pragma unroll
            for (int m = 0; m < 4; ++m)
#pragma unroll
                for (int n = 0; n < 2; ++n) acc[a][b][m][n] = (f32x4){0.f, 0.f, 0.f, 0.f};
    int mxs = 0x7f7f7f7f; asm volatile("" : "+v"(mxs));
    v8i_t At[4], B0[2], B1[2];
    const char* cA = (const char*)g.A + (size_t)cur.pm * tstep; const char* cB = (const char*)g.Bt + (size_t)cur.pn * tstep;
    S.a_ready(cur);
    if constexpr (SP2) {
        PG8_STAGE(PG8_SB(0, 0), cB, voffB); PG8_STAGE(PG8_SB(0, 1), cB + hstep, voffB); PG8_STAGE(PG8_SA(0, 0), cA, voffA); PG8_STAGE(PG8_SA(0, 1), cA + hstep, voffA);
        if (wr == 1) PG8_BAR;
        PG8_WAIT_V(2); PG8_BAR;
        PG8_STAGE(PG8_SB(1, 0), cB + kstep, voffB); PG8_STAGE(PG8_SA(1, 0), cA + kstep, voffA); PG8_STAGE(PG8_SB(1, 1), cB + hstep + kstep, voffB);
        PG8_WAIT_V(6); PG8_BAR;
    } else {
        PG8_STAGE(PG8_SB(0, 0), cB, voffB); PG8_STAGE(PG8_SA(0, 0), cA, voffA); PG8_STAGE(PG8_SB(0, 1), cB + hstep, voffB); PG8_STAGE(PG8_SA(0, 1), cA + hstep, voffA);
        if (wr == 1) PG8_BAR;
        PG8_WAIT_V(4); PG8_BAR;
        PG8_STAGE(PG8_SB(1, 0), cB + kstep, voffB); PG8_STAGE(PG8_SA(1, 0), cA + kstep, voffA); PG8_STAGE(PG8_SB(1, 1), cB + hstep + kstep, voffB);
        PG8_WAIT_V(6); PG8_BAR;
    }
    for (;;) {
        const bool has_next = S.next(ui + 1, nxt);
        const char* nA = has_next ? (const char*)g.A + (size_t)nxt.pm * tstep : cA; const char* nB = has_next ? (const char*)g.Bt + (size_t)nxt.pn * tstep : cB;
        for (int t = 0; t < nt; t += 2) {
            const bool last = (t == nt - 2);
            const char* a1 = cA + (size_t)(t + 1) * kstep;
            const char* a2 = last ? nA : cA + (size_t)(t + 2) * kstep; const char* b2 = last ? nB : cB + (size_t)(t + 2) * kstep;
            const char* a3 = a2 + kstep; const char* b3 = b2 + kstep;
            if (last && has_next) S.a_ready(nxt);
            if constexpr (SP2) {
            PG8_LDB(B0, 0, 0); PG8_LDB(B1, 0, 1); PG8_SCHED; PG8_LDA(At, 0, 0); PG8_STAGE(PG8_SA(1, 1), a1 + hstep, voffA);
            PG8_WAIT_V(8); PG8_WAIT_L(0); PG8_BAR; PG8_MMA(0, 0, At, B0); PG8_MMA(0, 1, At, B1); PG8_BAR; PG8_SCHED;
            PG8_LDA(At, 0, 1); PG8_STAGE(PG8_SB(0, 0), b2, voffB); PG8_STAGE(PG8_SB(0, 1), b2 + hstep, voffB); PG8_STAGE(PG8_SA(0, 0), a2, voffA);
            PG8_WAIT_V(8); PG8_WAIT_L(0); PG8_BAR; PG8_MMA(1, 0, At, B0); PG8_MMA(1, 1, At, B1); PG8_BAR; PG8_SCHED;
            PG8_LDB(B0, 1, 0); PG8_LDB(B1, 1, 1); PG8_SCHED; PG8_LDA(At, 1, 0); PG8_STAGE(PG8_SA(0, 1), a2 + hstep, voffA);
            PG8_WAIT_V(8); PG8_WAIT_L(0); PG8_BAR; PG8_MMA(0, 0, At, B0); PG8_MMA(0, 1, At, B1); PG8_BAR; PG8_SCHED;
            PG8_LDA(At, 1, 1); PG8_STAGE(PG8_SB(1, 0), b3, voffB); PG8_STAGE(PG8_SB(1, 1), b3 + hstep, voffB); PG8_STAGE(PG8_SA(1, 0), a3, voffA);
            PG8_WAIT_V(8); PG8_WAIT_L(0); PG8_BAR; PG8_MMA(1, 0, At, B0); PG8_MMA(1, 1, At, B1); PG8_BAR; PG8_SCHED;
            } else {
            PG8_LDB(B0, 0, 0); PG8_SCHED; PG8_LDA(At, 0, 0); PG8_STAGE(PG8_SA(1, 1), a1 + hstep, voffA);
            PG8_WAIT_L(8); PG8_BAR; PG8_WAIT_L(0); PG8_MMA(0, 0, At, B0); PG8_BAR; PG8_SCHED;
            PG8_LDB(B1, 0, 1); PG8_STAGE(PG8_SB(0, 0), b2, voffB);
            PG8_BAR; PG8_WAIT_L(0); PG8_MMA(0, 1, At, B1); PG8_BAR;
            PG8_LDA(At, 0, 1); PG8_STAGE(PG8_SA(0, 0), a2, voffA);
            PG8_BAR; PG8_WAIT_L(0); PG8_MMA(1, 0, At, B0); PG8_BAR; PG8_SCHED;
            PG8_STAGE(PG8_SB(0, 1), b2 + hstep, voffB);
            PG8_WAIT_V(6); PG8_BAR; PG8_MMA(1, 1, At, B1); PG8_BAR;
            PG8_LDB(B0, 1, 0); PG8_SCHED; PG8_LDA(At, 1, 0); PG8_STAGE(PG8_SA(0, 1), a2 + hstep, voffA);
            PG8_WAIT_L(8); PG8_BAR; PG8_WAIT_L(0); PG8_MMA(0, 0, At, B0); PG8_BAR; PG8_SCHED;
            PG8_LDB(B1, 1, 1); PG8_STAGE(PG8_SB(1, 0), b3, voffB);
            PG8_BAR; PG8_WAIT_L(0); PG8_MMA(0, 1, At, B1); PG8_BAR;
            PG8_LDA(At, 1, 1); PG8_STAGE(PG8_SA(1, 0), a3, voffA);
            PG8_BAR; PG8_WAIT_L(0); PG8_MMA(1, 0, At, B0); PG8_BAR; PG8_SCHED;
            PG8_STAGE(PG8_SB(1, 1), b3 + hstep, voffB);
            PG8_WAIT_V(6); PG8_BAR; PG8_MMA(1, 1, At, B1); PG8_BAR;
            }
        }
        if constexpr (F8) asm volatile("s_nop 15\n\ts_nop 7" ::: "memory");
        if constexpr (ALIGN_EPI) { if (wr == 0) PG8_BAR; }
        if constexpr (!Epi::AFTER_DRAIN) { E(acc, cur, wr, wc, fr, fq); S.done(cur); }
        if (!has_next) break;
#pragma unroll
        for (int a = 0; a < 2; ++a)
#pragma unroll
            for (int b = 0; b < 2; ++b)
#pragma unroll
                for (int m = 0; m < 4; ++m)
#pragma unroll
                    for (int n = 0; n < 2; ++n) acc[a][b][m][n] = (f32x4){0.f, 0.f, 0.f, 0.f};
        cur = nxt; cA = nA; cB = nB; ++ui;
        if constexpr (ALIGN_EPI) { if (wr == 1) PG8_BAR; }
    }
    PG8_WAIT_V(0);
    if constexpr (!ALIGN_EPI) { if (wr == 0) PG8_BAR; }
    PG8_BAR;
    if constexpr (Epi::AFTER_DRAIN) { E.fused(acc, cur, wr, wc, fr, fq, lds, wid, lane); S.done(cur); }
#undef PG8_SA
#undef PG8_SB
#undef PG8_STAGE
#undef PG8_LDA
#undef PG8_LDB
#undef PG8_MMA
#undef PG8_H
#undef PG8_LD8
#undef PG8_WAIT_V
#undef PG8_WAIT_L
#undef PG8_BAR
#undef PG8_SCHED
}
}
#define GAS __attribute__((address_space(1)))
#define LAS __attribute__((address_space(3)))
#define XB_TMO      128
#define XB_XCNT(j)  (256  + 64 * (j))
#define XB_XSUB(j)  (1280 + 64 * (j))
#define XB_XGEN(j)  (2304 + 64 * (j))
#define XB_TOP      3328
#define XB_TOPGEN   3392
#define XCD_BAR_WORDS 3456
#define XB_SPIN_CAP (1u << 18)

__device__ __forceinline__ unsigned xb_ld(unsigned* p)              { return __hip_atomic_load(p, __ATOMIC_RELAXED, __HIP_MEMORY_SCOPE_AGENT); }
__device__ __forceinline__ unsigned xb_add(unsigned* p, unsigned v) { return __hip_atomic_fetch_add(p, v, __ATOMIC_RELAXED, __HIP_MEMORY_SCOPE_AGENT); }
__device__ __forceinline__ unsigned xb_xcc_id() { return (unsigned)__builtin_amdgcn_s_getreg((3 << 11) | 20) & 0xFu; }
#define XB_SPIN(cond, bar) do { unsigned _sp = 0; while (cond) { __builtin_amdgcn_s_sleep(1); \
    if ((++_sp & 255u) == 0u) { if (xb_ld(&(bar)[XB_TMO])) break; if (_sp > XB_SPIN_CAP) { atomicAdd(&(bar)[XB_TMO], 1u); break; } } } } while (0)

struct XcdBarrier {
    unsigned* bar; unsigned x;
    volatile LAS unsigned* st;
};

__device__ __forceinline__ XcdBarrier xcd_barrier_post(unsigned* bar, volatile LAS unsigned* st) {
    XcdBarrier b; b.bar = bar; b.x = xb_xcc_id(); b.st = st;
    if (threadIdx.x == 0) (void)xb_add(&bar[XB_XCNT(b.x)], 1u);
    return b;
}
__device__ __forceinline__ void xcd_barrier_complete(unsigned* bar, unsigned x, unsigned& nloc, unsigned& nx) {
    const unsigned G = gridDim.x * gridDim.y * gridDim.z;
    unsigned sum, cnt, mine, sp = 0u;
    for (;;) {
        sum = 0u; cnt = 0u; mine = 0u;
#pragma unroll
        for (unsigned j = 0; j < 16; ++j) { const unsigned c = xb_ld(&bar[XB_XCNT(j)]); sum += c; cnt += (c > 0u) ? 1u : 0u; mine = (j == x) ? c : mine; }
        if (sum == G) break;
        __builtin_amdgcn_s_sleep(1);
        if ((++sp & 255u) == 0u) { if (xb_ld(&bar[XB_TMO])) break; if (sp > XB_SPIN_CAP) { atomicAdd(&bar[XB_TMO], 1u); break; } }
    }
    nloc = mine > 0u ? mine : 1u; nx = cnt > 0u ? cnt : 1u;
}

__device__ __forceinline__ void xcd_barrier(const XcdBarrier& b) {
    asm volatile("s_waitcnt vmcnt(0)" ::: "memory");
    __syncthreads();
    if (threadIdx.x == 0) {
        unsigned* bar = b.bar;
        __builtin_amdgcn_s_waitcnt(0);
        unsigned nloc = b.st[0], nx = b.st[1];
        if (nloc == 0u) { xcd_barrier_complete(bar, b.x, nloc, nx); b.st[0] = nloc; b.st[1] = nx; }
        const unsigned old = xb_add(&bar[XB_XSUB(b.x)], 1u);
        const unsigned gen = old / nloc;
        if (old + 1u == (gen + 1u) * nloc) {
            __builtin_amdgcn_fence(__ATOMIC_RELEASE, "agent");
            asm volatile("s_waitcnt vmcnt(0)" ::: "memory");
            const unsigned og = xb_add(&bar[XB_TOP], 1u);
            const unsigned tg = og / nx;
            if (og + 1u == (tg + 1u) * nx) xb_add(&bar[XB_TOPGEN], 1u);
            else XB_SPIN(xb_ld(&bar[XB_TOPGEN]) == tg, bar);
            __builtin_amdgcn_fence(__ATOMIC_ACQUIRE, "agent");
            xb_add(&bar[XB_XGEN(b.x)], 1u);
            asm volatile("s_waitcnt vmcnt(0)" ::: "memory");
        } else {
            XB_SPIN(xb_ld(&bar[XB_XGEN(b.x)]) == gen, bar);
            __builtin_amdgcn_fence(__ATOMIC_ACQUIRE, "agent");
            asm volatile("s_waitcnt vmcnt(0)" ::: "memory");
        }
    }
    __syncthreads();
}

#ifndef MK_SPLIT
#define MK_SPLIT 0
#endif
#ifndef P8_NP
#define P8_NP 4
#endif
constexpr int NWAVES = 8;
constexpr int NB = 2, SEQ = 4096, DM = 2048, T = NB * SEQ, HD = 128;
constexpr int INW = 10240;
constexpr int C_QA = 0, C_KA = 1024, C_VA = 1280, C_QB = 1536, C_KB = 3072, C_VB = 4608, C_GA = 6144, C_GB = 8192;
constexpr int AQW = 1024, BOW = 512;
constexpr int NEXP = 16384, PHEADS = 8, NKEYS = 128, TOPK = 16;
constexpr int NBIAS = 20;
constexpr float EPS = 1e-6f;
constexpr float SM_SCALE = 0.088388347648318440f;
constexpr float LOG2E = 1.4426950408889634f;
constexpr float A_SCALE = 16.f;
constexpr float M_SCALE = 64.f;
constexpr float W_SCALE = 512.f;

constexpr size_t MiB = 1u << 20;
constexpr size_t WS_CTL = 0, CTL_ZERO_BYTES = 16384;
constexpr size_t WS_WIN = 1 * MiB;
constexpr size_t WS_WOA = 41 * MiB;
constexpr size_t WS_WOB = 45 * MiB;
constexpr size_t WS_WOUT = 47 * MiB;
constexpr size_t WS_W2 = 55 * MiB;
constexpr size_t WS_U = 63 * MiB;
constexpr size_t WS_V = 95 * MiB;
constexpr size_t WS_ESC = 127 * MiB;
constexpr size_t WS_PROJ = 191 * MiB;
constexpr size_t WS_SC = WS_PROJ;
constexpr size_t WS_H = 351 * MiB;
constexpr size_t WS_MRG = WS_H;
constexpr size_t WS_ATTA = 383 * MiB;
constexpr size_t WS_OB = 399 * MiB;
constexpr size_t WS_X1B = WS_ATTA;
constexpr size_t WS_ATTB = 423 * MiB;
constexpr size_t WS_LSE = 431 * MiB;
constexpr size_t WS_PART = 432 * MiB;
constexpr size_t WS_TKI = 433 * MiB;
constexpr size_t WS_TKG = 437 * MiB;
constexpr size_t WS_MRG8 = 441 * MiB;
constexpr size_t WS_END = 457 * MiB;
constexpr int CW_BAR = 0;

constexpr int RING_OFF = 0, RING_BYTES = 131072;
constexpr int LDSCTL_OFF = RING_BYTES, MISC_OFF = LDSCTL_OFF + 320;
constexpr int RSTD_OFF = RING_BYTES + 1024;
constexpr int LDS_BYTES = 147456;
static_assert(RSTD_OFF + 1024 <= LDS_BYTES && XCD_BAR_WORDS * 4 <= (int)CTL_ZERO_BYTES, "maps");

typedef unsigned short bf16;
typedef unsigned v4u __attribute__((ext_vector_type(4)));
typedef unsigned v2u __attribute__((ext_vector_type(2)));
typedef float f32x4 __attribute__((ext_vector_type(4)));
typedef float f32x16 __attribute__((ext_vector_type(16)));
typedef short bf16x8 __attribute__((ext_vector_type(8)));
typedef short s16x4 __attribute__((ext_vector_type(4)));
typedef __bf16 bf16x2 __attribute__((ext_vector_type(2)));
#define LDS_WAIT() asm volatile("s_waitcnt lgkmcnt(0)" ::: "memory")
#define VM_WAIT() asm volatile("s_waitcnt vmcnt(0)" ::: "memory")
#define SBAR() __builtin_amdgcn_sched_barrier(0)
__device__ __forceinline__ unsigned cvtpk(float lo, float hi) { unsigned r; asm volatile("v_cvt_pk_bf16_f32 %0, %1, %2" : "=v"(r) : "v"(lo), "v"(hi)); return r; }
__device__ __forceinline__ float bflo(unsigned w) { return __builtin_bit_cast(float, w << 16); }
__device__ __forceinline__ float bfhi(unsigned w) { return __builtin_bit_cast(float, w & 0xffff0000u); }
__device__ __forceinline__ float dot2_bf16(unsigned w, unsigned x, float acc) { return __builtin_amdgcn_fdot2_f32_bf16(__builtin_bit_cast(bf16x2, w), __builtin_bit_cast(bf16x2, x), acc, false); }
__device__ __forceinline__ float wave_sum(float v) {
#pragma unroll
    for (int o = 1; o < 64; o <<= 1) v += __shfl_xor(v, o);
    return v;
}

struct Lane { int tid, lane, wave, gw; };
__device__ __forceinline__ Lane lane_state() { int t = threadIdx.x; asm volatile("" : "+v"(t)); Lane L; L.tid = t; L.lane = t & 63; L.wave = __builtin_amdgcn_readfirstlane(t >> 6); L.gw = blockIdx.x * 8 + L.wave; return L; }
struct Frame {
    LAS unsigned char* lds; char* ldsg;
    int G, NGW;
    const float *x, *rel_bias, *g_mix, *w_in, *sink_a, *w_oa, *w_ob, *w_out, *g_ffn, *w_pq, *keys, *eu, *ev, *g_fin;
    float* out; unsigned char* ws;
};

__device__ __forceinline__ unsigned pk4_fp8(float a, float b, float c, float d) { int p = __builtin_amdgcn_cvt_pk_fp8_f32(fminf(fmaxf(a, -448.f), 448.f), fminf(fmaxf(b, -448.f), 448.f), 0, false);
    return (unsigned)__builtin_amdgcn_cvt_pk_fp8_f32(fminf(fmaxf(c, -448.f), 448.f), fminf(fmaxf(d, -448.f), 448.f), p, true); }
__device__ __forceinline__ void p0_transpose_item_f8(const float* W, int K, int N, unsigned char* WT, float scale, LAS float* scr, int item, int lane) {
    const int nblk = N / 32, kb = item / nblk, nb = item % nblk, k0 = 64 * kb, n0 = 32 * nb;
    { f32x4 v[8];
#pragma unroll
      for (int i = 0; i < 8; ++i) v[i] = *(const f32x4*)(W + (size_t)(k0 + 8 * i + (lane >> 3)) * N + n0 + 4 * (lane & 7));
#pragma unroll
      for (int i = 0; i < 8; ++i) { LAS float* d = scr + (8 * i + (lane >> 3)) * 33 + 4 * (lane & 7); d[0] = v[i][0] * scale; d[1] = v[i][1] * scale; d[2] = v[i][2] * scale; d[3] = v[i][3] * scale; } }
    LDS_WAIT(); asm volatile("" ::: "memory");
    const int c = lane & 7;
#pragma unroll
    for (int j = 0; j < 4; ++j) { const int n = (lane >> 3) + 8 * j; const LAS float* s = scr + (8 * c) * 33 + n;
        v2u o; o.x = pk4_fp8(s[0 * 33], s[1 * 33], s[2 * 33], s[3 * 33]); o.y = pk4_fp8(s[4 * 33], s[5 * 33], s[6 * 33], s[7 * 33]);
        *(v2u*)(WT + (size_t)(n0 + n) * K + k0 + 8 * c) = o; }
    LDS_WAIT(); asm volatile("" ::: "memory");
}
__device__ __forceinline__ void p0_transpose_item(const float* W, int K, int N, bf16* WT, LAS float* scr, int item, int lane) {
    const int nblk = N / 32, kb = item / nblk, nb = item % nblk, k0 = 64 * kb, n0 = 32 * nb;
    { f32x4 v[8];
#pragma unroll
      for (int i = 0; i < 8; ++i) v[i] = *(const f32x4*)(W + (size_t)(k0 + 8 * i + (lane >> 3)) * N + n0 + 4 * (lane & 7));
#pragma unroll
      for (int i = 0; i < 8; ++i) { LAS float* d = scr + (8 * i + (lane >> 3)) * 33 + 4 * (lane & 7); d[0] = v[i][0]; d[1] = v[i][1]; d[2] = v[i][2]; d[3] = v[i][3]; } }
    LDS_WAIT(); asm volatile("" ::: "memory");
    const int c = lane & 7;
#pragma unroll
    for (int j = 0; j < 4; ++j) { const int n = (lane >> 3) + 8 * j; const LAS float* s = scr + (8 * c) * 33 + n;
        v4u o; o.x = cvtpk(s[0 * 33], s[1 * 33]); o.y = cvtpk(s[2 * 33], s[3 * 33]); o.z = cvtpk(s[4 * 33], s[5 * 33]); o.w = cvtpk(s[6 * 33], s[7 * 33]);
        *(v4u*)(WT + (size_t)(n0 + n) * K + k0 + 8 * c) = o; }
    LDS_WAIT(); asm volatile("" ::: "memory");
}
__device__ __forceinline__ void p0_w2_item(Frame& F, bf16* W2T, int item, int tid) {
    const int hc = item >> 5, j0 = (item & 31) * 64;
    LAS float* Ks = (LAS float*)F.lds; LAS float* Ws = Ks + 128 * 129;
    const f32x4* kp = (const f32x4*)(F.keys + (size_t)hc * 16384);
#pragma unroll
    for (int q = 0; q < 8; ++q) { const int idx = tid + 512 * q, row = idx >> 5, c4 = idx & 31; const f32x4 v = kp[idx];
        LAS float* d = Ks + row * 129 + c4 * 4; d[0] = v[0]; d[1] = v[1]; d[2] = v[2]; d[3] = v[3]; }
#pragma unroll
    for (int q = 0; q < 4; ++q) { const int idx = tid + 512 * q, row = idx >> 5, c4 = idx & 31; const f32x4 v = *(const f32x4*)(F.w_pq + (size_t)(j0 + row) * DM + hc * 128 + c4 * 4);
        LAS float* d = Ws + row * 129 + c4 * 4; d[0] = v[0]; d[1] = v[1]; d[2] = v[2]; d[3] = v[3]; }
    __syncthreads();
    { const int wv = tid >> 6, ln = tid & 63, kt = wv & 3, jt = wv >> 2, r = ln & 31, h2 = ln >> 5;
      const LAS float* ap = Ks + (kt * 32 + r) * 129 + h2; const LAS float* bp = Ws + (jt * 32 + r) * 129 + h2;
      f32x16 acc = {};
#pragma unroll 8
      for (int d0 = 0; d0 < 128; d0 += 2) acc = __builtin_amdgcn_mfma_f32_32x32x2f32(ap[d0], bp[d0], acc, 0, 0, 0);
      const int j = j0 + jt * 32 + r; const float g = F.g_ffn[j];
#pragma unroll
      for (int q = 0; q < 16; ++q) { const int k = kt * 32 + (q & 3) + 8 * (q >> 2) + 4 * h2; const float v = acc[q] * g;
          W2T[(size_t)(hc * 128 + k) * DM + j] = (bf16)(cvtpk(v, v) & 0xffffu); } }
    __syncthreads();
}
__device__ __forceinline__ void p0_prologue(Frame& F) {
    const Lane Ls = lane_state();
    LAS float* scr = (LAS float*)(F.lds + RING_OFF + Ls.wave * 16384);
    bf16* WinT = (bf16*)(F.ws + WS_WIN); bf16* WoaT = (bf16*)(F.ws + WS_WOA); bf16* WobT = (bf16*)(F.ws + WS_WOB); bf16* WoutT = (bf16*)(F.ws + WS_WOUT);
    constexpr int I_IN = (DM / 64) * (INW / 32), I_OA = (AQW / 64) * (DM / 32), I_OB = (BOW / 64) * (DM / 32), I_OUT = (DM / 64) * (DM / 32);
    constexpr int NITEMS = I_IN + I_OA + I_OB + I_OUT;
    for (int it = Ls.gw; it < NITEMS; it += F.NGW) {
        int r = it;
        if (r < I_IN) { p0_transpose_item_f8(F.w_in, DM, INW, (unsigned char*)WinT, W_SCALE, scr, r, Ls.lane); continue; } r -= I_IN;
        if (r < I_OA) { p0_transpose_item_f8(F.w_oa, AQW, DM, (unsigned char*)WoaT, W_SCALE, scr, r, Ls.lane); continue; } r -= I_OA;
        if (r < I_OB) { p0_transpose_item_f8(F.w_ob, BOW, DM, (unsigned char*)WobT, W_SCALE, scr, r, Ls.lane); continue; } r -= I_OB;
        p0_transpose_item_f8(F.w_out, DM, DM, (unsigned char*)WoutT, W_SCALE, scr, r, Ls.lane);
    }
    __syncthreads();
    for (int it = blockIdx.x; it < 512; it += F.G) p0_w2_item(F, (bf16*)(F.ws + WS_W2), it, Ls.tid);
    { unsigned char* U8 = F.ws + WS_U; float* esc = (float*)(F.ws + WS_ESC);
      static_assert(WS_V == WS_U + (size_t)NEXP * DM, "table map");
      for (int row = Ls.gw; row < 2 * NEXP; row += F.NGW) {
          const float* src = row < NEXP ? F.eu + (size_t)row * DM : F.ev + (size_t)(row - NEXP) * DM;
          f32x4 v[8]; float am = 0.f;
#pragma unroll
          for (int jj = 0; jj < 2; ++jj)
#pragma unroll
              for (int q = 0; q < 4; ++q) { v[4 * jj + q] = *(const f32x4*)(src + 1024 * jj + 16 * Ls.lane + 4 * q);
                  am = fmaxf(am, fmaxf(fmaxf(fabsf(v[4 * jj + q][0]), fabsf(v[4 * jj + q][1])), fmaxf(fabsf(v[4 * jj + q][2]), fabsf(v[4 * jj + q][3])))); }
#pragma unroll
          for (int o = 1; o < 64; o <<= 1) am = fmaxf(am, __shfl_xor(am, o));
          const float inv = am > 0.f ? 400.f / am : 0.f;
#pragma unroll
          for (int jj = 0; jj < 2; ++jj) { v4u w;
#pragma unroll
              for (int q = 0; q < 4; ++q) { const f32x4 t = v[4 * jj + q] * inv; int pk = __builtin_amdgcn_cvt_pk_fp8_f32(t[0], t[1], 0, false); pk = __builtin_amdgcn_cvt_pk_fp8_f32(t[2], t[3], pk, true); w[q] = (unsigned)pk; }
              { const int d0 = 1024 * jj + 16 * Ls.lane, P8_PBc = 2048 / P8_NP;
                *(v4u*)(U8 + (size_t)(row >= NEXP) * ((size_t)NEXP * DM) + (size_t)(d0 / P8_PBc) * ((size_t)NEXP * P8_PBc) + (size_t)(row & (NEXP - 1)) * P8_PBc + (d0 % P8_PBc)) = w; } }
          if (Ls.lane == 0) esc[row] = am * (1.f / 400.f);
      } }
    { bf16* Hb = (bf16*)(F.ws + WS_H);
      for (int m = Ls.gw; m < T; m += F.NGW) {
          const f32x4* xr = (const f32x4*)(F.x + (size_t)m * DM) + Ls.lane; f32x4 v[8]; float s = 0.f;
#pragma unroll
          for (int j = 0; j < 8; ++j) { v[j] = xr[64 * j]; s += (v[j][0] * v[j][0] + v[j][1] * v[j][1]) + (v[j][2] * v[j][2] + v[j][3] * v[j][3]); }
          const float rstd = rsqrtf(wave_sum(s) * (1.f / DM) + EPS);
          unsigned* o4 = (unsigned*)((unsigned char*)Hb + (size_t)m * DM) + Ls.lane;
#pragma unroll
          for (int j = 0; j < 8; ++j) { const f32x4 g = ((const f32x4*)F.g_mix)[Ls.lane + 64 * j];
              o4[64 * j] = pk4_fp8(v[j][0] * rstd * g[0], v[j][1] * rstd * g[1], v[j][2] * rstd * g[2], v[j][3] * rstd * g[3]); } } }
}

namespace att {
#define KSWZ(row, colB) ((row) * 256 + ((colB) ^ (((row) & 7) << 4)))
__device__ __forceinline__ int crow(int r, int hi) { return (r & 3) + 8 * (r >> 2) + 4 * hi; }
__device__ __forceinline__ void qkt(f32x16& p0, f32x16& p1, const char* Ks, const bf16x8* qr, int r32, int hi) {
    p0 = f32x16{}; p1 = f32x16{};
#pragma unroll
    for (int d0 = 0; d0 < 8; ++d0) { const int cb = (d0 * 16 + hi * 8) * 2;
        const bf16x8 b0 = *reinterpret_cast<const bf16x8*>(Ks + KSWZ(r32, cb));
        const bf16x8 b1 = *reinterpret_cast<const bf16x8*>(Ks + KSWZ(32 + r32, cb));
        p0 = __builtin_amdgcn_mfma_f32_32x32x16_bf16(b0, qr[d0], p0, 0, 0, 0);
        p1 = __builtin_amdgcn_mfma_f32_32x32x16_bf16(b1, qr[d0], p1, 0, 0, 0); }
}
__device__ __forceinline__ int v_st(int k, int c) { const int kk = (k & ~0xC) | ((k & 4) << 1) | ((k & 8) >> 1); return ((kk >> 3) * 4 + (c >> 5)) * 512 + ((kk & 7) * 32 + (c & 31)) * 2; }
__device__ __forceinline__ int v_rd_base(int lane) { return ((lane & 3) << 3) | (((lane >> 2) & 3) << 6) | (((lane >> 4) & 1) << 5) | (((lane >> 5) & 1) << 8); }
constexpr int v_rd_off(int d0, int ks, int half) { return d0 * 512 + ks * 4096 + half * 2048; }
template <int OFF> __device__ __forceinline__ s16x4 tr_read(int vb) {
    s16x4 r; asm volatile("ds_read_b64_tr_b16 %0, %1 offset:%2" : "=&v"(r) : "v"(vb), "i"(OFF) : "memory"); return r;
}
template <int D0> __device__ __forceinline__ void pv_one(f32x16& od, int vb, bf16x8 pa0, bf16x8 pa1, bf16x8 pa2, bf16x8 pa3) {
    const s16x4 l0 = tr_read<v_rd_off(D0, 0, 0)>(vb), h0 = tr_read<v_rd_off(D0, 0, 1)>(vb), l1 = tr_read<v_rd_off(D0, 1, 0)>(vb), h1 = tr_read<v_rd_off(D0, 1, 1)>(vb);
    const s16x4 l2 = tr_read<v_rd_off(D0, 2, 0)>(vb), h2 = tr_read<v_rd_off(D0, 2, 1)>(vb), l3 = tr_read<v_rd_off(D0, 3, 0)>(vb), h3 = tr_read<v_rd_off(D0, 3, 1)>(vb);
    asm volatile("s_waitcnt lgkmcnt(0)" ::: "memory"); SBAR();
#define PK(L, H) (bf16x8){L[0], L[1], L[2], L[3], H[0], H[1], H[2], H[3]}
    od = __builtin_amdgcn_mfma_f32_32x32x16_bf16(pa0, PK(l0, h0), od, 0, 0, 0);
    od = __builtin_amdgcn_mfma_f32_32x32x16_bf16(pa1, PK(l1, h1), od, 0, 0, 0);
    od = __builtin_amdgcn_mfma_f32_32x32x16_bf16(pa2, PK(l2, h2), od, 0, 0, 0);
    od = __builtin_amdgcn_mfma_f32_32x32x16_bf16(pa3, PK(l3, h3), od, 0, 0, 0);
#undef PK
}
__device__ __forceinline__ void pv_d0(f32x16* o, int vb, bf16x8 pa0, bf16x8 pa1, bf16x8 pa2, bf16x8 pa3) {
    pv_one<0>(o[0], vb, pa0, pa1, pa2, pa3); pv_one<1>(o[1], vb, pa0, pa1, pa2, pa3); pv_one<2>(o[2], vb, pa0, pa1, pa2, pa3); pv_one<3>(o[3], vb, pa0, pa1, pa2, pa3);
}
__device__ __forceinline__ int t5_bucket(int rel) {
    const int n = rel < 0 ? -rel : rel; int b;
    if (n < 8) b = n; else { b = 8 + (n >= 15) + (n >= 27) + (n >= 50) + (n >= 91) + (n >= 166) + (n >= 305) + (n >= 559); b = b > 15 ? 15 : b; }
    return b + (rel > 0 ? 16 : 0);
}
constexpr int ATT_WS_OFF = RSTD_OFF + 1024, ATT_BT_OFF = ATT_WS_OFF + 2048;
static_assert(ATT_BT_OFF + 2 * 1040 <= LDS_BYTES, "attention scratch above the stage region");
template <int W, bool SINK>
__device__ __forceinline__ void attn_unit(char* lds, const bf16* proj, int b, int qcol, int kcol, int vcol, int d, int r, int m0u,
                                          const float* bias_col, float sinkv, bf16* O, int ldo, int ocol, float* lse, int lse_j) {
    int tid_ = threadIdx.x; asm volatile("" : "+v"(tid_));
    const int tid = tid_, wid = __builtin_amdgcn_readfirstlane(tid >> 6), lane = tid & 63, r32 = lane & 31, hi = lane >> 5;
    const int hh = wid >> 2, wq = wid & 3, htid = tid & 255;
    constexpr int NT = (128 + 2 * W) / 64;
    const int L = SEQ / d, m0 = m0u + 128 * hh;
    char* hbase = lds + hh * 65536;
    float* ws = (float*)(lds + ATT_WS_OFF) + wid * 64; float* li_l = ws; float* al_l = ws + 32;
    float* btab = (float*)(lds + ATT_BT_OFF + hh * 1040);
    __syncthreads();
    for (int i = htid; i <= 2 * W; i += 256) btab[i] = bias_col[t5_bucket((i - W) * d) * NBIAS];
    const int qm = m0 + wq * 32 + r32;
    const size_t tok0 = (size_t)b * SEQ + r;
    bf16x8 qr[8];
    { const bf16* Qw = proj + (tok0 + (size_t)qm * d) * INW + qcol + hi * 8;
#pragma unroll
      for (int d0 = 0; d0 < 8; ++d0) qr[d0] = *reinterpret_cast<const bf16x8*>(Qw + d0 * 16); }
    float m_run = SINK ? sinkv : -1e29f, l_run = SINK ? 1.f : 0.f;
    f32x16 o[4] = {};
    const int sr = htid >> 4, sc = (htid & 15) * 8;
    const int t_lo = wq >> 1, t_hi = (32 * wq + 31 + 2 * W) >> 6;
    bf16x8 vs[4], ks[4];
#define SLOAD(t) do { const int tm = m0 - W + 64 * (t); if (tm + 63 >= 0 && tm < L) { _Pragma("unroll") for (int i_ = 0; i_ < 4; ++i_) { int k_ = tm + sr + 16 * i_; k_ = k_ < 0 ? 0 : (k_ > L - 1 ? L - 1 : k_); \
        const bf16* p_ = proj + (tok0 + (size_t)k_ * d) * INW + sc; vs[i_] = *reinterpret_cast<const bf16x8*>(p_ + vcol); ks[i_] = *reinterpret_cast<const bf16x8*>(p_ + kcol); } } } while (0)
#define SWRITE(t) do { const int tm = m0 - W + 64 * (t); if (tm + 63 >= 0 && tm < L) { char* vb_ = hbase + ((t) & 1) * 32768; char* kb_ = vb_ + 16384; _Pragma("unroll") for (int i_ = 0; i_ < 4; ++i_) { \
        *(bf16x8*)(vb_ + v_st(sr + 16 * i_, sc)) = vs[i_]; *(bf16x8*)(kb_ + KSWZ(sr + 16 * i_, sc * 2)) = ks[i_]; } } } while (0)
    SLOAD(0);
#pragma unroll 1
    for (int t = 0; t < NT; ++t) {
        SWRITE(t);
        __syncthreads();
        if (t + 1 < NT) SLOAD(t + 1);
        const int tm0 = m0 - W + 64 * t;
        if (t >= t_lo && t <= t_hi && tm0 + 63 >= 0 && tm0 < L) {
            const char* V_lds = hbase + (t & 1) * 32768; const char* K_lds = V_lds + 16384;
            const int vb0 = (int)(uintptr_t)V_lds + v_rd_base(lane);
            f32x16 p0, p1; qkt(p0, p1, K_lds, qr, r32, hi);
            const int base = tm0 - qm + W;
            float pmax = -1e30f;
#pragma unroll
            for (int q = 0; q < 16; ++q) { const int key = crow(q, hi), idx = base + key, km = tm0 + key;
                const bool ok = (unsigned)idx <= (unsigned)(2 * W) && (unsigned)km < (unsigned)L;
                const float bv = btab[ok ? idx : 0]; const float s = ok ? fmaf(p0[q], SM_SCALE, bv) : -1e30f; p0[q] = s; pmax = fmaxf(pmax, s); }
#pragma unroll
            for (int q = 0; q < 16; ++q) { const int key = 32 + crow(q, hi), idx = base + key, km = tm0 + key;
                const bool ok = (unsigned)idx <= (unsigned)(2 * W) && (unsigned)km < (unsigned)L;
                const float bv = btab[ok ? idx : 0]; const float s = ok ? fmaf(p1[q], SM_SCALE, bv) : -1e30f; p1[q] = s; pmax = fmaxf(pmax, s); }
            { auto rr = __builtin_amdgcn_permlane32_swap(__float_as_uint(pmax), __float_as_uint(pmax), false, false);
              pmax = fmaxf(__uint_as_float(rr[0]), __uint_as_float(rr[1])); }
            const float mn = fmaxf(m_run, pmax), alpha = __builtin_amdgcn_exp2f((m_run - mn) * LOG2E); m_run = mn;
            const float mnc = -mn * LOG2E; float ps = 0.f;
#pragma unroll
            for (int q = 0; q < 16; ++q) { p0[q] = __builtin_amdgcn_exp2f(fmaf(p0[q], LOG2E, mnc)); ps += p0[q]; }
#pragma unroll
            for (int q = 0; q < 16; ++q) { p1[q] = __builtin_amdgcn_exp2f(fmaf(p1[q], LOG2E, mnc)); ps += p1[q]; }
            { auto rr = __builtin_amdgcn_permlane32_swap(__float_as_uint(ps), __float_as_uint(ps), false, false);
              ps = __uint_as_float(rr[0]) + __uint_as_float(rr[1]); }
            l_run = l_run * alpha + ps;
            if (__any(alpha < 1.f)) { if (hi == 0) al_l[r32] = alpha; asm volatile("s_waitcnt lgkmcnt(0)" ::: "memory");
#pragma unroll
                for (int dd = 0; dd < 4; ++dd)
#pragma unroll
                    for (int q = 0; q < 16; ++q) o[dd][q] *= al_l[crow(q, hi)]; }
            bf16x8 pa0, pa1, pa2, pa3;
#define PK4(P, BASE, OUT) do { unsigned a0 = cvtpk(P[BASE + 0], P[BASE + 1]), a1 = cvtpk(P[BASE + 2], P[BASE + 3]);   \
    unsigned b0 = cvtpk(P[BASE + 4], P[BASE + 5]), b1 = cvtpk(P[BASE + 6], P[BASE + 7]);                              \
    auto r0 = __builtin_amdgcn_permlane32_swap(a0, b0, false, false); auto r1 = __builtin_amdgcn_permlane32_swap(a1, b1, false, false); \
    v4u w = {r0[0], r1[0], r0[1], r1[1]}; OUT = *reinterpret_cast<bf16x8*>(&w); } while (0)
            PK4(p0, 0, pa0); PK4(p0, 8, pa1); PK4(p1, 0, pa2); PK4(p1, 8, pa3);
#undef PK4
            pv_d0(o, vb0, pa0, pa1, pa2, pa3);
        }
    }
#undef SLOAD
#undef SWRITE
    if (hi == 0) li_l[r32] = l_run; asm volatile("s_waitcnt lgkmcnt(0)" ::: "memory");
    if (!SINK && hi == 0) lse[(tok0 + (size_t)qm * d) * 4 + lse_j] = m_run + __logf(l_run);
    __syncthreads();
    if constexpr (SINK) {
      char* ost = lds + wid * 8704; unsigned char* O8 = (unsigned char*)O;
#pragma unroll
      for (int q = 0; q < 16; ++q) { const float rl = __builtin_amdgcn_rcpf(li_l[crow(q, hi)]) * A_SCALE; unsigned char* orow = (unsigned char*)(ost + crow(q, hi) * 144) + r32;
#pragma unroll
          for (int dd = 0; dd < 4; ++dd) { const float v = fminf(fmaxf(o[dd][q] * rl, -448.f), 448.f); orow[dd * 32] = (unsigned char)(__builtin_amdgcn_cvt_pk_fp8_f32(v, v, 0, false) & 0xff); } }
      asm volatile("s_waitcnt lgkmcnt(0)" ::: "memory");
      const int rr = lane >> 3, cc = lane & 7;
#pragma unroll
      for (int k = 0; k < 4; ++k) { const int row = rr + 8 * k; const v4u w = *(const v4u*)(ost + row * 144 + cc * 16);
          *(v4u*)(O8 + (tok0 + (size_t)(m0 + wq * 32 + row) * d) * ldo + ocol + cc * 16) = w; }
    } else {
      char* ost = lds + wid * 8704;
#pragma unroll
      for (int q = 0; q < 16; ++q) { const float rl = __builtin_amdgcn_rcpf(li_l[crow(q, hi)]); unsigned short* orow = (unsigned short*)(ost + crow(q, hi) * 272) + r32;
#pragma unroll
          for (int dd = 0; dd < 4; ++dd) { const float v = o[dd][q] * rl; orow[dd * 32] = (unsigned short)(cvtpk(v, v) & 0xffffu); } }
      asm volatile("s_waitcnt lgkmcnt(0)" ::: "memory");
      const int rr = lane >> 4, cc = lane & 15;
#pragma unroll
      for (int k = 0; k < 8; ++k) { const int row = rr + 4 * k; const v4u w = *(const v4u*)(ost + row * 272 + cc * 16);
          *(v4u*)(O + (tok0 + (size_t)(m0 + wq * 32 + row) * d) * ldo + ocol + cc * 8) = w; } }
}
}

__device__ __forceinline__ void p2_attention(Frame& F) {
    const bf16* proj = (const bf16*)(F.ws + WS_PROJ);
    bf16* attA = (bf16*)(F.ws + WS_ATTA); bf16* oB = (bf16*)(F.ws + WS_OB); float* lseB = (float*)(F.ws + WS_LSE);
    const int vcu = (F.G & 7) ? (int)blockIdx.x : (int)(blockIdx.x & 7) * (F.G >> 3) + (int)(blockIdx.x >> 3);
    for (int uid = vcu; uid < 640; uid += F.G) {
        if (uid < 256) {
            const int b = uid >> 7, rem = uid & 127, blk = rem >> 3, hq = rem & 7, kvh = hq >> 2;
            att::attn_unit<128, true>(F.ldsg, proj, b, C_QA + hq * HD, C_KA + kvh * HD, C_VA + kvh * HD, 1, 0, blk * 256,
                                      F.rel_bias + hq, F.sink_a[hq], attA, AQW, hq * HD, nullptr, 0);
        } else {
            const int u2 = uid - 256, gi = u2 >> 7, rem = u2 & 127, b = rem >> 6, blk = (rem >> 2) & 15, j = rem & 3;
            const int d = gi == 0 ? 1 : (gi == 1 ? 4 : 16), nbr = 16 / d, r = blk / nbr, m0 = (blk % nbr) * 256, hb = gi * 4 + j;
            att::attn_unit<64, false>(F.ldsg, proj, b, C_QB + hb * HD, C_KB + hb * HD, C_VB + hb * HD, d, r, m0,
                                      F.rel_bias + 8 + hb, 0.f, oB + (size_t)gi * T * BOW, BOW, j * HD, lseB + (size_t)gi * T * 4, j);
        }
    }
}
__device__ __forceinline__ void p3_combine(Frame& F) {
    const Lane Ls = lane_state();
    const bf16* oB = (const bf16*)(F.ws + WS_OB); const float* lseB = (const float*)(F.ws + WS_LSE); bf16* attB = (bf16*)(F.ws + WS_ATTB);
    for (int t = Ls.gw; t < T; t += F.NGW) {
        const int j = Ls.lane >> 4;
        const float l0 = lseB[(size_t)t * 4 + j], l1 = lseB[(size_t)(T + t) * 4 + j], l2 = lseB[(size_t)(2 * T + t) * 4 + j];
        const float mx = fmaxf(l0, fmaxf(l1, l2)); const float e0 = __expf(l0 - mx), e1 = __expf(l1 - mx), e2 = __expf(l2 - mx); const float inv = 1.f / (e0 + e1 + e2);
        const float w0 = e0 * inv, w1 = e1 * inv, w2 = e2 * inv;
        const v4u a = *(const v4u*)(oB + (size_t)t * BOW + Ls.lane * 8), bq = *(const v4u*)(oB + ((size_t)T + t) * BOW + Ls.lane * 8), c = *(const v4u*)(oB + ((size_t)2 * T + t) * BOW + Ls.lane * 8);
        float cv[8];
#pragma unroll
        for (int k = 0; k < 4; ++k) { cv[2 * k] = (w0 * bflo(a[k]) + w1 * bflo(bq[k]) + w2 * bflo(c[k])) * A_SCALE; cv[2 * k + 1] = (w0 * bfhi(a[k]) + w1 * bfhi(bq[k]) + w2 * bfhi(c[k])) * A_SCALE; }
        v2u o; o.x = pk4_fp8(cv[0], cv[1], cv[2], cv[3]); o.y = pk4_fp8(cv[4], cv[5], cv[6], cv[7]);
        *(v2u*)((unsigned char*)attB + (size_t)t * BOW + Ls.lane * 8) = o;
    }
}

__device__ __forceinline__ float gelu_erf(float v) {
    const float av = fabsf(v), t = __builtin_amdgcn_rcpf(fmaf(av, 0.2316418882f, 1.0f));
    float q = fmaf(t, 0.5307027145f, -0.7265760135f); q = fmaf(q, t, 0.7107068705f); q = fmaf(q, t, -0.142248368f); q = fmaf(q, t, 0.127414796f); q = q * t;
    const float e = __builtin_amdgcn_exp2f(v * v * -0.72134752044f);
    const float m = v * (q * e);
    return v < 0.f ? m : v - m;
}
typedef float f32x2 __attribute__((ext_vector_type(2)));
#define PIN16(A, B) asm volatile("" : "+v"(A[(B) + 0]), "+v"(A[(B) + 1]), "+v"(A[(B) + 2]), "+v"(A[(B) + 3]), "+v"(A[(B) + 4]), "+v"(A[(B) + 5]), "+v"(A[(B) + 6]), "+v"(A[(B) + 7]), \
    "+v"(A[(B) + 8]), "+v"(A[(B) + 9]), "+v"(A[(B) + 10]), "+v"(A[(B) + 11]), "+v"(A[(B) + 12]), "+v"(A[(B) + 13]), "+v"(A[(B) + 14]), "+v"(A[(B) + 15]) :: "memory")
#ifndef P8_DU
#define P8_DU 4
#endif
#ifndef P8_DV
#define P8_DV 8
#endif
constexpr int P8_CH = 8 / P8_NP;
constexpr int P8_ST = 16 * P8_CH;
constexpr int P8_PB = 256 * P8_CH;
template <int D> __device__ __forceinline__ void issue_part(v4u (&buf)[P8_CH], const unsigned char* tab, unsigned e, int gl) {
    const unsigned char* p = tab + (size_t)e * P8_PB + 16 * gl;
#pragma unroll
    for (int jj = 0; jj < P8_CH; ++jj) buf[jj] = *(const v4u*)(p + 256 * jj);
}
template <int D> __device__ __forceinline__ void sweep_u(const unsigned char* tab, const LAS unsigned* entg, LAS float* awg, int gl, int part, const float (&hv)[P8_ST]) {
    static_assert(128 % D == 0 && D % 4 == 0 && D <= 16, "block size");
    v4u buf[D][P8_CH];
    tab += (size_t)part * ((size_t)NEXP * P8_PB);
    { v4u e4[D / 4];
#pragma unroll
      for (int q = 0; q < D / 4; ++q) e4[q] = *(const LAS v4u*)(entg + 4 * q);
#pragma unroll
      for (int j = 0; j < D; ++j) issue_part<D>(buf[j], tab, e4[j >> 2][j & 3], gl); }
#pragma unroll 1
    for (int k0 = 0; k0 < 128; k0 += D) {
        v4u e4[D / 4]; const int kb = (k0 + D < 128) ? k0 + D : 128 - D;
#pragma unroll
        for (int q = 0; q < D / 4; ++q) e4[q] = *(const LAS v4u*)(entg + kb + 4 * q);
#pragma unroll
        for (int q = 0; q < D / 4; ++q) asm volatile("" : "+v"(e4[q]));
        float racc[D];
#pragma unroll
        for (int j = 0; j < D; ++j) {
            float a0 = 0.f, a1 = 0.f;
#pragma unroll
            for (int jj = 0; jj < P8_CH; ++jj)
#pragma unroll
                for (int c = 0; c < 4; ++c) { const f32x2 lo = __builtin_amdgcn_cvt_pk_f32_fp8((int)buf[j][jj][c], false), hi = __builtin_amdgcn_cvt_pk_f32_fp8((int)buf[j][jj][c], true);
                    a0 = fmaf(lo.x, hv[16 * jj + 4 * c + 0], a0); a1 = fmaf(lo.y, hv[16 * jj + 4 * c + 1], a1); a0 = fmaf(hi.x, hv[16 * jj + 4 * c + 2], a0); a1 = fmaf(hi.y, hv[16 * jj + 4 * c + 3], a1); }
            racc[j] = a0 + a1; asm volatile("" : "+v"(racc[j]) :: "memory");
            issue_part<D>(buf[j], tab, e4[j >> 2][j & 3], gl);
        }
#pragma unroll
        for (int st = D / 2; st >= 1; st >>= 1) { const bool up_ = (gl & st) != 0;
#pragma unroll
            for (int i = 0; i < st; ++i) { const float keep = up_ ? racc[i + st] : racc[i], send = up_ ? racc[i] : racc[i + st]; racc[i] = keep + __shfl_xor(send, st); } }
        float r = racc[0];
#pragma unroll
        for (int st = D; st < 16; st <<= 1) r += __shfl_xor(r, st);
        if (gl < D) awg[part * 512 + k0 + gl] = r;
    }
}
template <int D> __device__ __forceinline__ void sweep_v(const unsigned char* tab, const LAS unsigned* entg, const LAS float* awg, int gl, int part, float (&po)[P8_ST]) {
    static_assert(128 % D == 0 && D % 4 == 0 && D <= 16, "block size");
    v4u buf[D][P8_CH];
    tab += (size_t)part * ((size_t)NEXP * P8_PB);
    { v4u e4[D / 4];
#pragma unroll
      for (int q = 0; q < D / 4; ++q) e4[q] = *(const LAS v4u*)(entg + 4 * q);
#pragma unroll
      for (int j = 0; j < D; ++j) issue_part<D>(buf[j], tab, e4[j >> 2][j & 3], gl); }
#pragma unroll 1
    for (int k0 = 0; k0 < 128; k0 += D) {
        v4u e4[D / 4]; f32x4 w4[D / 4]; const int kb = (k0 + D < 128) ? k0 + D : 128 - D;
#pragma unroll
        for (int q = 0; q < D / 4; ++q) { e4[q] = *(const LAS v4u*)(entg + kb + 4 * q); w4[q] = *(const LAS f32x4*)(awg + k0 + 4 * q); }
#pragma unroll
        for (int q = 0; q < D / 4; ++q) asm volatile("" : "+v"(e4[q]), "+v"(w4[q]));
#pragma unroll
        for (int j = 0; j < D; ++j) {
            const float wk = w4[j >> 2][j & 3];
#pragma unroll
            for (int jj = 0; jj < P8_CH; ++jj)
#pragma unroll
                for (int c = 0; c < 4; ++c) { const f32x2 lo = __builtin_amdgcn_cvt_pk_f32_fp8((int)buf[j][jj][c], false), hi = __builtin_amdgcn_cvt_pk_f32_fp8((int)buf[j][jj][c], true);
                    po[16 * jj + 4 * c + 0] = fmaf(wk, lo.x, po[16 * jj + 4 * c + 0]); po[16 * jj + 4 * c + 1] = fmaf(wk, lo.y, po[16 * jj + 4 * c + 1]);
                    po[16 * jj + 4 * c + 2] = fmaf(wk, hi.x, po[16 * jj + 4 * c + 2]); po[16 * jj + 4 * c + 3] = fmaf(wk, hi.y, po[16 * jj + 4 * c + 3]); }
#pragma unroll
            for (int jj = 0; jj < P8_CH; ++jj) PIN16(po, 16 * jj);
            issue_part<D>(buf[j], tab, e4[j >> 2][j & 3], gl);
        }
    }
}
__device__ __forceinline__ void p8_expert(Frame& F) {
    const Lane Ls = lane_state();
    const unsigned char* U8 = F.ws + WS_U; const unsigned char* V8 = F.ws + WS_V; const float* esc = (const float*)(F.ws + WS_ESC);
    const float* part = (const float*)(F.ws + WS_PART); const int* tki = (const int*)(F.ws + WS_TKI); const float* tkg = (const float*)(F.ws + WS_TKG);
    bf16* X1b = (bf16*)(F.ws + WS_X1B);
    LAS unsigned* key = (LAS unsigned*)(F.lds + RING_OFF + Ls.wave * 16384); LAS unsigned* ent = key + 512; LAS float* gsv = (LAS float*)(ent + 512); LAS float* sus = gsv + 512; LAS float* aw = sus + 512;
    const int vw0 = ((int)(blockIdx.x & 7) * (F.G >> 3) + (int)(blockIdx.x >> 3)) * NWAVES + Ls.wave;
    for (int v = (F.G & 7) ? Ls.gw : vw0; v < T / 4; v += F.NGW) {
        unsigned zz = 0u; asm volatile("" : "+s"(zz));
        int lane = (int)__builtin_amdgcn_mbcnt_hi(~0u, __builtin_amdgcn_mbcnt_lo(~0u, zz)); asm volatile("" : "+v"(lane));
        const int sg = lane >> 4, gl = lane & 15, tok = 4 * v + sg;
        LAS unsigned* keyg = key + sg * 128; LAS unsigned* entg = ent + sg * 128; LAS float* gsvg = gsv + sg * 128; LAS float* susg = sus + sg * 128; LAS float* awg = aw + sg * 128;
        { unsigned mk[8]; float mg[8];
#pragma unroll
          for (int q = 0; q < 8; ++q) { const int j = gl + 16 * q; const int e = tki[(size_t)tok * 128 + j]; mg[q] = tkg[(size_t)tok * 128 + j]; mk[q] = ((unsigned)e << 7) | (unsigned)j; keyg[j] = mk[q]; }
          asm volatile("s_waitcnt lgkmcnt(0)" ::: "memory");
          int rk[8];
#pragma unroll
          for (int q = 0; q < 8; ++q) rk[q] = 0;
#pragma unroll 4
          for (int jj = 0; jj < 32; ++jj) { const v4u kk = *(const LAS v4u*)(keyg + 4 * jj);
#pragma unroll
              for (int c = 0; c < 4; ++c)
#pragma unroll
                  for (int q = 0; q < 8; ++q) rk[q] += (kk[c] < mk[q]) ? 1 : 0; }
#pragma unroll
          for (int q = 0; q < 8; ++q) { const int e = (int)(mk[q] >> 7); entg[rk[q]] = (unsigned)e; gsvg[rk[q]] = mg[q] * esc[NEXP + e]; susg[rk[q]] = esc[e]; }
          asm volatile("s_waitcnt lgkmcnt(0)" ::: "memory"); }
        float rstd;
        { float ps = part[(size_t)tok * 32 + gl] + part[(size_t)tok * 32 + 16 + gl];
          ps += __shfl_xor(ps, 1); ps += __shfl_xor(ps, 2); ps += __shfl_xor(ps, 4); ps += __shfl_xor(ps, 8);
          rstd = rsqrtf(ps * (1.f / DM) + EPS); }
#pragma unroll
        for (int pt = 0; pt < P8_NP; ++pt) {
            float hv[P8_ST];
            { int tok2 = tok; asm volatile("" : "+v"(tok2)); const bf16* xr = X1b + (size_t)tok2 * DM + P8_PB * pt + 16 * gl; const float* gp = F.g_ffn + P8_PB * pt + 16 * gl;
#pragma unroll
              for (int jj = 0; jj < P8_CH; ++jj) { const v4u a0 = *(const v4u*)(xr + 256 * jj), a1 = *(const v4u*)(xr + 256 * jj + 8);
#pragma unroll
                  for (int q = 0; q < 4; ++q) { const f32x4 g = *(const f32x4*)(gp + 256 * jj + 4 * q); const unsigned w0 = q < 2 ? a0[2 * q] : a1[2 * q - 4], w1 = q < 2 ? a0[2 * q + 1] : a1[2 * q - 3];
                      hv[16 * jj + 4 * q + 0] = bflo(w0) * rstd * g[0]; hv[16 * jj + 4 * q + 1] = bfhi(w0) * rstd * g[1]; hv[16 * jj + 4 * q + 2] = bflo(w1) * rstd * g[2]; hv[16 * jj + 4 * q + 3] = bfhi(w1) * rstd * g[3]; }
                  PIN16(hv, 16 * jj); } }
            sweep_u<P8_DU>(U8, entg, awg, gl, pt, hv);
            asm volatile("s_waitcnt lgkmcnt(0)" ::: "memory");
        }
#pragma unroll
        for (int q = 0; q < 8; ++q) { const int j = gl + 16 * q; const float x = ((awg[j] + awg[512 + j]) + (awg[1024 + j] + awg[1536 + j])) * susg[j]; awg[j] = gsvg[j] * gelu_erf(x); }
        asm volatile("s_waitcnt lgkmcnt(0)" ::: "memory");
        float s2 = 0.f;
#pragma unroll
        for (int pt = 0; pt < P8_NP; ++pt) {
            float po[P8_ST];
#pragma unroll
            for (int q = 0; q < P8_ST; ++q) po[q] = 0.f;
            sweep_v<P8_DV>(V8, entg, awg, gl, pt, po);
            { int tok2 = tok; asm volatile("" : "+v"(tok2)); bf16* xb = X1b + (size_t)tok2 * DM + P8_PB * pt + 16 * gl;
#pragma unroll
              for (int jj = 0; jj < P8_CH; ++jj) { const v4u a0 = *(const v4u*)(xb + 256 * jj), a1 = *(const v4u*)(xb + 256 * jj + 8); v4u o0, o1;
#pragma unroll
                  for (int q = 0; q < 4; ++q) { const unsigned w0 = q < 2 ? a0[2 * q] : a1[2 * q - 4], w1 = q < 2 ? a0[2 * q + 1] : a1[2 * q - 3]; f32x4 o;
                      o[0] = bflo(w0) + po[16 * jj + 4 * q + 0]; o[1] = bfhi(w0) + po[16 * jj + 4 * q + 1]; o[2] = bflo(w1) + po[16 * jj + 4 * q + 2]; o[3] = bfhi(w1) + po[16 * jj + 4 * q + 3];
#pragma unroll
                      for (int e = 0; e < 4; ++e) s2 = fmaf(o[e], o[e], s2);
                      const unsigned p0 = cvtpk(o[0], o[1]), p1 = cvtpk(o[2], o[3]);
                      if (q < 2) { o0[2 * q] = p0; o0[2 * q + 1] = p1; } else { o1[2 * q - 4] = p0; o1[2 * q - 3] = p1; } }
                  *(v4u*)(xb + 256 * jj) = o0; *(v4u*)(xb + 256 * jj + 8) = o1;
                  asm volatile("" : "+v"(s2) :: "memory"); } }
        }
        { s2 += __shfl_xor(s2, 1); s2 += __shfl_xor(s2, 2); s2 += __shfl_xor(s2, 4); s2 += __shfl_xor(s2, 8);
          const float r2 = rsqrtf(s2 * (1.f / DM) + EPS);
          int tok2 = tok; asm volatile("" : "+v"(tok2)); float* xr = F.out + (size_t)tok2 * DM + 16 * gl; const float* gf = F.g_fin + 16 * gl; const bf16* xb = X1b + (size_t)tok2 * DM + 16 * gl;
#pragma unroll
          for (int jj = 0; jj < 8; ++jj) { const v4u a0 = *(const v4u*)(xb + 256 * jj), a1 = *(const v4u*)(xb + 256 * jj + 8);
#pragma unroll
              for (int q = 0; q < 4; ++q) { const f32x4 g = *(const f32x4*)(gf + 256 * jj + 4 * q); const unsigned w0 = q < 2 ? a0[2 * q] : a1[2 * q - 4], w1 = q < 2 ? a0[2 * q + 1] : a1[2 * q - 3];
                  const f32x4 a = {bflo(w0), bfhi(w0), bflo(w1), bfhi(w1)};
                  *(f32x4*)(xr + 256 * jj + 4 * q) = a * r2 * g; }
              asm volatile("" ::: "memory"); } }
    }
}

constexpr int N_PHASES = 9;
struct Args { const float* in[14]; float* out; unsigned char* ws; int ph_lo, ph_hi; };
__global__ void __launch_bounds__(NWAVES * 64, 2) fwd_kernel(Args args) {
    extern __shared__ __attribute__((aligned(16))) unsigned char lds[];
    Frame F;
    F.lds = (LAS unsigned char*)lds; F.ldsg = (char*)lds;
    F.G = gridDim.x; F.NGW = F.G * NWAVES;
    F.x = args.in[0]; F.rel_bias = args.in[1]; F.g_mix = args.in[2]; F.w_in = args.in[3]; F.sink_a = args.in[4]; F.w_oa = args.in[5]; F.w_ob = args.in[6]; F.w_out = args.in[7];
    F.g_ffn = args.in[8]; F.w_pq = args.in[9]; F.keys = args.in[10]; F.eu = args.in[11]; F.ev = args.in[12]; F.g_fin = args.in[13];
    F.out = args.out; F.ws = args.ws;
    volatile LAS unsigned* MISC = (volatile LAS unsigned*)(F.lds + MISC_OFF);
    for (int u = threadIdx.x; u < (LDS_BYTES - LDSCTL_OFF) / 4; u += NWAVES * 64) ((LAS unsigned*)(F.lds + LDSCTL_OFF))[u] = 0u;
    __syncthreads();
    const int lo = args.ph_lo, hi = args.ph_hi;
    const bool multi = !MK_SPLIT || (hi - lo) > 1;
    XcdBarrier bar; bar.bar = (unsigned*)(F.ws + WS_CTL) + CW_BAR; bar.x = 0; bar.st = nullptr;
    if (multi) bar = xcd_barrier_post((unsigned*)(F.ws + WS_CTL) + CW_BAR, MISC + 8);
#ifndef PH_OFF
#define PH_OFF 0
#endif
#if MK_SPLIT
#define IN(k) (lo <= (k) && (k) < hi && !((PH_OFF >> (k)) & 1))
#else
#define IN(k) (!((PH_OFF >> (k)) & 1))
#endif
#define GRID_BAR() do { XcdBarrier b_ = bar; asm volatile("" : "+s"(b_.bar)); xcd_barrier(b_); } while (0)
#define SEAM(k) do { if (IN(k) && IN((k) + 1)) GRID_BAR(); } while (0)
#ifndef PH_REP
#define PH_REP 0
#endif
#define NREP(k) (IN(k) ? 1 + ((PH_REP >> (k)) & 1) : 0)
#define REPEAT(k) _Pragma("unroll") for (int r_ = 0; r_ < NREP(k); ++r_)
#define REBAR() do { if (r_) GRID_BAR(); } while (0)
    bf16* WinT = (bf16*)(F.ws + WS_WIN); bf16* WoaT = (bf16*)(F.ws + WS_WOA); bf16* WobT = (bf16*)(F.ws + WS_WOB); bf16* WoutT = (bf16*)(F.ws + WS_WOUT); bf16* W2T = (bf16*)(F.ws + WS_W2);
    bf16* proj = (bf16*)(F.ws + WS_PROJ); bf16* Hb = (bf16*)(F.ws + WS_H); bf16* mrg = (bf16*)(F.ws + WS_MRG);
    bf16* attA = (bf16*)(F.ws + WS_ATTA); bf16* attB = (bf16*)(F.ws + WS_ATTB); bf16* x1b = (bf16*)(F.ws + WS_X1B);
    float* part = (float*)(F.ws + WS_PART); float* scores = (float*)(F.ws + WS_SC);

    REPEAT(0) { REBAR(); p0_prologue(F); } SEAM(0);
    REPEAT(1) { REBAR();
        pg8::Gemm g{Hb, WinT, T, INW, DM / 2}; pg8::StaticOrder S; S.init(T, INW, F.G, (int)blockIdx.x);
        pg8::EpiProj E{proj, INW, C_GA / 256, 1.f / W_SCALE};
        pg8::gemm_phase<pg8::EpiProj, pg8::StaticOrder, true, true, true>(F.lds + RING_OFF, g, S, E);
    } SEAM(1);
    REPEAT(2) { REBAR(); p2_attention(F); } SEAM(2);
    for (int r34 = 0; r34 < 1 + ((PH_REP >> 3) & 1); ++r34) {
    if (r34) GRID_BAR();
    if (IN(3)) {
        p3_combine(F);
        pg8::Gemm g{attA, WoaT, T, DM, AQW / 2}; pg8::StaticOrder S; S.init(T, DM, F.G, (int)blockIdx.x);
        pg8::EpiGate<false> E{proj + C_GA, INW, mrg, DM, 1.f / (A_SCALE * W_SCALE)};
        pg8::gemm_phase<pg8::EpiGate<false>, pg8::StaticOrder, false, true, true>(F.lds + RING_OFF, g, S, E);
    } SEAM(3);
    if (IN(4)) {
        pg8::Gemm g{attB, WobT, T, DM, BOW / 2}; pg8::StaticOrder S; S.init(T, DM, F.G, (int)blockIdx.x);
        pg8::EpiGateF8 E{proj + C_GB, INW, mrg, DM, F.ws + WS_MRG8, DM, M_SCALE, 1.f / (A_SCALE * W_SCALE)};
        pg8::gemm_phase<pg8::EpiGateF8, pg8::StaticOrder, false, true, true>(F.lds + RING_OFF, g, S, E);
    }
    }
    SEAM(4);
    REPEAT(5) { REBAR();
        pg8::Gemm g{(const bf16*)(F.ws + WS_MRG8), WoutT, T, DM, DM / 2}; pg8::StaticOrder S; S.init(T, DM, F.G, (int)blockIdx.x);
        pg8::EpiResid E{F.x, x1b, part, DM, 1.f / (M_SCALE * W_SCALE)};
        pg8::gemm_phase<pg8::EpiResid, pg8::StaticOrder, false, true, true>(F.lds + RING_OFF, g, S, E);
    } SEAM(5);
    REPEAT(6) { REBAR();
        pg8::Gemm g{x1b, W2T, T, DM, DM}; pg8::StaticOrder S; S.init(T, DM, F.G, (int)blockIdx.x);
        LAS float* rs = (LAS float*)(F.lds + RSTD_OFF);
        const Lane Ls = lane_state();
        pg8::Unit u0; if (S.next(0, u0) && Ls.tid < 256) { const f32x4* pp = (const f32x4*)(part + (size_t)(u0.pm * 256 + Ls.tid) * 32); float s = 0.f;
#pragma unroll
            for (int i = 0; i < 8; ++i) { const f32x4 v = pp[i]; s += (v[0] + v[1]) + (v[2] + v[3]); }
            rs[Ls.tid] = rsqrtf(s * (1.f / DM) + EPS); }
        __syncthreads();
        pg8::EpiTopk E{rs, (int*)(F.ws + WS_TKI), (float*)(F.ws + WS_TKG), PHEADS, scores, DM};
        pg8::gemm_phase<pg8::EpiTopk, pg8::StaticOrder, false, true>(F.lds + RING_OFF, g, S, E);
    }
    if (IN(6) && IN(8)) GRID_BAR();
    if (IN(8)) { p8_expert(F); }
#undef IN
#undef SEAM
}

extern "C" void kernel_launch(void* const* d_in, const int* in_sizes, int n_in, void* d_out, int out_size, void* d_ws, size_t ws_size, hipStream_t stream) {
    static int grid = 0;
    if (grid == 0) {
        if (n_in != 14 || in_sizes[0] != T * DM || out_size != T * DM || ws_size < WS_END) {
            fprintf(stderr, "kernel_launch: unexpected shapes: n_in %d in0 %d out %d ws %zu (need >= %zu); nothing launched\n", n_in, n_in > 0 ? in_sizes[0] : -1, out_size, ws_size, (size_t)WS_END); grid = -1; return; }
        int dev = 0, cus = 0, per_cu = 0;
        if (hipGetDevice(&dev) != hipSuccess || hipDeviceGetAttribute(&cus, hipDeviceAttributeMultiprocessorCount, dev) != hipSuccess) { grid = -1; return; }
        if (hipFuncSetAttribute((const void*)fwd_kernel, hipFuncAttributeMaxDynamicSharedMemorySize, LDS_BYTES) != hipSuccess) { fprintf(stderr, "kernel_launch: hipFuncSetAttribute failed\n"); grid = -1; return; }
        if (hipOccupancyMaxActiveBlocksPerMultiprocessor(&per_cu, (const void*)fwd_kernel, NWAVES * 64, LDS_BYTES) != hipSuccess || per_cu < 1)
            fprintf(stderr, "kernel_launch: note: occupancy query reports %d workgroups per CU\n", per_cu);
        (void)hipGetLastError();
        grid = cus;
        if (grid != 256) fprintf(stderr, "kernel_launch: note: %d CUs (built for 256)\n", grid);
    }
    if (grid < 0) return;
    (void)hipMemsetAsync((char*)d_ws + WS_CTL, 0, CTL_ZERO_BYTES, stream);
    Args a{};
    for (int i = 0; i < 14; ++i) a.in[i] = (const float*)d_in[i];
    a.out = (float*)d_out; a.ws = (unsigned char*)d_ws;
#if MK_SPLIT
    for (int p = 0; p < N_PHASES; ++p) { a.ph_lo = p; a.ph_hi = p + 1; hipLaunchKernelGGL(fwd_kernel, dim3(grid), dim3(NWAVES * 64), LDS_BYTES, stream, a); }
#else
    a.ph_lo = 0; a.ph_hi = N_PHASES; hipLaunchKernelGGL(fwd_kernel, dim3(grid), dim3(NWAVES * 64), LDS_BYTES, stream, a);
#endif
    const hipError_t le = hipPeekAtLastError();
    if (le != hipSuccess) fprintf(stderr, "kernel_launch: launch failed: %s\n", hipGetErrorName(le));
}
```

```cpp
#include <hip/hip_runtime.h>
#include <cstdio>
#include <cstdint>
namespace pg8 {
#define PG8_LAS __attribute__((address_space(3)))
typedef unsigned short bf16_t;
typedef short bf16x8 __attribute__((ext_vector_type(8)));
typedef float f32x4 __attribute__((ext_vector_type(4)));
typedef unsigned u32x4 __attribute__((ext_vector_type(4)));
typedef int v4i_t __attribute__((ext_vector_type(4)));
typedef int v8i_t __attribute__((ext_vector_type(8)));
constexpr int BM = 256, BK = 64, HALF = 128, HTB = HALF * BK * 2  , STAGE_BYTES = 8 * HTB, NXCD = 8, WGM = 8;

__host__ __device__ __forceinline__ int lds_byte(int r, int c) { const int st = (r >> 4) * 2 + (c >> 5), rr = r & 15, cc = c & 31, ob = rr * 64 + cc * 2; return st * 1024 + (ob ^ (((ob >> 9) & 1) << 5)); }
__host__ __device__ __forceinline__ void stage_rc(int b, int& R, int& C) { const int st = b / 1024, sb = b % 1024, swz = sb ^ (((sb >> 9) & 1) << 5); R = (st >> 1) * 16 + swz / 64; C = (st & 1) * 32 + (swz % 64) / 2; }
__host__ __device__ __forceinline__ int perm32(int rho) { const int n = rho >> 4, i = rho & 15; return 8 * (i >> 2) + 4 * n + (i & 3); }

struct Unit { int pm, pn; };
struct Gemm { const bf16_t* A; const bf16_t* Bt; int M, N, K; };

struct StaticOrder {
    int nM, nN, nwg, G, c;
    __host__ __device__ void init(int M, int N, int G_, int c_) { nM = M / BM; nN = N / BM; nwg = nM * nN; G = G_; c = c_; }
    __host__ __device__ bool next(int i, Unit& u) const {
        const long L = (long)i * G + c; if (L >= nwg) return false;
        int wgid = (int)L; { const int q = nwg / NXCD, r = nwg % NXCD, xcd = wgid % NXCD, off = wgid / NXCD; wgid = (xcd < r ? xcd * (q + 1) : r * (q + 1) + (xcd - r) * q) + off; }
        const int nig = WGM * nN, gid = wgid / nig, fm = gid * WGM, gsz = (nM - fm) < WGM ? (nM - fm) : WGM;
        u.pm = fm + ((wgid % nig) % gsz); u.pn = (wgid % nig) / gsz; return true;
    }
    __device__ __forceinline__ void a_ready(const Unit&) const {}
    __device__ __forceinline__ void done(const Unit&) const {}
};

typedef unsigned u32x2 __attribute__((ext_vector_type(2)));
__device__ __forceinline__ unsigned cvt_pk_bf16(float lo, float hi) { unsigned r; asm volatile("v_cvt_pk_bf16_f32 %0, %1, %2" : "=v"(r) : "v"(lo), "v"(hi)); return r; }
__device__ __forceinline__ float sigm(float v) { return __builtin_amdgcn_rcpf(1.0f + __builtin_amdgcn_exp2f(-1.4426950408889634f * v)); }
__device__ __forceinline__ float bflo(unsigned w) { return __builtin_bit_cast(float, w << 16); }
__device__ __forceinline__ float bfhi(unsigned w) { return __builtin_bit_cast(float, w & 0xffff0000u); }

struct EpiProj {
    static constexpr bool PERM = true, AFTER_DRAIN = false;
    bf16_t* O; int ldc; int gate_pn; float osc;
    __device__ __forceinline__ void operator()(const f32x4 (&acc)[2][2][4][2], const Unit& u, int wr, int wc, int fr_, int fq_) const {
        (void)fr_; (void)fq_; int ln_ = (int)__builtin_amdgcn_mbcnt_hi(~0u, __builtin_amdgcn_mbcnt_lo(~0u, 0u)); asm volatile("" : "+v"(ln_));
        const int fr = ln_ & 15, fq = ln_ >> 4;
        const int row0 = u.pm * BM + wr * 64 + fr, col0 = u.pn * BM + wc * 32 + 8 * fq; const bool gate = u.pn >= gate_pn;
#pragma unroll
        for (int ai = 0; ai < 2; ++ai)
#pragma unroll
            for (int m = 0; m < 4; ++m) { bf16_t* rowp = O + (size_t)(row0 + ai * HALF + m * 16) * ldc + col0;
#pragma unroll
                for (int bj = 0; bj < 2; ++bj) { f32x4 v0 = acc[ai][bj][m][0] * osc, v1 = acc[ai][bj][m][1] * osc;
                    if (gate) {
#pragma unroll
                        for (int j = 0; j < 4; ++j) { v0[j] = sigm(v0[j]); v1[j] = sigm(v1[j]); } }
                    u32x4 w; w.x = cvt_pk_bf16(v0[0], v0[1]); w.y = cvt_pk_bf16(v0[2], v0[3]); w.z = cvt_pk_bf16(v1[0], v1[1]); w.w = cvt_pk_bf16(v1[2], v1[3]);
                    *(u32x4*)(rowp + bj * HALF) = w; } }
    }
};
template <bool ACCUM> struct EpiGate {
    static constexpr bool PERM = true, AFTER_DRAIN = false;
    const bf16_t* G; int ldg; bf16_t* O; int ldc; float osc;
    __device__ __forceinline__ void operator()(const f32x4 (&acc)[2][2][4][2], const Unit& u, int wr, int wc, int fr_, int fq_) const {
        (void)fr_; (void)fq_; int ln_ = (int)__builtin_amdgcn_mbcnt_hi(~0u, __builtin_amdgcn_mbcnt_lo(~0u, 0u)); asm volatile("" : "+v"(ln_));
        const int fr = ln_ & 15, fq = ln_ >> 4;
        const int row0 = u.pm * BM + wr * 64 + fr, col0 = u.pn * BM + wc * 32 + 8 * fq;
#pragma unroll
        for (int ai = 0; ai < 2; ++ai)
#pragma unroll
            for (int m = 0; m < 4; ++m) { const int row = row0 + ai * HALF + m * 16; const bf16_t* gp = G + (size_t)row * ldg + col0; bf16_t* op = O + (size_t)row * ldc + col0;
#pragma unroll
                for (int bj = 0; bj < 2; ++bj) { const u32x4 gw = *(const u32x4*)(gp + bj * HALF);
                    f32x4 v0 = acc[ai][bj][m][0] * osc, v1 = acc[ai][bj][m][1] * osc;
                    v0[0] *= bflo(gw.x); v0[1] *= bfhi(gw.x); v0[2] *= bflo(gw.y); v0[3] *= bfhi(gw.y);
                    v1[0] *= bflo(gw.z); v1[1] *= bfhi(gw.z); v1[2] *= bflo(gw.w); v1[3] *= bfhi(gw.w);
                    if (ACCUM) { const u32x4 mw = *(const u32x4*)(op + bj * HALF);
                        v0[0] += bflo(mw.x); v0[1] += bfhi(mw.x); v0[2] += bflo(mw.y); v0[3] += bfhi(mw.y);
                        v1[0] += bflo(mw.z); v1[1] += bfhi(mw.z); v1[2] += bflo(mw.w); v1[3] += bfhi(mw.w); }
                    u32x4 w; w.x = cvt_pk_bf16(v0[0], v0[1]); w.y = cvt_pk_bf16(v0[2], v0[3]); w.z = cvt_pk_bf16(v1[0], v1[1]); w.w = cvt_pk_bf16(v1[2], v1[3]);
                    *(u32x4*)(op + bj * HALF) = w; } }
    }
};
__device__ __forceinline__ unsigned pk4_fp8e(float a, float b, float c, float d) { int p = __builtin_amdgcn_cvt_pk_fp8_f32(fminf(fmaxf(a, -448.f), 448.f), fminf(fmaxf(b, -448.f), 448.f), 0, false);
    return (unsigned)__builtin_amdgcn_cvt_pk_fp8_f32(fminf(fmaxf(c, -448.f), 448.f), fminf(fmaxf(d, -448.f), 448.f), p, true); }
struct EpiGateF8 {
    static constexpr bool PERM = true, AFTER_DRAIN = false;
    const bf16_t* G; int ldg; const bf16_t* M1; int ldm; unsigned char* O8; int ldc; float oscale; float osc;
    __device__ __forceinline__ void operator()(const f32x4 (&acc)[2][2][4][2], const Unit& u, int wr, int wc, int fr_, int fq_) const {
        (void)fr_; (void)fq_; int ln_ = (int)__builtin_amdgcn_mbcnt_hi(~0u, __builtin_amdgcn_mbcnt_lo(~0u, 0u)); asm volatile("" : "+v"(ln_));
        const int fr = ln_ & 15, fq = ln_ >> 4;
        const int row0 = u.pm * BM + wr * 64 + fr, col0 = u.pn * BM + wc * 32 + 8 * fq;
#pragma unroll
        for (int ai = 0; ai < 2; ++ai)
#pragma unroll
            for (int m = 0; m < 4; ++m) { const int row = row0 + ai * HALF + m * 16; const bf16_t* gp = G + (size_t)row * ldg + col0; const bf16_t* mp = M1 + (size_t)row * ldm + col0; unsigned char* op = O8 + (size_t)row * ldc + col0;
#pragma unroll
                for (int bj = 0; bj < 2; ++bj) { const u32x4 gw = *(const u32x4*)(gp + bj * HALF), mw = *(const u32x4*)(mp + bj * HALF);
                    f32x4 v0 = acc[ai][bj][m][0] * osc, v1 = acc[ai][bj][m][1] * osc;
                    v0[0] = (v0[0] * bflo(gw.x) + bflo(mw.x)) * oscale; v0[1] = (v0[1] * bfhi(gw.x) + bfhi(mw.x)) * oscale; v0[2] = (v0[2] * bflo(gw.y) + bflo(mw.y)) * oscale; v0[3] = (v0[3] * bfhi(gw.y) + bfhi(mw.y)) * oscale;
                    v1[0] = (v1[0] * bflo(gw.z) + bflo(mw.z)) * oscale; v1[1] = (v1[1] * bfhi(gw.z) + bfhi(mw.z)) * oscale; v1[2] = (v1[2] * bflo(gw.w) + bflo(mw.w)) * oscale; v1[3] = (v1[3] * bfhi(gw.w) + bfhi(mw.w)) * oscale;
                    u32x2 w; w.x = pk4_fp8e(v0[0], v0[1], v0[2], v0[3]); w.y = pk4_fp8e(v1[0], v1[1], v1[2], v1[3]);
                    *(u32x2*)(op + bj * HALF) = w; } }
    }
};

struct EpiResid {
    static constexpr bool PERM = false, AFTER_DRAIN = false;
    const float* X; bf16_t* X1b; float* part; int ld; float osc;
    __device__ __forceinline__ void operator()(const f32x4 (&acc)[2][2][4][2], const Unit& u, int wr, int wc, int fr_, int fq_) const {
        (void)fr_; (void)fq_; int ln_ = (int)__builtin_amdgcn_mbcnt_hi(~0u, __builtin_amdgcn_mbcnt_lo(~0u, 0u)); asm volatile("" : "+v"(ln_));
        const int fr = ln_ & 15, fq = ln_ >> 4;
        const int row0 = u.pm * BM + wr * 64 + fr, col0 = u.pn * BM + wc * 32 + 4 * fq;
#pragma unroll
        for (int ai = 0; ai < 2; ++ai)
#pragma unroll
            for (int m = 0; m < 4; ++m) { const int row = row0 + ai * HALF + m * 16; float ss = 0.f;
#pragma unroll
                for (int bj = 0; bj < 2; ++bj)
#pragma unroll
                    for (int n = 0; n < 2; ++n) { const size_t off = (size_t)row * ld + col0 + bj * HALF + n * 16;
                        const f32x4 x = *(const f32x4*)(X + off); const f32x4 v = x + acc[ai][bj][m][n] * osc;
                        u32x2 w; w.x = cvt_pk_bf16(v[0], v[1]); w.y = cvt_pk_bf16(v[2], v[3]); *(u32x2*)(X1b + off) = w;
                        ss += (v[0] * v[0] + v[1] * v[1]) + (v[2] * v[2] + v[3] * v[3]); }
                ss += __shfl_xor(ss, 16); ss += __shfl_xor(ss, 32);
                if (fq == 0) part[(size_t)row * 32 + u.pn * 4 + wc] = ss; }
    }
};
__device__ __forceinline__ int tk_enc(float s) { const int b = __builtin_bit_cast(int, s); return b ^ ((b >> 31) & 0x7fffffff); }
__device__ __forceinline__ float tk_dec(int k) { return __builtin_bit_cast(float, k ^ ((k >> 31) & 0x7fffffff)); }
#define TK_INS16(Lst, X) do { int x_ = (X); _Pragma("unroll") for (int i_ = 0; i_ < 16; ++i_) { const int h_ = Lst[i_] > x_ ? Lst[i_] : x_; x_ = Lst[i_] > x_ ? x_ : Lst[i_]; Lst[i_] = h_; } } while (0)
__device__ __forceinline__ void tk_sort16(int (&v)[16]) {
#pragma unroll
    for (int k = 2; k <= 16; k <<= 1)
#pragma unroll
        for (int j = k >> 1; j > 0; j >>= 1)
#pragma unroll
            for (int i = 0; i < 16; ++i) { const int l = i ^ j; if (l > i) { const int a = v[i], b = v[l]; const int hi = a > b ? a : b, lo = a > b ? b : a; const bool desc = (i & k) == 0; v[i] = desc ? hi : lo; v[l] = desc ? lo : hi; } }
}
__device__ __forceinline__ void tk_merge16(int (&a)[16], const int (&b)[16]) {
#pragma unroll
    for (int i = 0; i < 16; ++i) a[i] = a[i] > b[15 - i] ? a[i] : b[15 - i];
#pragma unroll
    for (int j = 8; j > 0; j >>= 1)
#pragma unroll
        for (int i = 0; i < 16; ++i) { const int l = i ^ j; if (l > i) { const int x = a[i], y = a[l]; a[i] = x > y ? x : y; a[l] = x > y ? y : x; } }
}
#define TK_BAR() do { asm volatile("s_waitcnt lgkmcnt(0)" ::: "memory"); __builtin_amdgcn_s_barrier(); asm volatile("" ::: "memory"); } while (0)
struct EpiTopk {
    static constexpr bool PERM = false, AFTER_DRAIN = true;
    const PG8_LAS float* rs; int* tki; float* tkg; int nheads; float* S; int ld;
    __device__ __forceinline__ void fused(f32x4 (&acc)[2][2][4][2], const Unit& u, int wr, int wc, int fr_, int fq_, PG8_LAS unsigned char* lds, int wid, int lane_) const {
        (void)fr_; (void)fq_; (void)lane_; int lane = (int)__builtin_amdgcn_mbcnt_hi(~0u, __builtin_amdgcn_mbcnt_lo(~0u, 0u)); asm volatile("" : "+v"(lane));
        const int fr = lane & 15, fq = lane >> 4;
        PG8_LAS float* img = (PG8_LAS float*)lds;
        PG8_LAS int* lst = (PG8_LAS int*)lds;
        PG8_LAS int* mrg = (PG8_LAS int*)(lds + 32768);
#pragma unroll
        for (int ai = 0; ai < 2; ++ai)
#pragma unroll
            for (int m = 0; m < 4; ++m) { const int row = ai * HALF + wr * 64 + m * 16 + fr; const float s = rs[row]; float* rowp = S + (size_t)(u.pm * BM + row) * ld + u.pn * BM + wc * 32 + 4 * fq;
#pragma unroll
                for (int bj = 0; bj < 2; ++bj)
#pragma unroll
                    for (int n = 0; n < 2; ++n) *(f32x4*)(rowp + bj * HALF + n * 16) = acc[ai][bj][m][n] * s; }
        asm volatile("s_waitcnt vmcnt(0)" ::: "memory");
        TK_BAR();
#ifndef TK_REP
#define TK_REP 0
#endif
#pragma unroll 1
        for (int ai_ = 0; ai_ < 2 * (1 + TK_REP); ++ai_) { const int ai = ai_ & 1;
            asm volatile("" : "+v"(lane) :: "memory");
            const int tid = wid * 64 + lane;
            { const float* src = S + (size_t)(u.pm * BM + ai * HALF) * ld + u.pn * BM;
#pragma unroll 4
              for (int i = 0; i < 16; ++i) { const int idx = tid + 512 * i, row = idx >> 6, q = idx & 63; *(PG8_LAS f32x4*)(img + row * 256 + ((q ^ (row & 63)) << 2)) = *(const f32x4*)(src + (size_t)row * ld + 4 * q); } }
            TK_BAR();
            const int row = tid & 127, c = (tid >> 7) & 1, kh = tid >> 8;
            int Lk[16];
#pragma unroll 1
            for (int g = 0; g < 4; ++g) {
                int Nk[16];
#pragma unroll
                for (int i = 0; i < 4; ++i) { const int q = 32 * c + 16 * kh + 4 * g + i; const f32x4 v = *(const PG8_LAS f32x4*)(img + row * 256 + ((q ^ (row & 63)) << 2));
#pragma unroll
                    for (int e = 0; e < 4; ++e) Nk[4 * i + e] = (tk_enc(v[e]) & ~127) | (127 - (64 * kh + 16 * g + 4 * i + e)); }
                tk_sort16(Nk);
                if (g == 0) {
#pragma unroll
                    for (int i = 0; i < 16; ++i) Lk[i] = Nk[i]; }
                else tk_merge16(Lk, Nk);
            }
            TK_BAR();
            { PG8_LAS int* d = lst + ((row * 2 + c) * 2 + kh) * 16;
#pragma unroll
              for (int i = 0; i < 4; ++i) *(PG8_LAS v4i_t*)(d + 4 * i) = (v4i_t){Lk[4 * i], Lk[4 * i + 1], Lk[4 * i + 2], Lk[4 * i + 3]}; }
            TK_BAR();
            if (kh == 0) {
                const PG8_LAS int* o = lst + ((row * 2 + c) * 2 + 1) * 16; int Ok[16];
#pragma unroll
                for (int i = 0; i < 4; ++i) { const v4i_t w = *(const PG8_LAS v4i_t*)(o + 4 * i); Ok[4 * i] = w[0]; Ok[4 * i + 1] = w[1]; Ok[4 * i + 2] = w[2]; Ok[4 * i + 3] = w[3]; }
                tk_merge16(Lk, Ok);
                PG8_LAS int* d = mrg + (row * 2 + c) * 16;
#pragma unroll
                for (int i = 0; i < 4; ++i) *(PG8_LAS v4i_t*)(d + 4 * i) = (v4i_t){Lk[4 * i], Lk[4 * i + 1], Lk[4 * i + 2], Lk[4 * i + 3]};
            }
            TK_BAR();
            if (tid < 128) {
                const PG8_LAS int* A = mrg + (tid * 2 + 0) * 16; const PG8_LAS int* B = mrg + (tid * 2 + 1) * 16;
                float s0[16], s1[16];
#pragma unroll
                for (int i = 0; i < 4; ++i) { const v4i_t a = *(const PG8_LAS v4i_t*)(A + 4 * i), b = *(const PG8_LAS v4i_t*)(B + 4 * i);
#pragma unroll
                    for (int e = 0; e < 4; ++e) { s0[4 * i + e] = tk_dec(a[e] & ~127); s1[4 * i + e] = tk_dec(b[e] & ~127); } }
                int Mk[16], Ck[16];
                int cnt = 0;
#pragma unroll
                for (int i = 0; i < 16; ++i)
#pragma unroll
                    for (int j = 0; j < 16; ++j) if ((i + 1) * (j + 1) <= 16) {
                        Ck[cnt & 15] = (tk_enc(s0[i] + s1[j]) & ~255) | (i << 4) | j; ++cnt;
                        if ((cnt & 15) == 0 || cnt == 50) {
                            if (cnt == 50) {
#pragma unroll
                                for (int z = 2; z < 16; ++z) Ck[z] = (int)0x80000000; }
                            tk_sort16(Ck);
                            if (cnt == 16) {
#pragma unroll
                                for (int z = 0; z < 16; ++z) Mk[z] = Ck[z]; }
                            else tk_merge16(Mk, Ck);
                        } }
                const float smax = tk_dec(Mk[0] & ~255); float ev[16], den = 0.f;
#pragma unroll
                for (int q = 0; q < 16; ++q) { ev[q] = __expf(tk_dec(Mk[q] & ~255) - smax); den += ev[q]; }
                const float inv = 1.f / den; const size_t ob = ((size_t)(u.pm * BM + ai * HALF + tid) * nheads + u.pn) * 16;
#pragma unroll
                for (int q4 = 0; q4 < 4; ++q4) { v4i_t ei; f32x4 gv;
#pragma unroll
                    for (int e = 0; e < 4; ++e) { const int k = Mk[4 * q4 + e]; ei[e] = (127 - (A[(k >> 4) & 15] & 127)) * 128 + (127 - (B[k & 15] & 127)); gv[e] = ev[4 * q4 + e] * inv; }
                    *(v4i_t*)(tki + ob + 4 * q4) = ei; *(f32x4*)(tkg + ob + 4 * q4) = gv; }
            }
            TK_BAR();
        }
    }
};

template <class Epi, class Sched, bool ALIGN_EPI = false, bool SP2 = false, bool F8 = false>
__device__ __forceinline__ void gemm_phase(PG8_LAS unsigned char* lds, const Gemm g, const Sched& S, const Epi& E) {
    int tid_ = threadIdx.x; asm volatile("" : "+v"(tid_));
    const int tid = tid_, wid = __builtin_amdgcn_readfirstlane(tid >> 6), lane = tid & 63, wr = wid >> 2, wc = wid & 3, fr = lane & 15, fq = lane >> 4;
    const int K = g.K, nt = K / BK;
    unsigned voffA[2], voffB[2];
#pragma unroll
    for (int i = 0; i < 2; ++i) { int R, C; stage_rc(tid * 16 + i * 8192, R, C); const int Rb = Epi::PERM ? ((R & ~31) + perm32(R & 31)) : R;
        voffA[i] = (unsigned)(R * K + C) * 2u; voffB[i] = (unsigned)(Rb * K + C) * 2u; }
    const size_t kstep = (size_t)(BK * 2);
    const size_t hstep = (size_t)HALF * K * 2;
    const size_t tstep = 2 * hstep;
    const unsigned ldsw = (unsigned)__builtin_amdgcn_readfirstlane((int)((unsigned)(__SIZE_TYPE__)lds + (unsigned)wid * 1024u));
    const int aoff = lds_byte(wr * 64 + fr, fq * 8), boff = lds_byte(wc * 32 + fr, fq * 8);
#define PG8_SA(b, h) (((b) * 2 + (h)) * HTB)
#define PG8_SB(b, h) ((4 + (b) * 2 + (h)) * HTB)
#define PG8_STAGE(bufoff, gbase, voff) do { _Pragma("unroll") for (int _i = 0; _i < 2; ++_i) \
        __builtin_amdgcn_global_load_lds((const unsigned*)((const char*)(gbase) + (voff)[_i]), (PG8_LAS unsigned*)(__SIZE_TYPE__)(ldsw + (unsigned)((bufoff) + _i * 8192)), 16, 0, 0); } while (0)
    PG8_LAS unsigned char* ldsA = lds + aoff; PG8_LAS unsigned char* ldsB = lds + 4 * HTB + boff; asm volatile("" : "+v"(ldsA), "+v"(ldsB));
#define PG8_LD8(p) __builtin_shufflevector(*(const PG8_LAS v4i_t*)(p), *(const PG8_LAS v4i_t*)((p) + 1024), 0, 1, 2, 3, 4, 5, 6, 7)
#define PG8_LDA(dst, b, h) do { _Pragma("unroll") for (int m = 0; m < 4; ++m) dst[m] = PG8_LD8(ldsA + ((b) * 2 + (h)) * HTB + m * 2048); } while (0)
#define PG8_LDB(dst, b, h) do { _Pragma("unroll") for (int n = 0; n < 2; ++n) dst[n] = PG8_LD8(ldsB + ((b) * 2 + (h)) * HTB + n * 2048); } while (0)
#define PG8_H(X, k) __builtin_bit_cast(bf16x8, __builtin_shufflevector(X, X, 4 * (k), 4 * (k) + 1, 4 * (k) + 2, 4 * (k) + 3))
#define PG8_MMA(ai, bj, At, Bt) do { __builtin_amdgcn_s_setprio(1); _Pragma("unroll") for (int m = 0; m < 4; ++m) _Pragma("unroll") for (int n = 0; n < 2; ++n) { \
        if constexpr (F8) asm volatile("v_mfma_scale_f32_16x16x128_f8f6f4 %0, %1, %2, %0, %3, %3 op_sel_hi:[0,0,0]" : "+v"(acc[ai][bj][m][n]) : "v"(Bt[n]), "v"(At[m]), "v"(mxs));   \
        else { acc[ai][bj][m][n] = __builtin_amdgcn_mfma_f32_16x16x32_bf16(PG8_H(Bt[n], 0), PG8_H(At[m], 0), acc[ai][bj][m][n], 0, 0, 0); \
               acc[ai][bj][m][n] = __builtin_amdgcn_mfma_f32_16x16x32_bf16(PG8_H(Bt[n], 1), PG8_H(At[m], 1), acc[ai][bj][m][n], 0, 0, 0); } } __builtin_amdgcn_s_setprio(0); } while (0)
#define PG8_WAIT_V(n) asm volatile("s_waitcnt vmcnt(" #n ")" ::: "memory")
#define PG8_WAIT_L(n) asm volatile("s_waitcnt lgkmcnt(" #n ")" ::: "memory")
#define PG8_BAR __builtin_amdgcn_s_barrier()
#define PG8_SCHED __builtin_amdgcn_sched_barrier(0)
    Unit cur, nxt; int ui = 0;
    if (!S.next(0, cur)) return;
    f32x4 acc[2][2][4][2];
#pragma unroll
    for (int a = 0; a < 2; ++a)
#pragma unroll
        for (int b = 0; b < 2; ++b)
#pragma unroll
            for (int m = 0; m < 4; ++m)
#pragma unroll
                for (int n = 0; n < 2; ++n) acc[a][b][m][n] = (f32x4){0.f, 0.f, 0.f, 0.f};
    int mxs = 0x7f7f7f7f; asm volatile("" : "+v"(mxs));
    v8i_t At[4], B0[2], B1[2];
    const char* cA = (const char*)g.A + (size_t)cur.pm * tstep; const char* cB = (const char*)g.Bt + (size_t)cur.pn * tstep;
    S.a_ready(cur);
    if constexpr (SP2) {
        PG8_STAGE(PG8_SB(0, 0), cB, voffB); PG8_STAGE(PG8_SB(0, 1), cB + hstep, voffB); PG8_STAGE(PG8_SA(0, 0), cA, voffA); PG8_STAGE(PG8_SA(0, 1), cA + hstep, voffA);
        if (wr == 1) PG8_BAR;
        PG8_WAIT_V(2); PG8_BAR;
        PG8_STAGE(PG8_SB(1, 0), cB + kstep, voffB); PG8_STAGE(PG8_SA(1, 0), cA + kstep, voffA); PG8_STAGE(PG8_SB(1, 1), cB + hstep + kstep, voffB);
        PG8_WAIT_V(6); PG8_BAR;
    } else {
        PG8_STAGE(PG8_SB(0, 0), cB, voffB); PG8_STAGE(PG8_SA(0, 0), cA, voffA); PG8_STAGE(PG8_SB(0, 1), cB + hstep, voffB); PG8_STAGE(PG8_SA(0, 1), cA + hstep, voffA);
        if (wr == 1) PG8_BAR;
        PG8_WAIT_V(4); PG8_BAR;
        PG8_STAGE(PG8_SB(1, 0), cB + kstep, voffB); PG8_STAGE(PG8_SA(1, 0), cA + kstep, voffA); PG8_STAGE(PG8_SB(1, 1), cB + hstep + kstep, voffB);
        PG8_WAIT_V(6); PG8_BAR;
    }
    for (;;) {
        const bool has_next = S.next(ui + 1, nxt);
        const char* nA = has_next ? (const char*)g.A + (size_t)nxt.pm * tstep : cA; const char* nB = has_next ? (const char*)g.Bt + (size_t)nxt.pn * tstep : cB;
        for (int t = 0; t < nt; t += 2) {
            const bool last = (t == nt - 2);
            const char* a1 = cA + (size_t)(t + 1) * kstep;
            const char* a2 = last ? nA : cA + (size_t)(t + 2) * kstep; const char* b2 = last ? nB : cB + (size_t)(t + 2) * kstep;
            const char* a3 = a2 + kstep; const char* b3 = b2 + kstep;
            if (last && has_next) S.a_ready(nxt);
            if constexpr (SP2) {
            PG8_LDB(B0, 0, 0); PG8_LDB(B1, 0, 1); PG8_SCHED; PG8_LDA(At, 0, 0); PG8_STAGE(PG8_SA(1, 1), a1 + hstep, voffA);
            PG8_WAIT_V(8); PG8_WAIT_L(0); PG8_BAR; PG8_MMA(0, 0, At, B0); PG8_MMA(0, 1, At, B1); PG8_BAR; PG8_SCHED;
            PG8_LDA(At, 0, 1); PG8_STAGE(PG8_SB(0, 0), b2, voffB); PG8_STAGE(PG8_SB(0, 1), b2 + hstep, voffB); PG8_STAGE(PG8_SA(0, 0), a2, voffA);
            PG8_WAIT_V(8); PG8_WAIT_L(0); PG8_BAR; PG8_MMA(1, 0, At, B0); PG8_MMA(1, 1, At, B1); PG8_BAR; PG8_SCHED;
            PG8_LDB(B0, 1, 0); PG8_LDB(B1, 1, 1); PG8_SCHED; PG8_LDA(At, 1, 0); PG8_STAGE(PG8_SA(0, 1), a2 + hstep, voffA);
            PG8_WAIT_V(8); PG8_WAIT_L(0); PG8_BAR; PG8_MMA(0, 0, At, B0); PG8_MMA(0, 1, At, B1); PG8_BAR; PG8_SCHED;
            PG8_LDA(At, 1, 1); PG8_STAGE(PG8_SB(1, 0), b3, voffB); PG8_STAGE(PG8_SB(1, 1), b3 + hstep, voffB); PG8_STAGE(PG8_SA(1, 0), a3, voffA);
            PG8_WAIT_V(8); PG8_WAIT_L(0); PG8_BAR; PG8_MMA(1, 0, At, B0); PG8_MMA(1, 1, At, B1); PG8_BAR; PG8_SCHED;
            } else {
            PG8_LDB(B0, 0, 0); PG8_SCHED; PG8_LDA(At, 0, 0); PG8_STAGE(PG8_SA(1, 1), a1 + hstep, voffA);
            PG8_WAIT_L(8); PG8_BAR; PG8_WAIT_L(0); PG8_MMA(0, 0, At, B0); PG8_BAR; PG8_SCHED;
            PG8_LDB(B1, 0, 1); PG8_STAGE(PG8_SB(0, 0), b2, voffB);
            PG8_BAR; PG8_WAIT_L(0); PG8_MMA(0, 1, At, B1); PG8_BAR;
            PG8_LDA(At, 0, 1); PG8_STAGE(PG8_SA(0, 0), a2, voffA);
            PG8_BAR; PG8_WAIT_L(0); PG8_MMA(1, 0, At, B0); PG8_BAR; PG8_SCHED;
            PG8_STAGE(PG8_SB(0, 1), b2 + hstep, voffB);
            PG8_WAIT_V(6); PG8_BAR; PG8_MMA(1, 1, At, B1); PG8_BAR;
            PG8_LDB(B0, 1, 0); PG8_SCHED; PG8_LDA(At, 1, 0); PG8_STAGE(PG8_SA(0, 1), a2 + hstep, voffA);
            PG8_WAIT_L(8); PG8_BAR; PG8_WAIT_L(0); PG8_MMA(0, 0, At, B0); PG8_BAR; PG8_SCHED;
            PG8_LDB(B1, 1, 1); PG8_STAGE(PG8_SB(1, 0), b3, voffB);
            PG8_BAR; PG8_WAIT_L(0); PG8_MMA(0, 1, At, B1); PG8_BAR;
            PG8_LDA(At, 1, 1); PG8_STAGE(PG8_SA(1, 0), a3, voffA);
            PG8_BAR; PG8_WAIT_L(0); PG8_MMA(1, 0, At, B0); PG8_BAR; PG8_SCHED;
            PG8_STAGE(PG8_SB(1, 1), b3 + hstep, voffB);
            PG8_WAIT_V(6); PG8_BAR; PG8_MMA(1, 1, At, B1); PG8_BAR;
            }
        }
        if constexpr (F8) asm volatile("s_nop 15\n\ts_nop 7" ::: "memory");
        if constexpr (ALIGN_EPI) { if (wr == 0) PG8_BAR; }
        if constexpr (!Epi::AFTER_DRAIN) { E(acc, cur, wr, wc, fr, fq); S.done(cur); }
        if (!has_next) break;
#pragma unroll
        for (int a = 0; a < 2; ++a)
#pragma unroll
            for (int b = 0; b < 2; ++b)
#pragma unroll
                for (int m = 0; m < 4; ++m)
#pragma unroll
                    for (int n = 0; n < 2; ++n) acc[a][b][m][n] = (f32x4){0.f, 0.f, 0.f, 0.f};
        cur = nxt; cA = nA; cB = nB; ++ui;
        if constexpr (ALIGN_EPI) { if (wr == 1) PG8_BAR; }
    }
    PG8_WAIT_V(0);
    if constexpr (!ALIGN_EPI) { if (wr == 0) PG8_BAR; }
    PG8_BAR;
    if constexpr (Epi::AFTER_DRAIN) { E.fused(acc, cur, wr, wc, fr, fq, lds, wid, lane); S.done(cur); }
#undef PG8_SA
#undef PG8_SB
#undef PG8_STAGE
#undef PG8_LDA
#undef PG8_LDB
#undef PG8_MMA
#undef PG8_H
#undef PG8_LD8
#undef PG8_WAIT_V
#undef PG8_WAIT_L
#undef PG8_BAR
#undef PG8_SCHED
}
}
#define GAS __attribute__((address_space(1)))
#define LAS __attribute__((address_space(3)))
#define XB_TMO      128
#define XB_XCNT(j)  (256  + 64 * (j))
#define XB_XSUB(j)  (1280 + 64 * (j))
#define XB_XGEN(j)  (2304 + 64 * (j))
#define XB_TOP      3328
#define XB_TOPGEN   3392
#define XCD_BAR_WORDS 3456
#define XB_SPIN_CAP (1u << 18)

__device__ __forceinline__ unsigned xb_ld(unsigned* p)              { return __hip_atomic_load(p, __ATOMIC_RELAXED, __HIP_MEMORY_SCOPE_AGENT); }
__device__ __forceinline__ unsigned xb_add(unsigned* p, unsigned v) { return __hip_atomic_fetch_add(p, v, __ATOMIC_RELAXED, __HIP_MEMORY_SCOPE_AGENT); }
__device__ __forceinline__ unsigned xb_xcc_id() { return (unsigned)__builtin_amdgcn_s_getreg((3 << 11) | 20) & 0xFu; }
#define XB_SPIN(cond, bar) do { unsigned _sp = 0; while (cond) { __builtin_amdgcn_s_sleep(1); \
    if ((++_sp & 255u) == 0u) { if (xb_ld(&(bar)[XB_TMO])) break; if (_sp > XB_SPIN_CAP) { atomicAdd(&(bar)[XB_TMO], 1u); break; } } } } while (0)

struct XcdBarrier {
    unsigned* bar; unsigned x;
    volatile LAS unsigned* st;
};

__device__ __forceinline__ XcdBarrier xcd_barrier_post(unsigned* bar, volatile LAS unsigned* st) {
    XcdBarrier b; b.bar = bar; b.x = xb_xcc_id(); b.st = st;
    if (threadIdx.x == 0) (void)xb_add(&bar[XB_XCNT(b.x)], 1u);
    return b;
}
__device__ __forceinline__ void xcd_barrier_complete(unsigned* bar, unsigned x, unsigned& nloc, unsigned& nx) {
    const unsigned G = gridDim.x * gridDim.y * gridDim.z;
    unsigned sum, cnt, mine, sp = 0u;
    for (;;) {
        sum = 0u; cnt = 0u; mine = 0u;
#pragma unroll
        for (unsigned j = 0; j < 16; ++j) { const unsigned c = xb_ld(&bar[XB_XCNT(j)]); sum += c; cnt += (c > 0u) ? 1u : 0u; mine = (j == x) ? c : mine; }
        if (sum == G) break;
        __builtin_amdgcn_s_sleep(1);
        if ((++sp & 255u) == 0u) { if (xb_ld(&bar[XB_TMO])) break; if (sp > XB_SPIN_CAP) { atomicAdd(&bar[XB_TMO], 1u); break; } }
    }
    nloc = mine > 0u ? mine : 1u; nx = cnt > 0u ? cnt : 1u;
}

__device__ __forceinline__ void xcd_barrier(const XcdBarrier& b) {
    asm volatile("s_waitcnt vmcnt(0)" ::: "memory");
    __syncthreads();
    if (threadIdx.x == 0) {
        unsigned* bar = b.bar;
        __builtin_amdgcn_s_waitcnt(0);
        unsigned nloc = b.st[0], nx = b.st[1];
        if (nloc == 0u) { xcd_barrier_complete(bar, b.x, nloc, nx); b.st[0] = nloc; b.st[1] = nx; }
        const unsigned old = xb_add(&bar[XB_XSUB(b.x)], 1u);
        const unsigned gen = old / nloc;
        if (old + 1u == (gen + 1u) * nloc) {
            __builtin_amdgcn_fence(__ATOMIC_RELEASE, "agent");
            asm volatile("s_waitcnt vmcnt(0)" ::: "memory");
            const unsigned og = xb_add(&bar[XB_TOP], 1u);
            const unsigned tg = og / nx;
            if (og + 1u == (tg + 1u) * nx) xb_add(&bar[XB_TOPGEN], 1u);
            else XB_SPIN(xb_ld(&bar[XB_TOPGEN]) == tg, bar);
            __builtin_amdgcn_fence(__ATOMIC_ACQUIRE, "agent");
            xb_add(&bar[XB_XGEN(b.x)], 1u);
            asm volatile("s_waitcnt vmcnt(0)" ::: "memory");
        } else {
            XB_SPIN(xb_ld(&bar[XB_XGEN(b.x)]) == gen, bar);
            __builtin_amdgcn_fence(__ATOMIC_ACQUIRE, "agent");
            asm volatile("s_waitcnt vmcnt(0)" ::: "memory");
        }
    }
    __syncthreads();
}

#ifndef MK_SPLIT
#define MK_SPLIT 0
#endif
#ifndef P8_NP
#define P8_NP 4
#endif
constexpr int NWAVES = 8;
constexpr int NB = 2, SEQ = 4096, DM = 2048, T = NB * SEQ, HD = 128;
constexpr int INW = 10240;
constexpr int C_QA = 0, C_KA = 1024, C_VA = 1280, C_QB = 1536, C_KB = 3072, C_VB = 4608, C_GA = 6144, C_GB = 8192;
constexpr int AQW = 1024, BOW = 512;
constexpr int NEXP = 16384, PHEADS = 8, NKEYS = 128, TOPK = 16;
constexpr int NBIAS = 20;
constexpr float EPS = 1e-6f;
constexpr float SM_SCALE = 0.088388347648318440f;
constexpr float LOG2E = 1.4426950408889634f;
constexpr float A_SCALE = 16.f;
constexpr float M_SCALE = 64.f;
constexpr float W_SCALE = 512.f;

constexpr size_t MiB = 1u << 20;
constexpr size_t WS_CTL = 0, CTL_ZERO_BYTES = 16384;
constexpr size_t WS_WIN = 1 * MiB;
constexpr size_t WS_WOA = 41 * MiB;
constexpr size_t WS_WOB = 45 * MiB;
constexpr size_t WS_WOUT = 47 * MiB;
constexpr size_t WS_W2 = 55 * MiB;
constexpr size_t WS_U = 63 * MiB;
constexpr size_t WS_V = 95 * MiB;
constexpr size_t WS_ESC = 127 * MiB;
constexpr size_t WS_PROJ = 191 * MiB;
constexpr size_t WS_SC = WS_PROJ;
constexpr size_t WS_H = 351 * MiB;
constexpr size_t WS_MRG = WS_H;
constexpr size_t WS_ATTA = 383 * MiB;
constexpr size_t WS_OB = 399 * MiB;
constexpr size_t WS_X1B = WS_ATTA;
constexpr size_t WS_ATTB = 423 * MiB;
constexpr size_t WS_LSE = 431 * MiB;
constexpr size_t WS_PART = 432 * MiB;
constexpr size_t WS_TKI = 433 * MiB;
constexpr size_t WS_TKG = 437 * MiB;
constexpr size_t WS_MRG8 = 441 * MiB;
constexpr size_t WS_END = 457 * MiB;
constexpr int CW_BAR = 0;

constexpr int RING_OFF = 0, RING_BYTES = 131072;
constexpr int LDSCTL_OFF = RING_BYTES, MISC_OFF = LDSCTL_OFF + 320;
constexpr int RSTD_OFF = RING_BYTES + 1024;
constexpr int LDS_BYTES = 147456;
static_assert(RSTD_OFF + 1024 <= LDS_BYTES && XCD_BAR_WORDS * 4 <= (int)CTL_ZERO_BYTES, "maps");

typedef unsigned short bf16;
typedef unsigned v4u __attribute__((ext_vector_type(4)));
typedef unsigned v2u __attribute__((ext_vector_type(2)));
typedef float f32x4 __attribute__((ext_vector_type(4)));
typedef float f32x16 __attribute__((ext_vector_type(16)));
typedef short bf16x8 __attribute__((ext_vector_type(8)));
typedef short s16x4 __attribute__((ext_vector_type(4)));
typedef __bf16 bf16x2 __attribute__((ext_vector_type(2)));
#define LDS_WAIT() asm volatile("s_waitcnt lgkmcnt(0)" ::: "memory")
#define VM_WAIT() asm volatile("s_waitcnt vmcnt(0)" ::: "memory")
#define SBAR() __builtin_amdgcn_sched_barrier(0)
__device__ __forceinline__ unsigned cvtpk(float lo, float hi) { unsigned r; asm volatile("v_cvt_pk_bf16_f32 %0, %1, %2" : "=v"(r) : "v"(lo), "v"(hi)); return r; }
__device__ __forceinline__ float bflo(unsigned w) { return __builtin_bit_cast(float, w << 16); }
__device__ __forceinline__ float bfhi(unsigned w) { return __builtin_bit_cast(float, w & 0xffff0000u); }
__device__ __forceinline__ float dot2_bf16(unsigned w, unsigned x, float acc) { return __builtin_amdgcn_fdot2_f32_bf16(__builtin_bit_cast(bf16x2, w), __builtin_bit_cast(bf16x2, x), acc, false); }
__device__ __forceinline__ float wave_sum(float v) {
#pragma unroll
    for (int o = 1; o < 64; o <<= 1) v += __shfl_xor(v, o);
    return v;
}

struct Lane { int tid, lane, wave, gw; };
__device__ __forceinline__ Lane lane_state() { int t = threadIdx.x; asm volatile("" : "+v"(t)); Lane L; L.tid = t; L.lane = t & 63; L.wave = __builtin_amdgcn_readfirstlane(t >> 6); L.gw = blockIdx.x * 8 + L.wave; return L; }
struct Frame {
    LAS unsigned char* lds; char* ldsg;
    int G, NGW;
    const float *x, *rel_bias, *g_mix, *w_in, *sink_a, *w_oa, *w_ob, *w_out, *g_ffn, *w_pq, *keys, *eu, *ev, *g_fin;
    float* out; unsigned char* ws;
};

__device__ __forceinline__ unsigned pk4_fp8(float a, float b, float c, float d) { int p = __builtin_amdgcn_cvt_pk_fp8_f32(fminf(fmaxf(a, -448.f), 448.f), fminf(fmaxf(b, -448.f), 448.f), 0, false);
    return (unsigned)__builtin_amdgcn_cvt_pk_fp8_f32(fminf(fmaxf(c, -448.f), 448.f), fminf(fmaxf(d, -448.f), 448.f), p, true); }
__device__ __forceinline__ void p0_transpose_item_f8(const float* W, int K, int N, unsigned char* WT, float scale, LAS float* scr, int item, int lane) {
    const int nblk = N / 32, kb = item / nblk, nb = item % nblk, k0 = 64 * kb, n0 = 32 * nb;
    { f32x4 v[8];
#pragma unroll
      for (int i = 0; i < 8; ++i) v[i] = *(const f32x4*)(W + (size_t)(k0 + 8 * i + (lane >> 3)) * N + n0 + 4 * (lane & 7));
#pragma unroll
      for (int i = 0; i < 8; ++i) { LAS float* d = scr + (8 * i + (lane >> 3)) * 33 + 4 * (lane & 7); d[0] = v[i][0] * scale; d[1] = v[i][1] * scale; d[2] = v[i][2] * scale; d[3] = v[i][3] * scale; } }
    LDS_WAIT(); asm volatile("" ::: "memory");
    const int c = lane & 7;
#pragma unroll
    for (int j = 0; j < 4; ++j) { const int n = (lane >> 3) + 8 * j; const LAS float* s = scr + (8 * c) * 33 + n;
        v2u o; o.x = pk4_fp8(s[0 * 33], s[1 * 33], s[2 * 33], s[3 * 33]); o.y = pk4_fp8(s[4 * 33], s[5 * 33], s[6 * 33], s[7 * 33]);
        *(v2u*)(WT + (size_t)(n0 + n) * K + k0 + 8 * c) = o; }
    LDS_WAIT(); asm volatile("" ::: "memory");
}
__device__ __forceinline__ void p0_transpose_item(const float* W, int K, int N, bf16* WT, LAS float* scr, int item, int lane) {
    const int nblk = N / 32, kb = item / nblk, nb = item % nblk, k0 = 64 * kb, n0 = 32 * nb;
    { f32x4 v[8];
#pragma unroll
      for (int i = 0; i < 8; ++i) v[i] = *(const f32x4*)(W + (size_t)(k0 + 8 * i + (lane >> 3)) * N + n0 + 4 * (lane & 7));
#pragma unroll
      for (int i = 0; i < 8; ++i) { LAS float* d = scr + (8 * i + (lane >> 3)) * 33 + 4 * (lane & 7); d[0] = v[i][0]; d[1] = v[i][1]; d[2] = v[i][2]; d[3] = v[i][3]; } }
    LDS_WAIT(); asm volatile("" ::: "memory");
    const int c = lane & 7;
#pragma unroll
    for (int j = 0; j < 4; ++j) { const int n = (lane >> 3) + 8 * j; const LAS float* s = scr + (8 * c) * 33 + n;
        v4u o; o.x = cvtpk(s[0 * 33], s[1 * 33]); o.y = cvtpk(s[2 * 33], s[3 * 33]); o.z = cvtpk(s[4 * 33], s[5 * 33]); o.w = cvtpk(s[6 * 33], s[7 * 33]);
        *(v4u*)(WT + (size_t)(n0 + n) * K + k0 + 8 * c) = o; }
    LDS_WAIT(); asm volatile("" ::: "memory");
}
__device__ __forceinline__ void p0_w2_item(Frame& F, bf16* W2T, int item, int tid) {
    const int hc = item >> 5, j0 = (item & 31) * 64;
    LAS float* Ks = (LAS float*)F.lds; LAS float* Ws = Ks + 128 * 129;
    const f32x4* kp = (const f32x4*)(F.keys + (size_t)hc * 16384);
#pragma unroll
    for (int q = 0; q < 8; ++q) { const int idx = tid + 512 * q, row = idx >> 5, c4 = idx & 31; const f32x4 v = kp[idx];
        LAS float* d = Ks + row * 129 + c4 * 4; d[0] = v[0]; d[1] = v[1]; d[2] = v[2]; d[3] = v[3]; }
#pragma unroll
    for (int q = 0; q < 4; ++q) { const int idx = tid + 512 * q, row = idx >> 5, c4 = idx & 31; const f32x4 v = *(const f32x4*)(F.w_pq + (size_t)(j0 + row) * DM + hc * 128 + c4 * 4);
        LAS float* d = Ws + row * 129 + c4 * 4; d[0] = v[0]; d[1] = v[1]; d[2] = v[2]; d[3] = v[3]; }
    __syncthreads();
    { const int wv = tid >> 6, ln = tid & 63, kt = wv & 3, jt = wv >> 2, r = ln & 31, h2 = ln >> 5;
      const LAS float* ap = Ks + (kt * 32 + r) * 129 + h2; const LAS float* bp = Ws + (jt * 32 + r) * 129 + h2;
      f32x16 acc = {};
#pragma unroll 8
      for (int d0 = 0; d0 < 128; d0 += 2) acc = __builtin_amdgcn_mfma_f32_32x32x2f32(ap[d0], bp[d0], acc, 0, 0, 0);
      const int j = j0 + jt * 32 + r; const float g = F.g_ffn[j];
#pragma unroll
      for (int q = 0; q < 16; ++q) { const int k = kt * 32 + (q & 3) + 8 * (q >> 2) + 4 * h2; const float v = acc[q] * g;
          W2T[(size_t)(hc * 128 + k) * DM + j] = (bf16)(cvtpk(v, v) & 0xffffu); } }
    __syncthreads();
}
__device__ __forceinline__ void p0_prologue(Frame& F) {
    const Lane Ls = lane_state();
    LAS float* scr = (LAS float*)(F.lds + RING_OFF + Ls.wave * 16384);
    bf16* WinT = (bf16*)(F.ws + WS_WIN); bf16* WoaT = (bf16*)(F.ws + WS_WOA); bf16* WobT = (bf16*)(F.ws + WS_WOB); bf16* WoutT = (bf16*)(F.ws + WS_WOUT);
    constexpr int I_IN = (DM / 64) * (INW / 32), I_OA = (AQW / 64) * (DM / 32), I_OB = (BOW / 64) * (DM / 32), I_OUT = (DM / 64) * (DM / 32);
    constexpr int NITEMS = I_IN + I_OA + I_OB + I_OUT;
    for (int it = Ls.gw; it < NITEMS; it += F.NGW) {
        int r = it;
        if (r < I_IN) { p0_transpose_item_f8(F.w_in, DM, INW, (unsigned char*)WinT, W_SCALE, scr, r, Ls.lane); continue; } r -= I_IN;
        if (r < I_OA) { p0_transpose_item_f8(F.w_oa, AQW, DM, (unsigned char*)WoaT, W_SCALE, scr, r, Ls.lane); continue; } r -= I_OA;
        if (r < I_OB) { p0_transpose_item_f8(F.w_ob, BOW, DM, (unsigned char*)WobT, W_SCALE, scr, r, Ls.lane); continue; } r -= I_OB;
        p0_transpose_item_f8(F.w_out, DM, DM, (unsigned char*)WoutT, W_SCALE, scr, r, Ls.lane);
    }
    __syncthreads();
    for (int it = blockIdx.x; it < 512; it += F.G) p0_w2_item(F, (bf16*)(F.ws + WS_W2), it, Ls.tid);
    { unsigned char* U8 = F.ws + WS_U; float* esc = (float*)(F.ws + WS_ESC);
      static_assert(WS_V == WS_U + (size_t)NEXP * DM, "table map");
      for (int row = Ls.gw; row < 2 * NEXP; row += F.NGW) {
          const float* src = row < NEXP ? F.eu + (size_t)row * DM : F.ev + (size_t)(row - NEXP) * DM;
          f32x4 v[8]; float am = 0.f;
#pragma unroll
          for (int jj = 0; jj < 2; ++jj)
#pragma unroll
              for (int q = 0; q < 4; ++q) { v[4 * jj + q] = *(const f32x4*)(src + 1024 * jj + 16 * Ls.lane + 4 * q);
                  am = fmaxf(am, fmaxf(fmaxf(fabsf(v[4 * jj + q][0]), fabsf(v[4 * jj + q][1])), fmaxf(fabsf(v[4 * jj + q][2]), fabsf(v[4 * jj + q][3])))); }
#pragma unroll
          for (int o = 1; o < 64; o <<= 1) am = fmaxf(am, __shfl_xor(am, o));
          const float inv = am > 0.f ? 400.f / am : 0.f;
#pragma unroll
          for (int jj = 0; jj < 2; ++jj) { v4u w;
#pragma unroll
              for (int q = 0; q < 4; ++q) { const f32x4 t = v[4 * jj + q] * inv; int pk = __builtin_amdgcn_cvt_pk_fp8_f32(t[0], t[1], 0, false); pk = __builtin_amdgcn_cvt_pk_fp8_f32(t[2], t[3], pk, true); w[q] = (unsigned)pk; }
              { const int d0 = 1024 * jj + 16 * Ls.lane, P8_PBc = 2048 / P8_NP;
                *(v4u*)(U8 + (size_t)(row >= NEXP) * ((size_t)NEXP * DM) + (size_t)(d0 / P8_PBc) * ((size_t)NEXP * P8_PBc) + (size_t)(row & (NEXP - 1)) * P8_PBc + (d0 % P8_PBc)) = w; } }
          if (Ls.lane == 0) esc[row] = am * (1.f / 400.f);
      } }
    { bf16* Hb = (bf16*)(F.ws + WS_H);
      for (int m = Ls.gw; m < T; m += F.NGW) {
          const f32x4* xr = (const f32x4*)(F.x + (size_t)m * DM) + Ls.lane; f32x4 v[8]; float s = 0.f;
#pragma unroll
          for (int j = 0; j < 8; ++j) { v[j] = xr[64 * j]; s += (v[j][0] * v[j][0] + v[j][1] * v[j][1]) + (v[j][2] * v[j][2] + v[j][3] * v[j][3]); }
          const float rstd = rsqrtf(wave_sum(s) * (1.f / DM) + EPS);
          unsigned* o4 = (unsigned*)((unsigned char*)Hb + (size_t)m * DM) + Ls.lane;
#pragma unroll
          for (int j = 0; j < 8; ++j) { const f32x4 g = ((const f32x4*)F.g_mix)[Ls.lane + 64 * j];
              o4[64 * j] = pk4_fp8(v[j][0] * rstd * g[0], v[j][1] * rstd * g[1], v[j][2] * rstd * g[2], v[j][3] * rstd * g[3]); } } }
}

namespace att {
#define KSWZ(row, colB) ((row) * 256 + ((colB) ^ (((row) & 7) << 4)))
__device__ __forceinline__ int crow(int r, int hi) { return (r & 3) + 8 * (r >> 2) + 4 * hi; }
__device__ __forceinline__ void qkt(f32x16& p0, f32x16& p1, const char* Ks, const bf16x8* qr, int r32, int hi) {
    p0 = f32x16{}; p1 = f32x16{};
#pragma unroll
    for (int d0 = 0; d0 < 8; ++d0) { const int cb = (d0 * 16 + hi * 8) * 2;
        const bf16x8 b0 = *reinterpret_cast<const bf16x8*>(Ks + KSWZ(r32, cb));
        const bf16x8 b1 = *reinterpret_cast<const bf16x8*>(Ks + KSWZ(32 + r32, cb));
        p0 = __builtin_amdgcn_mfma_f32_32x32x16_bf16(b0, qr[d0], p0, 0, 0, 0);
        p1 = __builtin_amdgcn_mfma_f32_32x32x16_bf16(b1, qr[d0], p1, 0, 0, 0); }
}
__device__ __forceinline__ int v_st(int k, int c) { const int kk = (k & ~0xC) | ((k & 4) << 1) | ((k & 8) >> 1); return ((kk >> 3) * 4 + (c >> 5)) * 512 + ((kk & 7) * 32 + (c & 31)) * 2; }
__device__ __forceinline__ int v_rd_base(int lane) { return ((lane & 3) << 3) | (((lane >> 2) & 3) << 6) | (((lane >> 4) & 1) << 5) | (((lane >> 5) & 1) << 8); }
constexpr int v_rd_off(int d0, int ks, int half) { return d0 * 512 + ks * 4096 + half * 2048; }
template <int OFF> __device__ __forceinline__ s16x4 tr_read(int vb) {
    s16x4 r; asm volatile("ds_read_b64_tr_b16 %0, %1 offset:%2" : "=&v"(r) : "v"(vb), "i"(OFF) : "memory"); return r;
}
template <int D0> __device__ __forceinline__ void pv_one(f32x16& od, int vb, bf16x8 pa0, bf16x8 pa1, bf16x8 pa2, bf16x8 pa3) {
    const s16x4 l0 = tr_read<v_rd_off(D0, 0, 0)>(vb), h0 = tr_read<v_rd_off(D0, 0, 1)>(vb), l1 = tr_read<v_rd_off(D0, 1, 0)>(vb), h1 = tr_read<v_rd_off(D0, 1, 1)>(vb);
    const s16x4 l2 = tr_read<v_rd_off(D0, 2, 0)>(vb), h2 = tr_read<v_rd_off(D0, 2, 1)>(vb), l3 = tr_read<v_rd_off(D0, 3, 0)>(vb), h3 = tr_read<v_rd_off(D0, 3, 1)>(vb);
    asm volatile("s_waitcnt lgkmcnt(0)" ::: "memory"); SBAR();
#define PK(L, H) (bf16x8){L[0], L[1], L[2], L[3], H[0], H[1], H[2], H[3]}
    od = __builtin_amdgcn_mfma_f32_32x32x16_bf16(pa0, PK(l0, h0), od, 0, 0, 0);
    od = __builtin_amdgcn_mfma_f32_32x32x16_bf16(pa1, PK(l1, h1), od, 0, 0, 0);
    od = __builtin_amdgcn_mfma_f32_32x32x16_bf16(pa2, PK(l2, h2), od, 0, 0, 0);
    od = __builtin_amdgcn_mfma_f32_32x32x16_bf16(pa3, PK(l3, h3), od, 0, 0, 0);
#undef PK
}
__device__ __forceinline__ void pv_d0(f32x16* o, int vb, bf16x8 pa0, bf16x8 pa1, bf16x8 pa2, bf16x8 pa3) {
    pv_one<0>(o[0], vb, pa0, pa1, pa2, pa3); pv_one<1>(o[1], vb, pa0, pa1, pa2, pa3); pv_one<2>(o[2], vb, pa0, pa1, pa2, pa3); pv_one<3>(o[3], vb, pa0, pa1, pa2, pa3);
}
__device__ __forceinline__ int t5_bucket(int rel) {
    const int n = rel < 0 ? -rel : rel; int b;
    if (n < 8) b = n; else { b = 8 + (n >= 15) + (n >= 27) + (n >= 50) + (n >= 91) + (n >= 166) + (n >= 305) + (n >= 559); b = b > 15 ? 15 : b; }
    return b + (rel > 0 ? 16 : 0);
}
constexpr int ATT_WS_OFF = RSTD_OFF + 1024, ATT_BT_OFF = ATT_WS_OFF + 2048;
static_assert(ATT_BT_OFF + 2 * 1040 <= LDS_BYTES, "attention scratch above the stage region");
template <int W, bool SINK>
__device__ __forceinline__ void attn_unit(char* lds, const bf16* proj, int b, int qcol, int kcol, int vcol, int d, int r, int m0u,
                                          const float* bias_col, float sinkv, bf16* O, int ldo, int ocol, float* lse, int lse_j) {
    int tid_ = threadIdx.x; asm volatile("" : "+v"(tid_));
    const int tid = tid_, wid = __builtin_amdgcn_readfirstlane(tid >> 6), lane = tid & 63, r32 = lane & 31, hi = lane >> 5;
    const int hh = wid >> 2, wq = wid & 3, htid = tid & 255;
    constexpr int NT = (128 + 2 * W) / 64;
    const int L = SEQ / d, m0 = m0u + 128 * hh;
    char* hbase = lds + hh * 65536;
    float* ws = (float*)(lds + ATT_WS_OFF) + wid * 64; float* li_l = ws; float* al_l = ws + 32;
    float* btab = (float*)(lds + ATT_BT_OFF + hh * 1040);
    __syncthreads();
    for (int i = htid; i <= 2 * W; i += 256) btab[i] = bias_col[t5_bucket((i - W) * d) * NBIAS];
    const int qm = m0 + wq * 32 + r32;
    const size_t tok0 = (size_t)b * SEQ + r;
    bf16x8 qr[8];
    { const bf16* Qw = proj + (tok0 + (size_t)qm * d) * INW + qcol + hi * 8;
#pragma unroll
      for (int d0 = 0; d0 < 8; ++d0) qr[d0] = *reinterpret_cast<const bf16x8*>(Qw + d0 * 16); }
    float m_run = SINK ? sinkv : -1e29f, l_run = SINK ? 1.f : 0.f;
    f32x16 o[4] = {};
    const int sr = htid >> 4, sc = (htid & 15) * 8;
    const int t_lo = wq >> 1, t_hi = (32 * wq + 31 + 2 * W) >> 6;
    bf16x8 vs[4], ks[4];
#define SLOAD(t) do { const int tm = m0 - W + 64 * (t); if (tm + 63 >= 0 && tm < L) { _Pragma("unroll") for (int i_ = 0; i_ < 4; ++i_) { int k_ = tm + sr + 16 * i_; k_ = k_ < 0 ? 0 : (k_ > L - 1 ? L - 1 : k_); \
        const bf16* p_ = proj + (tok0 + (size_t)k_ * d) * INW + sc; vs[i_] = *reinterpret_cast<const bf16x8*>(p_ + vcol); ks[i_] = *reinterpret_cast<const bf16x8*>(p_ + kcol); } } } while (0)
#define SWRITE(t) do { const int tm = m0 - W + 64 * (t); if (tm + 63 >= 0 && tm < L) { char* vb_ = hbase + ((t) & 1) * 32768; char* kb_ = vb_ + 16384; _Pragma("unroll") for (int i_ = 0; i_ < 4; ++i_) { \
        *(bf16x8*)(vb_ + v_st(sr + 16 * i_, sc)) = vs[i_]; *(bf16x8*)(kb_ + KSWZ(sr + 16 * i_, sc * 2)) = ks[i_]; } } } while (0)
    SLOAD(0);
#pragma unroll 1
    for (int t = 0; t < NT; ++t) {
        SWRITE(t);
        __syncthreads();
        if (t + 1 < NT) SLOAD(t + 1);
        const int tm0 = m0 - W + 64 * t;
        if (t >= t_lo && t <= t_hi && tm0 + 63 >= 0 && tm0 < L) {
            const char* V_lds = hbase + (t & 1) * 32768; const char* K_lds = V_lds + 16384;
            const int vb0 = (int)(uintptr_t)V_lds + v_rd_base(lane);
            f32x16 p0, p1; qkt(p0, p1, K_lds, qr, r32, hi);
            const int base = tm0 - qm + W;
            float pmax = -1e30f;
#pragma unroll
            for (int q = 0; q < 16; ++q) { const int key = crow(q, hi), idx = base + key, km = tm0 + key;
                const bool ok = (unsigned)idx <= (unsigned)(2 * W) && (unsigned)km < (unsigned)L;
                const float bv = btab[ok ? idx : 0]; const float s = ok ? fmaf(p0[q], SM_SCALE, bv) : -1e30f; p0[q] = s; pmax = fmaxf(pmax, s); }
#pragma unroll
            for (int q = 0; q < 16; ++q) { const int key = 32 + crow(q, hi), idx = base + key, km = tm0 + key;
                const bool ok = (unsigned)idx <= (unsigned)(2 * W) && (unsigned)km < (unsigned)L;
                const float bv = btab[ok ? idx : 0]; const float s = ok ? fmaf(p1[q], SM_SCALE, bv) : -1e30f; p1[q] = s; pmax = fmaxf(pmax, s); }
            { auto rr = __builtin_amdgcn_permlane32_swap(__float_as_uint(pmax), __float_as_uint(pmax), false, false);
              pmax = fmaxf(__uint_as_float(rr[0]), __uint_as_float(rr[1])); }
            const float mn = fmaxf(m_run, pmax), alpha = __builtin_amdgcn_exp2f((m_run - mn) * LOG2E); m_run = mn;
            const float mnc = -mn * LOG2E; float ps = 0.f;
#pragma unroll
            for (int q = 0; q < 16; ++q) { p0[q] = __builtin_amdgcn_exp2f(fmaf(p0[q], LOG2E, mnc)); ps += p0[q]; }
#pragma unroll
            for (int q = 0; q < 16; ++q) { p1[q] = __builtin_amdgcn_exp2f(fmaf(p1[q], LOG2E, mnc)); ps += p1[q]; }
            { auto rr = __builtin_amdgcn_permlane32_swap(__float_as_uint(ps), __float_as_uint(ps), false, false);
              ps = __uint_as_float(rr[0]) + __uint_as_float(rr[1]); }
            l_run = l_run * alpha + ps;
            if (__any(alpha < 1.f)) { if (hi == 0) al_l[r32] = alpha; asm volatile("s_waitcnt lgkmcnt(0)" ::: "memory");
#pragma unroll
                for (int dd = 0; dd < 4; ++dd)
#pragma unroll
                    for (int q = 0; q < 16; ++q) o[dd][q] *= al_l[crow(q, hi)]; }
            bf16x8 pa0, pa1, pa2, pa3;
#define PK4(P, BASE, OUT) do { unsigned a0 = cvtpk(P[BASE + 0], P[BASE + 1]), a1 = cvtpk(P[BASE + 2], P[BASE + 3]);   \
    unsigned b0 = cvtpk(P[BASE + 4], P[BASE + 5]), b1 = cvtpk(P[BASE + 6], P[BASE + 7]);                              \
    auto r0 = __builtin_amdgcn_permlane32_swap(a0, b0, false, false); auto r1 = __builtin_amdgcn_permlane32_swap(a1, b1, false, false); \
    v4u w = {r0[0], r1[0], r0[1], r1[1]}; OUT = *reinterpret_cast<bf16x8*>(&w); } while (0)
            PK4(p0, 0, pa0); PK4(p0, 8, pa1); PK4(p1, 0, pa2); PK4(p1, 8, pa3);
#undef PK4
            pv_d0(o, vb0, pa0, pa1, pa2, pa3);
        }
    }
#undef SLOAD
#undef SWRITE
    if (hi == 0) li_l[r32] = l_run; asm volatile("s_waitcnt lgkmcnt(0)" ::: "memory");
    if (!SINK && hi == 0) lse[(tok0 + (size_t)qm * d) * 4 + lse_j] = m_run + __logf(l_run);
    __syncthreads();
    if constexpr (SINK) {
      char* ost = lds + wid * 8704; unsigned char* O8 = (unsigned char*)O;
#pragma unroll
      for (int q = 0; q < 16; ++q) { const float rl = __builtin_amdgcn_rcpf(li_l[crow(q, hi)]) * A_SCALE; unsigned char* orow = (unsigned char*)(ost + crow(q, hi) * 144) + r32;
#pragma unroll
          for (int dd = 0; dd < 4; ++dd) { const float v = fminf(fmaxf(o[dd][q] * rl, -448.f), 448.f); orow[dd * 32] = (unsigned char)(__builtin_amdgcn_cvt_pk_fp8_f32(v, v, 0, false) & 0xff); } }
      asm volatile("s_waitcnt lgkmcnt(0)" ::: "memory");
      const int rr = lane >> 3, cc = lane & 7;
#pragma unroll
      for (int k = 0; k < 4; ++k) { const int row = rr + 8 * k; const v4u w = *(const v4u*)(ost + row * 144 + cc * 16);
          *(v4u*)(O8 + (tok0 + (size_t)(m0 + wq * 32 + row) * d) * ldo + ocol + cc * 16) = w; }
    } else {
      char* ost = lds + wid * 8704;
#pragma unroll
      for (int q = 0; q < 16; ++q) { const float rl = __builtin_amdgcn_rcpf(li_l[crow(q, hi)]); unsigned short* orow = (unsigned short*)(ost + crow(q, hi) * 272) + r32;
#pragma unroll
          for (int dd = 0; dd < 4; ++dd) { const float v = o[dd][q] * rl; orow[dd * 32] = (unsigned short)(cvtpk(v, v) & 0xffffu); } }
      asm volatile("s_waitcnt lgkmcnt(0)" ::: "memory");
      const int rr = lane >> 4, cc = lane & 15;
#pragma unroll
      for (int k = 0; k < 8; ++k) { const int row = rr + 4 * k; const v4u w = *(const v4u*)(ost + row * 272 + cc * 16);
          *(v4u*)(O + (tok0 + (size_t)(m0 + wq * 32 + row) * d) * ldo + ocol + cc * 8) = w; } }
}
}

__device__ __forceinline__ void p2_attention(Frame& F) {
    const bf16* proj = (const bf16*)(F.ws + WS_PROJ);
    bf16* attA = (bf16*)(F.ws + WS_ATTA); bf16* oB = (bf16*)(F.ws + WS_OB); float* lseB = (float*)(F.ws + WS_LSE);
    const int vcu = (F.G & 7) ? (int)blockIdx.x : (int)(blockIdx.x & 7) * (F.G >> 3) + (int)(blockIdx.x >> 3);
    const bool bal = F.G == 256; const int nmine = bal ? (vcu < 128 ? 2 : 3) : (640 - vcu + F.G - 1) / F.G;
    for (int ui = 0; ui < nmine; ++ui) { const int uid = bal ? (vcu < 128 ? 2 * vcu + ui : 256 + 3 * (vcu - 128) + ui) : vcu + ui * F.G;
        if (uid < 256) {
            const int b = uid >> 7, rem = uid & 127, blk = rem >> 3, hq = rem & 7, kvh = hq >> 2;
            att::attn_unit<128, true>(F.ldsg, proj, b, C_QA + hq * HD, C_KA + kvh * HD, C_VA + kvh * HD, 1, 0, blk * 256,
                                      F.rel_bias + hq, F.sink_a[hq], attA, AQW, hq * HD, nullptr, 0);
        } else {
            const int u2 = uid - 256, gi = u2 >> 7, rem = u2 & 127, b = rem >> 6, blk = (rem >> 2) & 15, j = rem & 3;
            const int d = gi == 0 ? 1 : (gi == 1 ? 4 : 16), nbr = 16 / d, r = blk / nbr, m0 = (blk % nbr) * 256, hb = gi * 4 + j;
            att::attn_unit<64, false>(F.ldsg, proj, b, C_QB + hb * HD, C_KB + hb * HD, C_VB + hb * HD, d, r, m0,
                                      F.rel_bias + 8 + hb, 0.f, oB + (size_t)gi * T * BOW, BOW, j * HD, lseB + (size_t)gi * T * 4, j);
        }
    }
}
__device__ __forceinline__ void p3_combine(Frame& F) {
    const Lane Ls = lane_state();
    const bf16* oB = (const bf16*)(F.ws + WS_OB); const float* lseB = (const float*)(F.ws + WS_LSE); bf16* attB = (bf16*)(F.ws + WS_ATTB);
    for (int t = Ls.gw; t < T; t += F.NGW) {
        const int j = Ls.lane >> 4;
        const float l0 = lseB[(size_t)t * 4 + j], l1 = lseB[(size_t)(T + t) * 4 + j], l2 = lseB[(size_t)(2 * T + t) * 4 + j];
        const float mx = fmaxf(l0, fmaxf(l1, l2)); const float e0 = __expf(l0 - mx), e1 = __expf(l1 - mx), e2 = __expf(l2 - mx); const float inv = 1.f / (e0 + e1 + e2);
        const float w0 = e0 * inv, w1 = e1 * inv, w2 = e2 * inv;
        const v4u a = *(const v4u*)(oB + (size_t)t * BOW + Ls.lane * 8), bq = *(const v4u*)(oB + ((size_t)T + t) * BOW + Ls.lane * 8), c = *(const v4u*)(oB + ((size_t)2 * T + t) * BOW + Ls.lane * 8);
        float cv[8];
#pragma unroll
        for (int k = 0; k < 4; ++k) { cv[2 * k] = (w0 * bflo(a[k]) + w1 * bflo(bq[k]) + w2 * bflo(c[k])) * A_SCALE; cv[2 * k + 1] = (w0 * bfhi(a[k]) + w1 * bfhi(bq[k]) + w2 * bfhi(c[k])) * A_SCALE; }
        v2u o; o.x = pk4_fp8(cv[0], cv[1], cv[2], cv[3]); o.y = pk4_fp8(cv[4], cv[5], cv[6], cv[7]);
        *(v2u*)((unsigned char*)attB + (size_t)t * BOW + Ls.lane * 8) = o;
    }
}

__device__ __forceinline__ float gelu_erf(float v) {
    const float av = fabsf(v), t = __builtin_amdgcn_rcpf(fmaf(av, 0.2316418882f, 1.0f));
    float q = fmaf(t, 0.5307027145f, -0.7265760135f); q = fmaf(q, t, 0.7107068705f); q = fmaf(q, t, -0.142248368f); q = fmaf(q, t, 0.127414796f); q = q * t;
    const float e = __builtin_amdgcn_exp2f(v * v * -0.72134752044f);
    const float m = v * (q * e);
    return v < 0.f ? m : v - m;
}
typedef float f32x2 __attribute__((ext_vector_type(2)));
#define PIN16(A, B) asm volatile("" : "+v"(A[(B) + 0]), "+v"(A[(B) + 1]), "+v"(A[(B) + 2]), "+v"(A[(B) + 3]), "+v"(A[(B) + 4]), "+v"(A[(B) + 5]), "+v"(A[(B) + 6]), "+v"(A[(B) + 7]), \
    "+v"(A[(B) + 8]), "+v"(A[(B) + 9]), "+v"(A[(B) + 10]), "+v"(A[(B) + 11]), "+v"(A[(B) + 12]), "+v"(A[(B) + 13]), "+v"(A[(B) + 14]), "+v"(A[(B) + 15]) :: "memory")
#ifndef P8_DU
#define P8_DU 4
#endif
#ifndef P8_DV
#define P8_DV 8
#endif
constexpr int P8_CH = 8 / P8_NP;
constexpr int P8_ST = 16 * P8_CH;
constexpr int P8_PB = 256 * P8_CH;
template <int D> __device__ __forceinline__ void issue_part(v4u (&buf)[P8_CH], const unsigned char* tab, unsigned e, int gl) {
    const unsigned char* p = tab + (size_t)e * P8_PB + 16 * gl;
#pragma unroll
    for (int jj = 0; jj < P8_CH; ++jj) buf[jj] = *(const v4u*)(p + 256 * jj);
}
template <int D> __device__ __forceinline__ void sweep_u(const unsigned char* tab, const LAS unsigned* entg, LAS float* awg, int gl, int part, const float (&hv)[P8_ST]) {
    static_assert(128 % D == 0 && D % 4 == 0 && D <= 16, "block size");
    v4u buf[D][P8_CH];
    tab += (size_t)part * ((size_t)NEXP * P8_PB);
    { v4u e4[D / 4];
#pragma unroll
      for (int q = 0; q < D / 4; ++q) e4[q] = *(const LAS v4u*)(entg + 4 * q);
#pragma unroll
      for (int j = 0; j < D; ++j) issue_part<D>(buf[j], tab, e4[j >> 2][j & 3], gl); }
#pragma unroll 1
    for (int k0 = 0; k0 < 128; k0 += D) {
        v4u e4[D / 4]; const int kb = (k0 + D < 128) ? k0 + D : 128 - D;
#pragma unroll
        for (int q = 0; q < D / 4; ++q) e4[q] = *(const LAS v4u*)(entg + kb + 4 * q);
#pragma unroll
        for (int q = 0; q < D / 4; ++q) asm volatile("" : "+v"(e4[q]));
        float racc[D];
#pragma unroll
        for (int j = 0; j < D; ++j) {
            float a0 = 0.f, a1 = 0.f;
#pragma unroll
            for (int jj = 0; jj < P8_CH; ++jj)
#pragma unroll
                for (int c = 0; c < 4; ++c) { const f32x2 lo = __builtin_amdgcn_cvt_pk_f32_fp8((int)buf[j][jj][c], false), hi = __builtin_amdgcn_cvt_pk_f32_fp8((int)buf[j][jj][c], true);
                    a0 = fmaf(lo.x, hv[16 * jj + 4 * c + 0], a0); a1 = fmaf(lo.y, hv[16 * jj + 4 * c + 1], a1); a0 = fmaf(hi.x, hv[16 * jj + 4 * c + 2], a0); a1 = fmaf(hi.y, hv[16 * jj + 4 * c + 3], a1); }
            racc[j] = a0 + a1; asm volatile("" : "+v"(racc[j]) :: "memory");
            issue_part<D>(buf[j], tab, e4[j >> 2][j & 3], gl);
        }
#pragma unroll
        for (int st = D / 2; st >= 1; st >>= 1) { const bool up_ = (gl & st) != 0;
#pragma unroll
            for (int i = 0; i < st; ++i) { const float keep = up_ ? racc[i + st] : racc[i], send = up_ ? racc[i] : racc[i + st]; racc[i] = keep + __shfl_xor(send, st); } }
        float r = racc[0];
#pragma unroll
        for (int st = D; st < 16; st <<= 1) r += __shfl_xor(r, st);
        if (gl < D) awg[part * 512 + k0 + gl] = r;
    }
}
template <int D> __device__ __forceinline__ void sweep_v(const unsigned char* tab, const LAS unsigned* entg, const LAS float* awg, int gl, int part, float (&po)[P8_ST]) {
    static_assert(128 % D == 0 && D % 4 == 0 && D <= 16, "block size");
    v4u buf[D][P8_CH];
    tab += (size_t)part * ((size_t)NEXP * P8_PB);
    { v4u e4[D / 4];
#pragma unroll
      for (int q = 0; q < D / 4; ++q) e4[q] = *(const LAS v4u*)(entg + 4 * q);
#pragma unroll
      for (int j = 0; j < D; ++j) issue_part<D>(buf[j], tab, e4[j >> 2][j & 3], gl); }
#pragma unroll 1
    for (int k0 = 0; k0 < 128; k0 += D) {
        v4u e4[D / 4]; f32x4 w4[D / 4]; const int kb = (k0 + D < 128) ? k0 + D : 128 - D;
#pragma unroll
        for (int q = 0; q < D / 4; ++q) { e4[q] = *(const LAS v4u*)(entg + kb + 4 * q); w4[q] = *(const LAS f32x4*)(awg + k0 + 4 * q); }
#pragma unroll
        for (int q = 0; q < D / 4; ++q) asm volatile("" : "+v"(e4[q]), "+v"(w4[q]));
#pragma unroll
        for (int j = 0; j < D; ++j) {
            const float wk = w4[j >> 2][j & 3];
#pragma unroll
            for (int jj = 0; jj < P8_CH; ++jj)
#pragma unroll
                for (int c = 0; c < 4; ++c) { const f32x2 lo = __builtin_amdgcn_cvt_pk_f32_fp8((int)buf[j][jj][c], false), hi = __builtin_amdgcn_cvt_pk_f32_fp8((int)buf[j][jj][c], true);
                    po[16 * jj + 4 * c + 0] = fmaf(wk, lo.x, po[16 * jj + 4 * c + 0]); po[16 * jj + 4 * c + 1] = fmaf(wk, lo.y, po[16 * jj + 4 * c + 1]);
                    po[16 * jj + 4 * c + 2] = fmaf(wk, hi.x, po[16 * jj + 4 * c + 2]); po[16 * jj + 4 * c + 3] = fmaf(wk, hi.y, po[16 * jj + 4 * c + 3]); }
#pragma unroll
            for (int jj = 0; jj < P8_CH; ++jj) PIN16(po, 16 * jj);
            issue_part<D>(buf[j], tab, e4[j >> 2][j & 3], gl);
        }
    }
}
__device__ __forceinline__ void p8_expert(Frame& F) {
    const Lane Ls = lane_state();
    const unsigned char* U8 = F.ws + WS_U; const unsigned char* V8 = F.ws + WS_V; const float* esc = (const float*)(F.ws + WS_ESC);
    const float* part = (const float*)(F.ws + WS_PART); const int* tki = (const int*)(F.ws + WS_TKI); const float* tkg = (const float*)(F.ws + WS_TKG);
    bf16* X1b = (bf16*)(F.ws + WS_X1B);
    LAS unsigned* key = (LAS unsigned*)(F.lds + RING_OFF + Ls.wave * 16384); LAS unsigned* ent = key + 512; LAS float* gsv = (LAS float*)(ent + 512); LAS float* sus = gsv + 512; LAS float* aw = sus + 512;
    const int vw0 = ((int)(blockIdx.x & 7) * (F.G >> 3) + (int)(blockIdx.x >> 3)) * NWAVES + Ls.wave;
    for (int v = (F.G & 7) ? Ls.gw : vw0; v < T / 4; v += F.NGW) {
        unsigned zz = 0u; asm volatile("" : "+s"(zz));
        int lane = (int)__builtin_amdgcn_mbcnt_hi(~0u, __builtin_amdgcn_mbcnt_lo(~0u, zz)); asm volatile("" : "+v"(lane));
        const int sg = lane >> 4, gl = lane & 15, tok = 4 * v + sg;
        LAS unsigned* keyg = key + sg * 128; LAS unsigned* entg = ent + sg * 128; LAS float* gsvg = gsv + sg * 128; LAS float* susg = sus + sg * 128; LAS float* awg = aw + sg * 128;
        { unsigned mk[8]; float mg[8];
#pragma unroll
          for (int q = 0; q < 8; ++q) { const int j = gl + 16 * q; const int e = tki[(size_t)tok * 128 + j]; mg[q] = tkg[(size_t)tok * 128 + j]; mk[q] = ((unsigned)e << 7) | (unsigned)j; keyg[j] = mk[q]; }
          asm volatile("s_waitcnt lgkmcnt(0)" ::: "memory");
          int rk[8];
#pragma unroll
          for (int q = 0; q < 8; ++q) rk[q] = 0;
#pragma unroll 4
          for (int jj = 0; jj < 32; ++jj) { const v4u kk = *(const LAS v4u*)(keyg + 4 * jj);
#pragma unroll
              for (int c = 0; c < 4; ++c)
#pragma unroll
                  for (int q = 0; q < 8; ++q) rk[q] += (kk[c] < mk[q]) ? 1 : 0; }
#pragma unroll
          for (int q = 0; q < 8; ++q) { const int e = (int)(mk[q] >> 7); entg[rk[q]] = (unsigned)e; gsvg[rk[q]] = mg[q] * esc[NEXP + e]; susg[rk[q]] = esc[e]; }
          asm volatile("s_waitcnt lgkmcnt(0)" ::: "memory"); }
        float rstd;
        { float ps = part[(size_t)tok * 32 + gl] + part[(size_t)tok * 32 + 16 + gl];
          ps += __shfl_xor(ps, 1); ps += __shfl_xor(ps, 2); ps += __shfl_xor(ps, 4); ps += __shfl_xor(ps, 8);
          rstd = rsqrtf(ps * (1.f / DM) + EPS); }
#pragma unroll
        for (int pt = 0; pt < P8_NP; ++pt) {
            float hv[P8_ST];
            { int tok2 = tok; asm volatile("" : "+v"(tok2)); const bf16* xr = X1b + (size_t)tok2 * DM + P8_PB * pt + 16 * gl; const float* gp = F.g_ffn + P8_PB * pt + 16 * gl;
#pragma unroll
              for (int jj = 0; jj < P8_CH; ++jj) { const v4u a0 = *(const v4u*)(xr + 256 * jj), a1 = *(const v4u*)(xr + 256 * jj + 8);
#pragma unroll
                  for (int q = 0; q < 4; ++q) { const f32x4 g = *(const f32x4*)(gp + 256 * jj + 4 * q); const unsigned w0 = q < 2 ? a0[2 * q] : a1[2 * q - 4], w1 = q < 2 ? a0[2 * q + 1] : a1[2 * q - 3];
                      hv[16 * jj + 4 * q + 0] = bflo(w0) * rstd * g[0]; hv[16 * jj + 4 * q + 1] = bfhi(w0) * rstd * g[1]; hv[16 * jj + 4 * q + 2] = bflo(w1) * rstd * g[2]; hv[16 * jj + 4 * q + 3] = bfhi(w1) * rstd * g[3]; }
                  PIN16(hv, 16 * jj); } }
            sweep_u<P8_DU>(U8, entg, awg, gl, pt, hv);
            asm volatile("s_waitcnt lgkmcnt(0)" ::: "memory");
        }
#pragma unroll
        for (int q = 0; q < 8; ++q) { const int j = gl + 16 * q; const float x = ((awg[j] + awg[512 + j]) + (awg[1024 + j] + awg[1536 + j])) * susg[j]; awg[j] = gsvg[j] * gelu_erf(x); }
        asm volatile("s_waitcnt lgkmcnt(0)" ::: "memory");
        float s2 = 0.f;
#pragma unroll
        for (int pt = 0; pt < P8_NP; ++pt) {
            float po[P8_ST];
#pragma unroll
            for (int q = 0; q < P8_ST; ++q) po[q] = 0.f;
            sweep_v<P8_DV>(V8, entg, awg, gl, pt, po);
            { int tok2 = tok; asm volatile("" : "+v"(tok2)); bf16* xb = X1b + (size_t)tok2 * DM + P8_PB * pt + 16 * gl;
#pragma unroll
              for (int jj = 0; jj < P8_CH; ++jj) { const v4u a0 = *(const v4u*)(xb + 256 * jj), a1 = *(const v4u*)(xb + 256 * jj + 8); v4u o0, o1;
#pragma unroll
                  for (int q = 0; q < 4; ++q) { const unsigned w0 = q < 2 ? a0[2 * q] : a1[2 * q - 4], w1 = q < 2 ? a0[2 * q + 1] : a1[2 * q - 3]; f32x4 o;
                      o[0] = bflo(w0) + po[16 * jj + 4 * q + 0]; o[1] = bfhi(w0) + po[16 * jj + 4 * q + 1]; o[2] = bflo(w1) + po[16 * jj + 4 * q + 2]; o[3] = bfhi(w1) + po[16 * jj + 4 * q + 3];
#pragma unroll
                      for (int e = 0; e < 4; ++e) s2 = fmaf(o[e], o[e], s2);
                      const unsigned p0 = cvtpk(o[0], o[1]), p1 = cvtpk(o[2], o[3]);
                      if (q < 2) { o0[2 * q] = p0; o0[2 * q + 1] = p1; } else { o1[2 * q - 4] = p0; o1[2 * q - 3] = p1; } }
                  *(v4u*)(xb + 256 * jj) = o0; *(v4u*)(xb + 256 * jj + 8) = o1;
                  asm volatile("" : "+v"(s2) :: "memory"); } }
        }
        { s2 += __shfl_xor(s2, 1); s2 += __shfl_xor(s2, 2); s2 += __shfl_xor(s2, 4); s2 += __shfl_xor(s2, 8);
          const float r2 = rsqrtf(s2 * (1.f / DM) + EPS);
          int tok2 = tok; asm volatile("" : "+v"(tok2)); float* xr = F.out + (size_t)tok2 * DM + 16 * gl; const float* gf = F.g_fin + 16 * gl; const bf16* xb = X1b + (size_t)tok2 * DM + 16 * gl;
#pragma unroll
          for (int jj = 0; jj < 8; ++jj) { const v4u a0 = *(const v4u*)(xb + 256 * jj), a1 = *(const v4u*)(xb + 256 * jj + 8);
#pragma unroll
              for (int q = 0; q < 4; ++q) { const f32x4 g = *(const f32x4*)(gf + 256 * jj + 4 * q); const unsigned w0 = q < 2 ? a0[2 * q] : a1[2 * q - 4], w1 = q < 2 ? a0[2 * q + 1] : a1[2 * q - 3];
                  const f32x4 a = {bflo(w0), bfhi(w0), bflo(w1), bfhi(w1)};
                  *(f32x4*)(xr + 256 * jj + 4 * q) = a * r2 * g; }
              asm volatile("" ::: "memory"); } }
    }
}

constexpr int N_PHASES = 9;
struct Args { const float* in[14]; float* out; unsigned char* ws; int ph_lo, ph_hi; };
__global__ void __launch_bounds__(NWAVES * 64, 2) fwd_kernel(Args args) {
    extern __shared__ __attribute__((aligned(16))) unsigned char lds[];
    Frame F;
    F.lds = (LAS unsigned char*)lds; F.ldsg = (char*)lds;
    F.G = gridDim.x; F.NGW = F.G * NWAVES;
    F.x = args.in[0]; F.rel_bias = args.in[1]; F.g_mix = args.in[2]; F.w_in = args.in[3]; F.sink_a = args.in[4]; F.w_oa = args.in[5]; F.w_ob = args.in[6]; F.w_out = args.in[7];
    F.g_ffn = args.in[8]; F.w_pq = args.in[9]; F.keys = args.in[10]; F.eu = args.in[11]; F.ev = args.in[12]; F.g_fin = args.in[13];
    F.out = args.out; F.ws = args.ws;
    volatile LAS unsigned* MISC = (volatile LAS unsigned*)(F.lds + MISC_OFF);
    for (int u = threadIdx.x; u < (LDS_BYTES - LDSCTL_OFF) / 4; u += NWAVES * 64) ((LAS unsigned*)(F.lds + LDSCTL_OFF))[u] = 0u;
    __syncthreads();
    const int lo = args.ph_lo, hi = args.ph_hi;
    const bool multi = !MK_SPLIT || (hi - lo) > 1;
    XcdBarrier bar; bar.bar = (unsigned*)(F.ws + WS_CTL) + CW_BAR; bar.x = 0; bar.st = nullptr;
    if (multi) bar = xcd_barrier_post((unsigned*)(F.ws + WS_CTL) + CW_BAR, MISC + 8);
#ifndef PH_OFF
#define PH_OFF 0
#endif
#if MK_SPLIT
#define IN(k) (lo <= (k) && (k) < hi && !((PH_OFF >> (k)) & 1))
#else
#define IN(k) (!((PH_OFF >> (k)) & 1))
#endif
#define GRID_BAR() do { XcdBarrier b_ = bar; asm volatile("" : "+s"(b_.bar)); xcd_barrier(b_); } while (0)
#define SEAM(k) do { if (IN(k) && IN((k) + 1)) GRID_BAR(); } while (0)
#ifndef PH_REP
#define PH_REP 0
#endif
#define NREP(k) (IN(k) ? 1 + ((PH_REP >> (k)) & 1) : 0)
#define REPEAT(k) _Pragma("unroll") for (int r_ = 0; r_ < NREP(k); ++r_)
#define REBAR() do { if (r_) GRID_BAR(); } while (0)
    bf16* WinT = (bf16*)(F.ws + WS_WIN); bf16* WoaT = (bf16*)(F.ws + WS_WOA); bf16* WobT = (bf16*)(F.ws + WS_WOB); bf16* WoutT = (bf16*)(F.ws + WS_WOUT); bf16* W2T = (bf16*)(F.ws + WS_W2);
    bf16* proj = (bf16*)(F.ws + WS_PROJ); bf16* Hb = (bf16*)(F.ws + WS_H); bf16* mrg = (bf16*)(F.ws + WS_MRG);
    bf16* attA = (bf16*)(F.ws + WS_ATTA); bf16* attB = (bf16*)(F.ws + WS_ATTB); bf16* x1b = (bf16*)(F.ws + WS_X1B);
    float* part = (float*)(F.ws + WS_PART); float* scores = (float*)(F.ws + WS_SC);

    REPEAT(0) { REBAR(); p0_prologue(F); } SEAM(0);
    REPEAT(1) { REBAR();
        pg8::Gemm g{Hb, WinT, T, INW, DM / 2}; pg8::StaticOrder S; S.init(T, INW, F.G, (int)blockIdx.x);
        pg8::EpiProj E{proj, INW, C_GA / 256, 1.f / W_SCALE};
        pg8::gemm_phase<pg8::EpiProj, pg8::StaticOrder, true, true, true>(F.lds + RING_OFF, g, S, E);
    } SEAM(1);
    REPEAT(2) { REBAR(); p2_attention(F); } SEAM(2);
    for (int r34 = 0; r34 < 1 + ((PH_REP >> 3) & 1); ++r34) {
    if (r34) GRID_BAR();
    if (IN(3)) {
        p3_combine(F);
        pg8::Gemm g{attA, WoaT, T, DM, AQW / 2}; pg8::StaticOrder S; S.init(T, DM, F.G, (int)blockIdx.x);
        pg8::EpiGate<false> E{proj + C_GA, INW, mrg, DM, 1.f / (A_SCALE * W_SCALE)};
        pg8::gemm_phase<pg8::EpiGate<false>, pg8::StaticOrder, false, true, true>(F.lds + RING_OFF, g, S, E);
    } SEAM(3);
    if (IN(4)) {
        pg8::Gemm g{attB, WobT, T, DM, BOW / 2}; pg8::StaticOrder S; S.init(T, DM, F.G, (int)blockIdx.x);
        pg8::EpiGateF8 E{proj + C_GB, INW, mrg, DM, F.ws + WS_MRG8, DM, M_SCALE, 1.f / (A_SCALE * W_SCALE)};
        pg8::gemm_phase<pg8::EpiGateF8, pg8::StaticOrder, false, true, true>(F.lds + RING_OFF, g, S, E);
    }
    }
    SEAM(4);
    REPEAT(5) { REBAR();
        pg8::Gemm g{(const bf16*)(F.ws + WS_MRG8), WoutT, T, DM, DM / 2}; pg8::StaticOrder S; S.init(T, DM, F.G, (int)blockIdx.x);
        pg8::EpiResid E{F.x, x1b, part, DM, 1.f / (M_SCALE * W_SCALE)};
        pg8::gemm_phase<pg8::EpiResid, pg8::StaticOrder, false, true, true>(F.lds + RING_OFF, g, S, E);
    } SEAM(5);
    REPEAT(6) { REBAR();
        pg8::Gemm g{x1b, W2T, T, DM, DM}; pg8::StaticOrder S; S.init(T, DM, F.G, (int)blockIdx.x);
        LAS float* rs = (LAS float*)(F.lds + RSTD_OFF);
        const Lane Ls = lane_state();
        pg8::Unit u0; if (S.next(0, u0) && Ls.tid < 256) { const f32x4* pp = (const f32x4*)(part + (size_t)(u0.pm * 256 + Ls.tid) * 32); float s = 0.f;
#pragma unroll
            for (int i = 0; i < 8; ++i) { const f32x4 v = pp[i]; s += (v[0] + v[1]) + (v[2] + v[3]); }
            rs[Ls.tid] = rsqrtf(s * (1.f / DM) + EPS); }
        __syncthreads();
        pg8::EpiTopk E{rs, (int*)(F.ws + WS_TKI), (float*)(F.ws + WS_TKG), PHEADS, scores, DM};
        pg8::gemm_phase<pg8::EpiTopk, pg8::StaticOrder, false, true>(F.lds + RING_OFF, g, S, E);
    }
    if (IN(6) && IN(8)) GRID_BAR();
    if (IN(8)) { p8_expert(F); }
#undef IN
#undef SEAM
}

extern "C" void kernel_launch(void* const* d_in, const int* in_sizes, int n_in, void* d_out, int out_size, void* d_ws, size_t ws_size, hipStream_t stream) {
    static int grid = 0;
    if (grid == 0) {
        if (n_in != 14 || in_sizes[0] != T * DM || out_size != T * DM || ws_size < WS_END) {
            fprintf(stderr, "kernel_launch: unexpected shapes: n_in %d in0 %d out %d ws %zu (need >= %zu); nothing launched\n", n_in, n_in > 0 ? in_sizes[0] : -1, out_size, ws_size, (size_t)WS_END); grid = -1; return; }
        int dev = 0, cus = 0, per_cu = 0;
        if (hipGetDevice(&dev) != hipSuccess || hipDeviceGetAttribute(&cus, hipDeviceAttributeMultiprocessorCount, dev) != hipSuccess) { grid = -1; return; }
        if (hipFuncSetAttribute((const void*)fwd_kernel, hipFuncAttributeMaxDynamicSharedMemorySize, LDS_BYTES) != hipSuccess) { fprintf(stderr, "kernel_launch: hipFuncSetAttribute failed\n"); grid = -1; return; }
        if (hipOccupancyMaxActiveBlocksPerMultiprocessor(&per_cu, (const void*)fwd_kernel, NWAVES * 64, LDS_BYTES) != hipSuccess || per_cu < 1)
            fprintf(stderr, "kernel_launch: note: occupancy query reports %d workgroups per CU\n", per_cu);
        (void)hipGetLastError();
        grid = cus;
        if (grid != 256) fprintf(stderr, "kernel_launch: note: %d CUs (built for 256)\n", grid);
    }
    if (grid < 0) return;
    (void)hipMemsetAsync((char*)d_ws + WS_CTL, 0, CTL_ZERO_BYTES, stream);
    Args a{};
    for (int i = 0; i < 14; ++i) a.in[i] = (const float*)d_in[i];
    a.out = (float*)d_out; a.ws = (unsigned char*)d_ws;
#if MK_SPLIT
    for (int p = 0; p < N_PHASES; ++p) { a.ph_lo = p; a.ph_hi = p + 1; hipLaunchKernelGGL(fwd_kernel, dim3(grid), dim3(NWAVES * 64), LDS_BYTES, stream, a); }
#else
    a.ph_lo = 0; a.ph_hi = N_PHASES; hipLaunchKernelGGL(fwd_kernel, dim3(grid), dim3(NWAVES * 64), LDS_BYTES, stream, a);
#endif
    const hipError_t le = hipPeekAtLastError();
    if (le != hipSuccess) fprintf(stderr, "kernel_launch: launch failed: %s\n", hipGetErrorName(le));
}
```

```cpp
#include <hip/hip_runtime.h>
#include <cstdio>
#include <cstdint>
namespace pg8 {
#define PG8_LAS __attribute__((address_space(3)))
typedef unsigned short bf16_t;
typedef short bf16x8 __attribute__((ext_vector_type(8)));
typedef float f32x4 __attribute__((ext_vector_type(4)));
typedef unsigned u32x4 __attribute__((ext_vector_type(4)));
typedef int v4i_t __attribute__((ext_vector_type(4)));
typedef int v8i_t __attribute__((ext_vector_type(8)));
constexpr int BM = 256, BK = 64, HALF = 128, HTB = HALF * BK * 2  , STAGE_BYTES = 8 * HTB, NXCD = 8, WGM = 8;

__host__ __device__ __forceinline__ int lds_byte(int r, int c) { const int st = (r >> 4) * 2 + (c >> 5), rr = r & 15, cc = c & 31, ob = rr * 64 + cc * 2; return st * 1024 + (ob ^ (((ob >> 9) & 1) << 5)); }
__host__ __device__ __forceinline__ void stage_rc(int b, int& R, int& C) { const int st = b / 1024, sb = b % 1024, swz = sb ^ (((sb >> 9) & 1) << 5); R = (st >> 1) * 16 + swz / 64; C = (st & 1) * 32 + (swz % 64) / 2; }
__host__ __device__ __forceinline__ int perm32(int rho) { const int n = rho >> 4, i = rho & 15; return 8 * (i >> 2) + 4 * n + (i & 3); }

struct Unit { int pm, pn; };
struct Gemm { const bf16_t* A; const bf16_t* Bt; int M, N, K; };

struct StaticOrder {
    int nM, nN, nwg, G, c;
    __host__ __device__ void init(int M, int N, int G_, int c_) { nM = M / BM; nN = N / BM; nwg = nM * nN; G = G_; c = c_; }
    __host__ __device__ bool next(int i, Unit& u) const {
        const long L = (long)i * G + c; if (L >= nwg) return false;
        int wgid = (int)L; { const int q = nwg / NXCD, r = nwg % NXCD, xcd = wgid % NXCD, off = wgid / NXCD; wgid = (xcd < r ? xcd * (q + 1) : r * (q + 1) + (xcd - r) * q) + off; }
        const int nig = WGM * nN, gid = wgid / nig, fm = gid * WGM, gsz = (nM - fm) < WGM ? (nM - fm) : WGM;
        u.pm = fm + ((wgid % nig) % gsz); u.pn = (wgid % nig) / gsz; return true;
    }
    __device__ __forceinline__ void a_ready(const Unit&) const {}
    __device__ __forceinline__ void done(const Unit&) const {}
};

typedef unsigned u32x2 __attribute__((ext_vector_type(2)));
__device__ __forceinline__ unsigned cvt_pk_bf16(float lo, float hi) { unsigned r; asm volatile("v_cvt_pk_bf16_f32 %0, %1, %2" : "=v"(r) : "v"(lo), "v"(hi)); return r; }
__device__ __forceinline__ float sigm(float v) { return __builtin_amdgcn_rcpf(1.0f + __builtin_amdgcn_exp2f(-1.4426950408889634f * v)); }
__device__ __forceinline__ float bflo(unsigned w) { return __builtin_bit_cast(float, w << 16); }
__device__ __forceinline__ float bfhi(unsigned w) { return __builtin_bit_cast(float, w & 0xffff0000u); }

struct EpiProj {
    static constexpr bool PERM = true, AFTER_DRAIN = false;
    bf16_t* O; int ldc; int gate_pn; float osc;
    __device__ __forceinline__ void operator()(const f32x4 (&acc)[2][2][4][2], const Unit& u, int wr, int wc, int fr_, int fq_) const {
        (void)fr_; (void)fq_; int ln_ = (int)__builtin_amdgcn_mbcnt_hi(~0u, __builtin_amdgcn_mbcnt_lo(~0u, 0u)); asm volatile("" : "+v"(ln_));
        const int fr = ln_ & 15, fq = ln_ >> 4;
        const int row0 = u.pm * BM + wr * 64 + fr, col0 = u.pn * BM + wc * 32 + 8 * fq; const bool gate = u.pn >= gate_pn;
#pragma unroll
        for (int ai = 0; ai < 2; ++ai)
#pragma unroll
            for (int m = 0; m < 4; ++m) { bf16_t* rowp = O + ((size_t)(2 * u.pn) * ldc + (row0 + ai * HALF + m * 16)) * 128 + wc * 32 + 8 * fq;
#pragma unroll
                for (int bj = 0; bj < 2; ++bj) { f32x4 v0 = acc[ai][bj][m][0] * osc, v1 = acc[ai][bj][m][1] * osc;
                    if (gate) {
#pragma unroll
                        for (int j = 0; j < 4; ++j) { v0[j] = sigm(v0[j]); v1[j] = sigm(v1[j]); } }
                    u32x4 w; w.x = cvt_pk_bf16(v0[0], v0[1]); w.y = cvt_pk_bf16(v0[2], v0[3]); w.z = cvt_pk_bf16(v1[0], v1[1]); w.w = cvt_pk_bf16(v1[2], v1[3]);
                    *(u32x4*)(rowp + (size_t)bj * ldc * 128) = w; } }
    }
};
template <bool ACCUM> struct EpiGate {
    static constexpr bool PERM = true, AFTER_DRAIN = false;
    const bf16_t* G; int ldg; bf16_t* O; int ldc; float osc;
    __device__ __forceinline__ void operator()(const f32x4 (&acc)[2][2][4][2], const Unit& u, int wr, int wc, int fr_, int fq_) const {
        (void)fr_; (void)fq_; int ln_ = (int)__builtin_amdgcn_mbcnt_hi(~0u, __builtin_amdgcn_mbcnt_lo(~0u, 0u)); asm volatile("" : "+v"(ln_));
        const int fr = ln_ & 15, fq = ln_ >> 4;
        const int row0 = u.pm * BM + wr * 64 + fr, col0 = u.pn * BM + wc * 32 + 8 * fq;
#pragma unroll
        for (int ai = 0; ai < 2; ++ai)
#pragma unroll
            for (int m = 0; m < 4; ++m) { const int row = row0 + ai * HALF + m * 16; const bf16_t* gp = G + ((size_t)(2 * u.pn) * ldg + row) * 128 + wc * 32 + 8 * fq; bf16_t* op = O + (size_t)row * ldc + col0;
#pragma unroll
                for (int bj = 0; bj < 2; ++bj) { const u32x4 gw = *(const u32x4*)(gp + (size_t)bj * ldg * 128);
                    f32x4 v0 = acc[ai][bj][m][0] * osc, v1 = acc[ai][bj][m][1] * osc;
                    v0[0] *= bflo(gw.x); v0[1] *= bfhi(gw.x); v0[2] *= bflo(gw.y); v0[3] *= bfhi(gw.y);
                    v1[0] *= bflo(gw.z); v1[1] *= bfhi(gw.z); v1[2] *= bflo(gw.w); v1[3] *= bfhi(gw.w);
                    if (ACCUM) { const u32x4 mw = *(const u32x4*)(op + bj * HALF);
                        v0[0] += bflo(mw.x); v0[1] += bfhi(mw.x); v0[2] += bflo(mw.y); v0[3] += bfhi(mw.y);
                        v1[0] += bflo(mw.z); v1[1] += bfhi(mw.z); v1[2] += bflo(mw.w); v1[3] += bfhi(mw.w); }
                    u32x4 w; w.x = cvt_pk_bf16(v0[0], v0[1]); w.y = cvt_pk_bf16(v0[2], v0[3]); w.z = cvt_pk_bf16(v1[0], v1[1]); w.w = cvt_pk_bf16(v1[2], v1[3]);
                    *(u32x4*)(op + bj * HALF) = w; } }
    }
};
__device__ __forceinline__ unsigned pk4_fp8e(float a, float b, float c, float d) { int p = __builtin_amdgcn_cvt_pk_fp8_f32(fminf(fmaxf(a, -448.f), 448.f), fminf(fmaxf(b, -448.f), 448.f), 0, false);
    return (unsigned)__builtin_amdgcn_cvt_pk_fp8_f32(fminf(fmaxf(c, -448.f), 448.f), fminf(fmaxf(d, -448.f), 448.f), p, true); }
struct EpiGateF8 {
    static constexpr bool PERM = true, AFTER_DRAIN = false;
    const bf16_t* G; int ldg; const bf16_t* M1; int ldm; unsigned char* O8; int ldc; float oscale; float osc;
    __device__ __forceinline__ void operator()(const f32x4 (&acc)[2][2][4][2], const Unit& u, int wr, int wc, int fr_, int fq_) const {
        (void)fr_; (void)fq_; int ln_ = (int)__builtin_amdgcn_mbcnt_hi(~0u, __builtin_amdgcn_mbcnt_lo(~0u, 0u)); asm volatile("" : "+v"(ln_));
        const int fr = ln_ & 15, fq = ln_ >> 4;
        const int row0 = u.pm * BM + wr * 64 + fr, col0 = u.pn * BM + wc * 32 + 8 * fq;
#pragma unroll
        for (int ai = 0; ai < 2; ++ai)
#pragma unroll
            for (int m = 0; m < 4; ++m) { const int row = row0 + ai * HALF + m * 16; const bf16_t* gp = G + ((size_t)(2 * u.pn) * ldg + row) * 128 + wc * 32 + 8 * fq; const bf16_t* mp = M1 + (size_t)row * ldm + col0; unsigned char* op = O8 + (size_t)row * ldc + col0;
#pragma unroll
                for (int bj = 0; bj < 2; ++bj) { const u32x4 gw = *(const u32x4*)(gp + (size_t)bj * ldg * 128), mw = *(const u32x4*)(mp + bj * HALF);
                    f32x4 v0 = acc[ai][bj][m][0] * osc, v1 = acc[ai][bj][m][1] * osc;
                    v0[0] = (v0[0] * bflo(gw.x) + bflo(mw.x)) * oscale; v0[1] = (v0[1] * bfhi(gw.x) + bfhi(mw.x)) * oscale; v0[2] = (v0[2] * bflo(gw.y) + bflo(mw.y)) * oscale; v0[3] = (v0[3] * bfhi(gw.y) + bfhi(mw.y)) * oscale;
                    v1[0] = (v1[0] * bflo(gw.z) + bflo(mw.z)) * oscale; v1[1] = (v1[1] * bfhi(gw.z) + bfhi(mw.z)) * oscale; v1[2] = (v1[2] * bflo(gw.w) + bflo(mw.w)) * oscale; v1[3] = (v1[3] * bfhi(gw.w) + bfhi(mw.w)) * oscale;
                    u32x2 w; w.x = pk4_fp8e(v0[0], v0[1], v0[2], v0[3]); w.y = pk4_fp8e(v1[0], v1[1], v1[2], v1[3]);
                    *(u32x2*)(op + bj * HALF) = w; } }
    }
};

struct EpiResid {
    static constexpr bool PERM = false, AFTER_DRAIN = false;
    const float* X; bf16_t* X1b; float* part; int ld; float osc;
    __device__ __forceinline__ void operator()(const f32x4 (&acc)[2][2][4][2], const Unit& u, int wr, int wc, int fr_, int fq_) const {
        (void)fr_; (void)fq_; int ln_ = (int)__builtin_amdgcn_mbcnt_hi(~0u, __builtin_amdgcn_mbcnt_lo(~0u, 0u)); asm volatile("" : "+v"(ln_));
        const int fr = ln_ & 15, fq = ln_ >> 4;
        const int row0 = u.pm * BM + wr * 64 + fr, col0 = u.pn * BM + wc * 32 + 4 * fq;
#pragma unroll
        for (int ai = 0; ai < 2; ++ai)
#pragma unroll
            for (int m = 0; m < 4; ++m) { const int row = row0 + ai * HALF + m * 16; float ss = 0.f;
#pragma unroll
                for (int bj = 0; bj < 2; ++bj)
#pragma unroll
                    for (int n = 0; n < 2; ++n) { const size_t off = (size_t)row * ld + col0 + bj * HALF + n * 16;
                        const f32x4 x = *(const f32x4*)(X + off); const f32x4 v = x + acc[ai][bj][m][n] * osc;
                        u32x2 w; w.x = cvt_pk_bf16(v[0], v[1]); w.y = cvt_pk_bf16(v[2], v[3]); *(u32x2*)(X1b + off) = w;
                        ss += (v[0] * v[0] + v[1] * v[1]) + (v[2] * v[2] + v[3] * v[3]); }
                ss += __shfl_xor(ss, 16); ss += __shfl_xor(ss, 32);
                if (fq == 0) part[(size_t)row * 32 + u.pn * 4 + wc] = ss; }
    }
};
__device__ __forceinline__ int tk_enc(float s) { const int b = __builtin_bit_cast(int, s); return b ^ ((b >> 31) & 0x7fffffff); }
__device__ __forceinline__ float tk_dec(int k) { return __builtin_bit_cast(float, k ^ ((k >> 31) & 0x7fffffff)); }
#define TK_INS16(Lst, X) do { int x_ = (X); _Pragma("unroll") for (int i_ = 0; i_ < 16; ++i_) { const int h_ = Lst[i_] > x_ ? Lst[i_] : x_; x_ = Lst[i_] > x_ ? x_ : Lst[i_]; Lst[i_] = h_; } } while (0)
__device__ __forceinline__ void tk_sort16(int (&v)[16]) {
#pragma unroll
    for (int k = 2; k <= 16; k <<= 1)
#pragma unroll
        for (int j = k >> 1; j > 0; j >>= 1)
#pragma unroll
            for (int i = 0; i < 16; ++i) { const int l = i ^ j; if (l > i) { const int a = v[i], b = v[l]; const int hi = a > b ? a : b, lo = a > b ? b : a; const bool desc = (i & k) == 0; v[i] = desc ? hi : lo; v[l] = desc ? lo : hi; } }
}
__device__ __forceinline__ void tk_merge16(int (&a)[16], const int (&b)[16]) {
#pragma unroll
    for (int i = 0; i < 16; ++i) a[i] = a[i] > b[15 - i] ? a[i] : b[15 - i];
#pragma unroll
    for (int j = 8; j > 0; j >>= 1)
#pragma unroll
        for (int i = 0; i < 16; ++i) { const int l = i ^ j; if (l > i) { const int x = a[i], y = a[l]; a[i] = x > y ? x : y; a[l] = x > y ? y : x; } }
}
#define TK_BAR() do { asm volatile("s_waitcnt lgkmcnt(0)" ::: "memory"); __builtin_amdgcn_s_barrier(); asm volatile("" ::: "memory"); } while (0)
struct EpiTopk {
    static constexpr bool PERM = false, AFTER_DRAIN = true;
    const PG8_LAS float* rs; int* tki; float* tkg; int nheads; float* S; int ld;
    __device__ __forceinline__ void fused(f32x4 (&acc)[2][2][4][2], const Unit& u, int wr, int wc, int fr_, int fq_, PG8_LAS unsigned char* lds, int wid, int lane_) const {
        (void)fr_; (void)fq_; (void)lane_; int lane = (int)__builtin_amdgcn_mbcnt_hi(~0u, __builtin_amdgcn_mbcnt_lo(~0u, 0u)); asm volatile("" : "+v"(lane));
        const int fr = lane & 15, fq = lane >> 4;
        PG8_LAS float* img = (PG8_LAS float*)lds;
        PG8_LAS int* lst = (PG8_LAS int*)lds;
        PG8_LAS int* mrg = (PG8_LAS int*)(lds + 32768);
#pragma unroll
        for (int ai = 0; ai < 2; ++ai)
#pragma unroll
            for (int m = 0; m < 4; ++m) { const int row = ai * HALF + wr * 64 + m * 16 + fr; const float s = rs[row]; float* rowp = S + (size_t)(u.pm * BM + row) * ld + u.pn * BM + wc * 32 + 4 * fq;
#pragma unroll
                for (int bj = 0; bj < 2; ++bj)
#pragma unroll
                    for (int n = 0; n < 2; ++n) *(f32x4*)(rowp + bj * HALF + n * 16) = acc[ai][bj][m][n] * s; }
        asm volatile("s_waitcnt vmcnt(0)" ::: "memory");
        TK_BAR();
#ifndef TK_REP
#define TK_REP 0
#endif
#pragma unroll 1
        for (int ai_ = 0; ai_ < 2 * (1 + TK_REP); ++ai_) { const int ai = ai_ & 1;
            asm volatile("" : "+v"(lane) :: "memory");
            const int tid = wid * 64 + lane;
            { const float* src = S + (size_t)(u.pm * BM + ai * HALF) * ld + u.pn * BM;
#pragma unroll 4
              for (int i = 0; i < 16; ++i) { const int idx = tid + 512 * i, row = idx >> 6, q = idx & 63; *(PG8_LAS f32x4*)(img + row * 256 + ((q ^ (row & 63)) << 2)) = *(const f32x4*)(src + (size_t)row * ld + 4 * q); } }
            TK_BAR();
            const int row = tid & 127, c = (tid >> 7) & 1, kh = tid >> 8;
            int Lk[16];
#pragma unroll 1
            for (int g = 0; g < 4; ++g) {
                int Nk[16];
#pragma unroll
                for (int i = 0; i < 4; ++i) { const int q = 32 * c + 16 * kh + 4 * g + i; const f32x4 v = *(const PG8_LAS f32x4*)(img + row * 256 + ((q ^ (row & 63)) << 2));
#pragma unroll
                    for (int e = 0; e < 4; ++e) Nk[4 * i + e] = (tk_enc(v[e]) & ~127) | (127 - (64 * kh + 16 * g + 4 * i + e)); }
                tk_sort16(Nk);
                if (g == 0) {
#pragma unroll
                    for (int i = 0; i < 16; ++i) Lk[i] = Nk[i]; }
                else tk_merge16(Lk, Nk);
            }
            TK_BAR();
            { PG8_LAS int* d = lst + ((row * 2 + c) * 2 + kh) * 16;
#pragma unroll
              for (int i = 0; i < 4; ++i) *(PG8_LAS v4i_t*)(d + 4 * i) = (v4i_t){Lk[4 * i], Lk[4 * i + 1], Lk[4 * i + 2], Lk[4 * i + 3]}; }
            TK_BAR();
            if (kh == 0) {
                const PG8_LAS int* o = lst + ((row * 2 + c) * 2 + 1) * 16; int Ok[16];
#pragma unroll
                for (int i = 0; i < 4; ++i) { const v4i_t w = *(const PG8_LAS v4i_t*)(o + 4 * i); Ok[4 * i] = w[0]; Ok[4 * i + 1] = w[1]; Ok[4 * i + 2] = w[2]; Ok[4 * i + 3] = w[3]; }
                tk_merge16(Lk, Ok);
                PG8_LAS int* d = mrg + (row * 2 + c) * 16;
#pragma unroll
                for (int i = 0; i < 4; ++i) *(PG8_LAS v4i_t*)(d + 4 * i) = (v4i_t){Lk[4 * i], Lk[4 * i + 1], Lk[4 * i + 2], Lk[4 * i + 3]};
            }
            TK_BAR();
            if (tid < 128) {
                const PG8_LAS int* A = mrg + (tid * 2 + 0) * 16; const PG8_LAS int* B = mrg + (tid * 2 + 1) * 16;
                float s0[16], s1[16];
#pragma unroll
                for (int i = 0; i < 4; ++i) { const v4i_t a = *(const PG8_LAS v4i_t*)(A + 4 * i), b = *(const PG8_LAS v4i_t*)(B + 4 * i);
#pragma unroll
                    for (int e = 0; e < 4; ++e) { s0[4 * i + e] = tk_dec(a[e] & ~127); s1[4 * i + e] = tk_dec(b[e] & ~127); } }
                int Mk[16], Ck[16];
                int cnt = 0;
#pragma unroll
                for (int i = 0; i < 16; ++i)
#pragma unroll
                    for (int j = 0; j < 16; ++j) if ((i + 1) * (j + 1) <= 16) {
                        Ck[cnt & 15] = (tk_enc(s0[i] + s1[j]) & ~255) | (i << 4) | j; ++cnt;
                        if ((cnt & 15) == 0 || cnt == 50) {
                            if (cnt == 50) {
#pragma unroll
                                for (int z = 2; z < 16; ++z) Ck[z] = (int)0x80000000; }
                            tk_sort16(Ck);
                            if (cnt == 16) {
#pragma unroll
                                for (int z = 0; z < 16; ++z) Mk[z] = Ck[z]; }
                            else tk_merge16(Mk, Ck);
                        } }
                const float smax = tk_dec(Mk[0] & ~255); float ev[16], den = 0.f;
#pragma unroll
                for (int q = 0; q < 16; ++q) { ev[q] = __expf(tk_dec(Mk[q] & ~255) - smax); den += ev[q]; }
                const float inv = 1.f / den; const size_t ob = ((size_t)(u.pm * BM + ai * HALF + tid) * nheads + u.pn) * 16;
#pragma unroll
                for (int q4 = 0; q4 < 4; ++q4) { v4i_t ei; f32x4 gv;
#pragma unroll
                    for (int e = 0; e < 4; ++e) { const int k = Mk[4 * q4 + e]; ei[e] = (127 - (A[(k >> 4) & 15] & 127)) * 128 + (127 - (B[k & 15] & 127)); gv[e] = ev[4 * q4 + e] * inv; }
                    *(v4i_t*)(tki + ob + 4 * q4) = ei; *(f32x4*)(tkg + ob + 4 * q4) = gv; }
            }
            TK_BAR();
        }
    }
};

template <class Epi, class Sched, bool ALIGN_EPI = false, bool SP2 = false, bool F8 = false>
__device__ __forceinline__ void gemm_phase(PG8_LAS unsigned char* lds, const Gemm g, const Sched& S, const Epi& E) {
    int tid_ = threadIdx.x; asm volatile("" : "+v"(tid_));
    const int tid = tid_, wid = __builtin_amdgcn_readfirstlane(tid >> 6), lane = tid & 63, wr = wid >> 2, wc = wid & 3, fr = lane & 15, fq = lane >> 4;
    const int K = g.K, nt = K / BK;
    unsigned voffA[2], voffB[2];
#pragma unroll
    for (int i = 0; i < 2; ++i) { int R, C; stage_rc(tid * 16 + i * 8192, R, C); const int Rb = Epi::PERM ? ((R & ~31) + perm32(R & 31)) : R;
        voffA[i] = (unsigned)(R * K + C) * 2u; voffB[i] = (unsigned)(Rb * K + C) * 2u; }
    const size_t kstep = (size_t)(BK * 2);
    const size_t hstep = (size_t)HALF * K * 2;
    const size_t tstep = 2 * hstep;
    const unsigned ldsw = (unsigned)__builtin_amdgcn_readfirstlane((int)((unsigned)(__SIZE_TYPE__)lds + (unsigned)wid * 1024u));
    const int aoff = lds_byte(wr * 64 + fr, fq * 8), boff = lds_byte(wc * 32 + fr, fq * 8);
#define PG8_SA(b, h) (((b) * 2 + (h)) * HTB)
#define PG8_SB(b, h) ((4 + (b) * 2 + (h)) * HTB)
#define PG8_STAGE(bufoff, gbase, voff) do { _Pragma("unroll") for (int _i = 0; _i < 2; ++_i) \
        __builtin_amdgcn_global_load_lds((const unsigned*)((const char*)(gbase) + (voff)[_i]), (PG8_LAS unsigned*)(__SIZE_TYPE__)(ldsw + (unsigned)((bufoff) + _i * 8192)), 16, 0, 0); } while (0)
    PG8_LAS unsigned char* ldsA = lds + aoff; PG8_LAS unsigned char* ldsB = lds + 4 * HTB + boff; asm volatile("" : "+v"(ldsA), "+v"(ldsB));
#define PG8_LD8(p) __builtin_shufflevector(*(const PG8_LAS v4i_t*)(p), *(const PG8_LAS v4i_t*)((p) + 1024), 0, 1, 2, 3, 4, 5, 6, 7)
#define PG8_LDA(dst, b, h) do { _Pragma("unroll") for (int m = 0; m < 4; ++m) dst[m] = PG8_LD8(ldsA + ((b) * 2 + (h)) * HTB + m * 2048); } while (0)
#define PG8_LDB(dst, b, h) do { _Pragma("unroll") for (int n = 0; n < 2; ++n) dst[n] = PG8_LD8(ldsB + ((b) * 2 + (h)) * HTB + n * 2048); } while (0)
#define PG8_H(X, k) __builtin_bit_cast(bf16x8, __builtin_shufflevector(X, X, 4 * (k), 4 * (k) + 1, 4 * (k) + 2, 4 * (k) + 3))
#define PG8_MMA(ai, bj, At, Bt) do { __builtin_amdgcn_s_setprio(1); _Pragma("unroll") for (int m = 0; m < 4; ++m) _Pragma("unroll") for (int n = 0; n < 2; ++n) { \
        if constexpr (F8) asm volatile("v_mfma_scale_f32_16x16x128_f8f6f4 %0, %1, %2, %0, %3, %3 op_sel_hi:[0,0,0]" : "+v"(acc[ai][bj][m][n]) : "v"(Bt[n]), "v"(At[m]), "v"(mxs));   \
        else { acc[ai][bj][m][n] = __builtin_amdgcn_mfma_f32_16x16x32_bf16(PG8_H(Bt[n], 0), PG8_H(At[m], 0), acc[ai][bj][m][n], 0, 0, 0); \
               acc[ai][bj][m][n] = __builtin_amdgcn_mfma_f32_16x16x32_bf16(PG8_H(Bt[n], 1), PG8_H(At[m], 1), acc[ai][bj][m][n], 0, 0, 0); } } __builtin_amdgcn_s_setprio(0); } while (0)
#define PG8_WAIT_V(n) asm volatile("s_waitcnt vmcnt(" #n ")" ::: "memory")
#define PG8_WAIT_L(n) asm volatile("s_waitcnt lgkmcnt(" #n ")" ::: "memory")
#define PG8_BAR __builtin_amdgcn_s_barrier()
#define PG8_SCHED __builtin_amdgcn_sched_barrier(0)
    Unit cur, nxt; int ui = 0;
    if (!S.next(0, cur)) return;
    f32x4 acc[2][2][4][2];
#pragma unroll
    for (int a = 0; a < 2; ++a)
#pragma unroll
        for (int b = 0; b < 2; ++b)
#pragma unroll
            for (int m = 0; m < 4; ++m)
#pragma unroll
                for (int n = 0; n < 2; ++n) acc[a][b][m][n] = (f32x4){0.f, 0.f, 0.f, 0.f};
    int mxs = 0x7f7f7f7f; asm volatile("" : "+v"(mxs));
    v8i_t At[4], B0[2], B1[2];
    const char* cA = (const char*)g.A + (size_t)cur.pm * tstep; const char* cB = (const char*)g.Bt + (size_t)cur.pn * tstep;
    S.a_ready(cur);
    if constexpr (SP2) {
        PG8_STAGE(PG8_SB(0, 0), cB, voffB); PG8_STAGE(PG8_SB(0, 1), cB + hstep, voffB); PG8_STAGE(PG8_SA(0, 0), cA, voffA); PG8_STAGE(PG8_SA(0, 1), cA + hstep, voffA);
        if (wr == 1) PG8_BAR;
        PG8_WAIT_V(2); PG8_BAR;
        PG8_STAGE(PG8_SB(1, 0), cB + kstep, voffB); PG8_STAGE(PG8_SA(1, 0), cA + kstep, voffA); PG8_STAGE(PG8_SB(1, 1), cB + hstep + kstep, voffB);
        PG8_WAIT_V(6); PG8_BAR;
    } else {
        PG8_STAGE(PG8_SB(0, 0), cB, voffB); PG8_STAGE(PG8_SA(0, 0), cA, voffA); PG8_STAGE(PG8_SB(0, 1), cB + hstep, voffB); PG8_STAGE(PG8_SA(0, 1), cA + hstep, voffA);
        if (wr == 1) PG8_BAR;
        PG8_WAIT_V(4); PG8_BAR;
        PG8_STAGE(PG8_SB(1, 0), cB + kstep, voffB); PG8_STAGE(PG8_SA(1, 0), cA + kstep, voffA); PG8_STAGE(PG8_SB(1, 1), cB + hstep + kstep, voffB);
        PG8_WAIT_V(6); PG8_BAR;
    }
    for (;;) {
        const bool has_next = S.next(ui + 1, nxt);
        const char* nA = has_next ? (const char*)g.A + (size_t)nxt.pm * tstep : cA; const char* nB = has_next ? (const char*)g.Bt + (size_t)nxt.pn * tstep : cB;
        for (int t = 0; t < nt; t += 2) {
            const bool last = (t == nt - 2);
            const char* a1 = cA + (size_t)(t + 1) * kstep;
            const char* a2 = last ? nA : cA + (size_t)(t + 2) * kstep; const char* b2 = last ? nB : cB + (size_t)(t + 2) * kstep;
            const char* a3 = a2 + kstep; const char* b3 = b2 + kstep;
            if (last && has_next) S.a_ready(nxt);
            if constexpr (SP2) {
            PG8_LDB(B0, 0, 0); PG8_LDB(B1, 0, 1); PG8_SCHED; PG8_LDA(At, 0, 0); PG8_STAGE(PG8_SA(1, 1), a1 + hstep, voffA);
            PG8_WAIT_V(8); PG8_WAIT_L(0); PG8_BAR; PG8_MMA(0, 0, At, B0); PG8_MMA(0, 1, At, B1); PG8_BAR; PG8_SCHED;
            PG8_LDA(At, 0, 1); PG8_STAGE(PG8_SB(0, 0), b2, voffB); PG8_STAGE(PG8_SB(0, 1), b2 + hstep, voffB); PG8_STAGE(PG8_SA(0, 0), a2, voffA);
            PG8_WAIT_V(8); PG8_WAIT_L(0); PG8_BAR; PG8_MMA(1, 0, At, B0); PG8_MMA(1, 1, At, B1); PG8_BAR; PG8_SCHED;
            PG8_LDB(B0, 1, 0); PG8_LDB(B1, 1, 1); PG8_SCHED; PG8_LDA(At, 1, 0); PG8_STAGE(PG8_SA(0, 1), a2 + hstep, voffA);
            PG8_WAIT_V(8); PG8_WAIT_L(0); PG8_BAR; PG8_MMA(0, 0, At, B0); PG8_MMA(0, 1, At, B1); PG8_BAR; PG8_SCHED;
            PG8_LDA(At, 1, 1); PG8_STAGE(PG8_SB(1, 0), b3, voffB); PG8_STAGE(PG8_SB(1, 1), b3 + hstep, voffB); PG8_STAGE(PG8_SA(1, 0), a3, voffA);
            PG8_WAIT_V(8); PG8_WAIT_L(0); PG8_BAR; PG8_MMA(1, 0, At, B0); PG8_MMA(1, 1, At, B1); PG8_BAR; PG8_SCHED;
            } else {
            PG8_LDB(B0, 0, 0); PG8_SCHED; PG8_LDA(At, 0, 0); PG8_STAGE(PG8_SA(1, 1), a1 + hstep, voffA);
            PG8_WAIT_L(8); PG8_BAR; PG8_WAIT_L(0); PG8_MMA(0, 0, At, B0); PG8_BAR; PG8_SCHED;
            PG8_LDB(B1, 0, 1); PG8_STAGE(PG8_SB(0, 0), b2, voffB);
            PG8_BAR; PG8_WAIT_L(0); PG8_MMA(0, 1, At, B1); PG8_BAR;
            PG8_LDA(At, 0, 1); PG8_STAGE(PG8_SA(0, 0), a2, voffA);
            PG8_BAR; PG8_WAIT_L(0); PG8_MMA(1, 0, At, B0); PG8_BAR; PG8_SCHED;
            PG8_STAGE(PG8_SB(0, 1), b2 + hstep, voffB);
            PG8_WAIT_V(6); PG8_BAR; PG8_MMA(1, 1, At, B1); PG8_BAR;
            PG8_LDB(B0, 1, 0); PG8_SCHED; PG8_LDA(At, 1, 0); PG8_STAGE(PG8_SA(0, 1), a2 + hstep, voffA);
            PG8_WAIT_L(8); PG8_BAR; PG8_WAIT_L(0); PG8_MMA(0, 0, At, B0); PG8_BAR; PG8_SCHED;
            PG8_LDB(B1, 1, 1); PG8_STAGE(PG8_SB(1, 0), b3, voffB);
            PG8_BAR; PG8_WAIT_L(0); PG8_MMA(0, 1, At, B1); PG8_BAR;
            PG8_LDA(At, 1, 1); PG8_STAGE(PG8_SA(1, 0), a3, voffA);
            PG8_BAR; PG8_WAIT_L(0); PG8_MMA(1, 0, At, B0); PG8_BAR; PG8_SCHED;
            PG8_STAGE(PG8_SB(1, 1), b3 + hstep, voffB);
            PG8_WAIT_V(6); PG8_BAR; PG8_MMA(1, 1, At, B1); PG8_BAR;
            }
        }
        if constexpr (F8) asm volatile("s_nop 15\n\ts_nop 7" ::: "memory");
        if constexpr (ALIGN_EPI) { if (wr == 0) PG8_BAR; }
        if constexpr (!Epi::AFTER_DRAIN) { E(acc, cur, wr, wc, fr, fq); S.done(cur); }
        if (!has_next) break;
#pragma unroll
        for (int a = 0; a < 2; ++a)
#pragma unroll
            for (int b = 0; b < 2; ++b)
#pragma unroll
                for (int m = 0; m < 4; ++m)
#pragma unroll
                    for (int n = 0; n < 2; ++n) acc[a][b][m][n] = (f32x4){0.f, 0.f, 0.f, 0.f};
        cur = nxt; cA = nA; cB = nB; ++ui;
        if constexpr (ALIGN_EPI) { if (wr == 1) PG8_BAR; }
    }
    PG8_WAIT_V(0);
    if constexpr (!ALIGN_EPI) { if (wr == 0) PG8_BAR; }
    PG8_BAR;
    if constexpr (Epi::AFTER_DRAIN) { E.fused(acc, cur, wr, wc, fr, fq, lds, wid, lane); S.done(cur); }
#undef PG8_SA
#undef PG8_SB
#undef PG8_STAGE
#undef PG8_LDA
#undef PG8_LDB
#undef PG8_MMA
#undef PG8_H
#undef PG8_LD8
#undef PG8_WAIT_V
#undef PG8_WAIT_L
#undef PG8_BAR
#undef PG8_SCHED
}
}
#define GAS __attribute__((address_space(1)))
#define LAS __attribute__((address_space(3)))
#define XB_TMO      128
#define XB_XCNT(j)  (256  + 64 * (j))
#define XB_XSUB(j)  (1280 + 64 * (j))
#define XB_XGEN(j)  (2304 + 64 * (j))
#define XB_TOP      3328
#define XB_TOPGEN   3392
#define XCD_BAR_WORDS 3456
#define XB_SPIN_CAP (1u << 18)

__device__ __forceinline__ unsigned xb_ld(unsigned* p)              { return __hip_atomic_load(p, __ATOMIC_RELAXED, __HIP_MEMORY_SCOPE_AGENT); }
__device__ __forceinline__ unsigned xb_add(unsigned* p, unsigned v) { return __hip_atomic_fetch_add(p, v, __ATOMIC_RELAXED, __HIP_MEMORY_SCOPE_AGENT); }
__device__ __forceinline__ unsigned xb_xcc_id() { return (unsigned)__builtin_amdgcn_s_getreg((3 << 11) | 20) & 0xFu; }
#define XB_SPIN(cond, bar) do { unsigned _sp = 0; while (cond) { __builtin_amdgcn_s_sleep(1); \
    if ((++_sp & 255u) == 0u) { if (xb_ld(&(bar)[XB_TMO])) break; if (_sp > XB_SPIN_CAP) { atomicAdd(&(bar)[XB_TMO], 1u); break; } } } } while (0)

struct XcdBarrier {
    unsigned* bar; unsigned x;
    volatile LAS unsigned* st;
};

__device__ __forceinline__ XcdBarrier xcd_barrier_post(unsigned* bar, volatile LAS unsigned* st) {
    XcdBarrier b; b.bar = bar; b.x = xb_xcc_id(); b.st = st;
    if (threadIdx.x == 0) (void)xb_add(&bar[XB_XCNT(b.x)], 1u);
    return b;
}
__device__ __forceinline__ void xcd_barrier_complete(unsigned* bar, unsigned x, unsigned& nloc, unsigned& nx) {
    const unsigned G = gridDim.x * gridDim.y * gridDim.z;
    unsigned sum, cnt, mine, sp = 0u;
    for (;;) {
        sum = 0u; cnt = 0u; mine = 0u;
#pragma unroll
        for (unsigned j = 0; j < 16; ++j) { const unsigned c = xb_ld(&bar[XB_XCNT(j)]); sum += c; cnt += (c > 0u) ? 1u : 0u; mine = (j == x) ? c : mine; }
        if (sum == G) break;
        __builtin_amdgcn_s_sleep(1);
        if ((++sp & 255u) == 0u) { if (xb_ld(&bar[XB_TMO])) break; if (sp > XB_SPIN_CAP) { atomicAdd(&bar[XB_TMO], 1u); break; } }
    }
    nloc = mine > 0u ? mine : 1u; nx = cnt > 0u ? cnt : 1u;
}

__device__ __forceinline__ void xcd_barrier(const XcdBarrier& b) {
    asm volatile("s_waitcnt vmcnt(0)" ::: "memory");
    __syncthreads();
    if (threadIdx.x == 0) {
        unsigned* bar = b.bar;
        __builtin_amdgcn_s_waitcnt(0);
        unsigned nloc = b.st[0], nx = b.st[1];
        if (nloc == 0u) { xcd_barrier_complete(bar, b.x, nloc, nx); b.st[0] = nloc; b.st[1] = nx; }
        const unsigned old = xb_add(&bar[XB_XSUB(b.x)], 1u);
        const unsigned gen = old / nloc;
        if (old + 1u == (gen + 1u) * nloc) {
            __builtin_amdgcn_fence(__ATOMIC_RELEASE, "agent");
            asm volatile("s_waitcnt vmcnt(0)" ::: "memory");
            const unsigned og = xb_add(&bar[XB_TOP], 1u);
            const unsigned tg = og / nx;
            if (og + 1u == (tg + 1u) * nx) xb_add(&bar[XB_TOPGEN], 1u);
            else XB_SPIN(xb_ld(&bar[XB_TOPGEN]) == tg, bar);
            __builtin_amdgcn_fence(__ATOMIC_ACQUIRE, "agent");
            xb_add(&bar[XB_XGEN(b.x)], 1u);
            asm volatile("s_waitcnt vmcnt(0)" ::: "memory");
        } else {
            XB_SPIN(xb_ld(&bar[XB_XGEN(b.x)]) == gen, bar);
            __builtin_amdgcn_fence(__ATOMIC_ACQUIRE, "agent");
            asm volatile("s_waitcnt vmcnt(0)" ::: "memory");
        }
    }
    __syncthreads();
}

#ifndef MK_SPLIT
#define MK_SPLIT 0
#endif
#ifndef P8_NP
#define P8_NP 4
#endif
constexpr int NWAVES = 8;
constexpr int NB = 2, SEQ = 4096, DM = 2048, T = NB * SEQ, HD = 128;
constexpr int INW = 10240;
constexpr int C_QA = 0, C_KA = 1024, C_VA = 1280, C_QB = 1536, C_KB = 3072, C_VB = 4608, C_GA = 6144, C_GB = 8192;
constexpr int AQW = 1024, BOW = 512;
constexpr int NEXP = 16384, PHEADS = 8, NKEYS = 128, TOPK = 16;
constexpr int NBIAS = 20;
constexpr float EPS = 1e-6f;
constexpr float SM_SCALE = 0.088388347648318440f;
constexpr float LOG2E = 1.4426950408889634f;
constexpr float A_SCALE = 16.f;
constexpr float M_SCALE = 64.f;
constexpr float W_SCALE = 512.f;

constexpr size_t MiB = 1u << 20;
constexpr size_t WS_CTL = 0, CTL_ZERO_BYTES = 16384;
constexpr size_t WS_WIN = 1 * MiB;
constexpr size_t WS_WOA = 41 * MiB;
constexpr size_t WS_WOB = 45 * MiB;
constexpr size_t WS_WOUT = 47 * MiB;
constexpr size_t WS_W2 = 55 * MiB;
constexpr size_t WS_U = 63 * MiB;
constexpr size_t WS_V = 95 * MiB;
constexpr size_t WS_ESC = 127 * MiB;
constexpr size_t WS_PROJ = 191 * MiB;
constexpr size_t WS_SC = WS_PROJ;
constexpr size_t WS_H = 351 * MiB;
constexpr size_t WS_MRG = WS_H;
constexpr size_t WS_ATTA = 383 * MiB;
constexpr size_t WS_OB = 399 * MiB;
constexpr size_t WS_X1B = WS_ATTA;
constexpr size_t WS_ATTB = 423 * MiB;
constexpr size_t WS_LSE = 431 * MiB;
constexpr size_t WS_PART = 432 * MiB;
constexpr size_t WS_TKI = 433 * MiB;
constexpr size_t WS_TKG = 437 * MiB;
constexpr size_t WS_MRG8 = 441 * MiB;
constexpr size_t WS_END = 457 * MiB;
constexpr int CW_BAR = 0;

constexpr int RING_OFF = 0, RING_BYTES = 131072;
constexpr int LDSCTL_OFF = RING_BYTES, MISC_OFF = LDSCTL_OFF + 320;
constexpr int RSTD_OFF = RING_BYTES + 1024;
constexpr int LDS_BYTES = 147456;
static_assert(RSTD_OFF + 1024 <= LDS_BYTES && XCD_BAR_WORDS * 4 <= (int)CTL_ZERO_BYTES, "maps");

typedef unsigned short bf16;
typedef unsigned v4u __attribute__((ext_vector_type(4)));
typedef unsigned v2u __attribute__((ext_vector_type(2)));
typedef float f32x4 __attribute__((ext_vector_type(4)));
typedef float f32x16 __attribute__((ext_vector_type(16)));
typedef short bf16x8 __attribute__((ext_vector_type(8)));
typedef short s16x4 __attribute__((ext_vector_type(4)));
typedef __bf16 bf16x2 __attribute__((ext_vector_type(2)));
#define LDS_WAIT() asm volatile("s_waitcnt lgkmcnt(0)" ::: "memory")
#define VM_WAIT() asm volatile("s_waitcnt vmcnt(0)" ::: "memory")
#define SBAR() __builtin_amdgcn_sched_barrier(0)
__device__ __forceinline__ unsigned cvtpk(float lo, float hi) { unsigned r; asm volatile("v_cvt_pk_bf16_f32 %0, %1, %2" : "=v"(r) : "v"(lo), "v"(hi)); return r; }
__device__ __forceinline__ float bflo(unsigned w) { return __builtin_bit_cast(float, w << 16); }
__device__ __forceinline__ float bfhi(unsigned w) { return __builtin_bit_cast(float, w & 0xffff0000u); }
__device__ __forceinline__ float dot2_bf16(unsigned w, unsigned x, float acc) { return __builtin_amdgcn_fdot2_f32_bf16(__builtin_bit_cast(bf16x2, w), __builtin_bit_cast(bf16x2, x), acc, false); }
__device__ __forceinline__ float wave_sum(float v) {
#pragma unroll
    for (int o = 1; o < 64; o <<= 1) v += __shfl_xor(v, o);
    return v;
}

struct Lane { int tid, lane, wave, gw; };
__device__ __forceinline__ Lane lane_state() { int t = threadIdx.x; asm volatile("" : "+v"(t)); Lane L; L.tid = t; L.lane = t & 63; L.wave = __builtin_amdgcn_readfirstlane(t >> 6); L.gw = blockIdx.x * 8 + L.wave; return L; }
struct Frame {
    LAS unsigned char* lds; char* ldsg;
    int G, NGW;
    const float *x, *rel_bias, *g_mix, *w_in, *sink_a, *w_oa, *w_ob, *w_out, *g_ffn, *w_pq, *keys, *eu, *ev, *g_fin;
    float* out; unsigned char* ws;
};

__device__ __forceinline__ unsigned pk4_fp8(float a, float b, float c, float d) { int p = __builtin_amdgcn_cvt_pk_fp8_f32(fminf(fmaxf(a, -448.f), 448.f), fminf(fmaxf(b, -448.f), 448.f), 0, false);
    return (unsigned)__builtin_amdgcn_cvt_pk_fp8_f32(fminf(fmaxf(c, -448.f), 448.f), fminf(fmaxf(d, -448.f), 448.f), p, true); }
__device__ __forceinline__ void p0_transpose_item_f8(const float* W, int K, int N, unsigned char* WT, float scale, LAS float* scr, int item, int lane) {
    const int nblk = N / 32, kb = item / nblk, nb = item % nblk, k0 = 64 * kb, n0 = 32 * nb;
    { f32x4 v[8];
#pragma unroll
      for (int i = 0; i < 8; ++i) v[i] = *(const f32x4*)(W + (size_t)(k0 + 8 * i + (lane >> 3)) * N + n0 + 4 * (lane & 7));
#pragma unroll
      for (int i = 0; i < 8; ++i) { LAS float* d = scr + (8 * i + (lane >> 3)) * 33 + 4 * (lane & 7); d[0] = v[i][0] * scale; d[1] = v[i][1] * scale; d[2] = v[i][2] * scale; d[3] = v[i][3] * scale; } }
    LDS_WAIT(); asm volatile("" ::: "memory");
    const int c = lane & 7;
#pragma unroll
    for (int j = 0; j < 4; ++j) { const int n = (lane >> 3) + 8 * j; const LAS float* s = scr + (8 * c) * 33 + n;
        v2u o; o.x = pk4_fp8(s[0 * 33], s[1 * 33], s[2 * 33], s[3 * 33]); o.y = pk4_fp8(s[4 * 33], s[5 * 33], s[6 * 33], s[7 * 33]);
        *(v2u*)(WT + (size_t)(n0 + n) * K + k0 + 8 * c) = o; }
    LDS_WAIT(); asm volatile("" ::: "memory");
}
__device__ __forceinline__ void p0_transpose_item(const float* W, int K, int N, bf16* WT, LAS float* scr, int item, int lane) {
    const int nblk = N / 32, kb = item / nblk, nb = item % nblk, k0 = 64 * kb, n0 = 32 * nb;
    { f32x4 v[8];
#pragma unroll
      for (int i = 0; i < 8; ++i) v[i] = *(const f32x4*)(W + (size_t)(k0 + 8 * i + (lane >> 3)) * N + n0 + 4 * (lane & 7));
#pragma unroll
      for (int i = 0; i < 8; ++i) { LAS float* d = scr + (8 * i + (lane >> 3)) * 33 + 4 * (lane & 7); d[0] = v[i][0]; d[1] = v[i][1]; d[2] = v[i][2]; d[3] = v[i][3]; } }
    LDS_WAIT(); asm volatile("" ::: "memory");
    const int c = lane & 7;
#pragma unroll
    for (int j = 0; j < 4; ++j) { const int n = (lane >> 3) + 8 * j; const LAS float* s = scr + (8 * c) * 33 + n;
        v4u o; o.x = cvtpk(s[0 * 33], s[1 * 33]); o.y = cvtpk(s[2 * 33], s[3 * 33]); o.z = cvtpk(s[4 * 33], s[5 * 33]); o.w = cvtpk(s[6 * 33], s[7 * 33]);
        *(v4u*)(WT + (size_t)(n0 + n) * K + k0 + 8 * c) = o; }
    LDS_WAIT(); asm volatile("" ::: "memory");
}
__device__ __forceinline__ void p0_w2_item(Frame& F, bf16* W2T, int item, int tid) {
    const int hc = item >> 5, j0 = (item & 31) * 64;
    LAS float* Ks = (LAS float*)F.lds; LAS float* Ws = Ks + 128 * 129;
    const f32x4* kp = (const f32x4*)(F.keys + (size_t)hc * 16384);
#pragma unroll
    for (int q = 0; q < 8; ++q) { const int idx = tid + 512 * q, row = idx >> 5, c4 = idx & 31; const f32x4 v = kp[idx];
        LAS float* d = Ks + row * 129 + c4 * 4; d[0] = v[0]; d[1] = v[1]; d[2] = v[2]; d[3] = v[3]; }
#pragma unroll
    for (int q = 0; q < 4; ++q) { const int idx = tid + 512 * q, row = idx >> 5, c4 = idx & 31; const f32x4 v = *(const f32x4*)(F.w_pq + (size_t)(j0 + row) * DM + hc * 128 + c4 * 4);
        LAS float* d = Ws + row * 129 + c4 * 4; d[0] = v[0]; d[1] = v[1]; d[2] = v[2]; d[3] = v[3]; }
    __syncthreads();
    { const int wv = tid >> 6, ln = tid & 63, kt = wv & 3, jt = wv >> 2, r = ln & 31, h2 = ln >> 5;
      const LAS float* ap = Ks + (kt * 32 + r) * 129 + h2; const LAS float* bp = Ws + (jt * 32 + r) * 129 + h2;
      f32x16 acc = {};
#pragma unroll 8
      for (int d0 = 0; d0 < 128; d0 += 2) acc = __builtin_amdgcn_mfma_f32_32x32x2f32(ap[d0], bp[d0], acc, 0, 0, 0);
      const int j = j0 + jt * 32 + r; const float g = F.g_ffn[j];
#pragma unroll
      for (int q = 0; q < 16; ++q) { const int k = kt * 32 + (q & 3) + 8 * (q >> 2) + 4 * h2; const float v = acc[q] * g;
          W2T[(size_t)(hc * 128 + k) * DM + j] = (bf16)(cvtpk(v, v) & 0xffffu); } }
    __syncthreads();
}
__device__ __forceinline__ void tab_issue(const Frame& F, int row, int lane, f32x4 (&v)[8]) {
    const float* src = (row < NEXP ? F.eu + (size_t)row * DM : F.ev + (size_t)(row - NEXP) * DM) + 4 * lane;
#pragma unroll
    for (int j = 0; j < 8; ++j) v[j] = *(const f32x4*)(src + 256 * j);
}
__device__ __forceinline__ void tab_finish(const Frame& F, int row, int lane, const f32x4 (&v)[8]) {
    static_assert(P8_NP == 4 && WS_V == WS_U + (size_t)NEXP * DM, "table layout");
    float am = 0.f;
#pragma unroll
    for (int j = 0; j < 8; ++j) am = fmaxf(am, fmaxf(fmaxf(fabsf(v[j][0]), fabsf(v[j][1])), fmaxf(fabsf(v[j][2]), fabsf(v[j][3]))));
#pragma unroll
    for (int o = 1; o < 64; o <<= 1) am = fmaxf(am, __shfl_xor(am, o));
    const float inv = am > 0.f ? 400.f / am : 0.f;
    unsigned char* dst = F.ws + WS_U + (size_t)(row >= NEXP) * ((size_t)NEXP * DM) + (size_t)(row & (NEXP - 1)) * 512 + 4 * lane;
#pragma unroll
    for (int j = 0; j < 8; ++j) { const f32x4 t = v[j] * inv; int pk = __builtin_amdgcn_cvt_pk_fp8_f32(t[0], t[1], 0, false); pk = __builtin_amdgcn_cvt_pk_fp8_f32(t[2], t[3], pk, true);
        *(unsigned*)(dst + (size_t)(j >> 1) * ((size_t)NEXP * 512) + (j & 1) * 256) = (unsigned)pk; }
    if (lane == 0) ((float*)(F.ws + WS_ESC))[row] = am * (1.f / 400.f);
}
__device__ __forceinline__ void p6_tables(Frame& F) {
    const Lane Ls = lane_state();
    for (int row = Ls.gw; row < 2 * NEXP; row += 2 * F.NGW) { f32x4 v0[8], v1[8]; const int row1 = row + F.NGW;
        tab_issue(F, row, Ls.lane, v0); if (row1 < 2 * NEXP) tab_issue(F, row1, Ls.lane, v1);
        tab_finish(F, row, Ls.lane, v0); if (row1 < 2 * NEXP) tab_finish(F, row1, Ls.lane, v1); }
}
__device__ __forceinline__ void p0_prologue(Frame& F) {
    const Lane Ls = lane_state();
    LAS float* scr = (LAS float*)(F.lds + RING_OFF + Ls.wave * 16384);
    bf16* WinT = (bf16*)(F.ws + WS_WIN); bf16* WoaT = (bf16*)(F.ws + WS_WOA); bf16* WobT = (bf16*)(F.ws + WS_WOB); bf16* WoutT = (bf16*)(F.ws + WS_WOUT);
    constexpr int I_IN = (DM / 64) * (INW / 32), I_OA = (AQW / 64) * (DM / 32), I_OB = (BOW / 64) * (DM / 32), I_OUT = (DM / 64) * (DM / 32);
    constexpr int NITEMS = I_IN + I_OA + I_OB + I_OUT;
    for (int it = Ls.gw; it < NITEMS; it += F.NGW) {
        int r = it;
        if (r < I_IN) { p0_transpose_item_f8(F.w_in, DM, INW, (unsigned char*)WinT, W_SCALE, scr, r, Ls.lane); continue; } r -= I_IN;
        if (r < I_OA) { p0_transpose_item_f8(F.w_oa, AQW, DM, (unsigned char*)WoaT, W_SCALE, scr, r, Ls.lane); continue; } r -= I_OA;
        if (r < I_OB) { p0_transpose_item_f8(F.w_ob, BOW, DM, (unsigned char*)WobT, W_SCALE, scr, r, Ls.lane); continue; } r -= I_OB;
        p0_transpose_item_f8(F.w_out, DM, DM, (unsigned char*)WoutT, W_SCALE, scr, r, Ls.lane);
    }
    __syncthreads();
    for (int it = blockIdx.x; it < 512; it += F.G) p0_w2_item(F, (bf16*)(F.ws + WS_W2), it, Ls.tid);
    { bf16* Hb = (bf16*)(F.ws + WS_H);
      for (int m = Ls.gw; m < T; m += F.NGW) {
          const f32x4* xr = (const f32x4*)(F.x + (size_t)m * DM) + Ls.lane; f32x4 v[8]; float s = 0.f;
#pragma unroll
          for (int j = 0; j < 8; ++j) { v[j] = xr[64 * j]; s += (v[j][0] * v[j][0] + v[j][1] * v[j][1]) + (v[j][2] * v[j][2] + v[j][3] * v[j][3]); }
          const float rstd = rsqrtf(wave_sum(s) * (1.f / DM) + EPS);
          unsigned* o4 = (unsigned*)((unsigned char*)Hb + (size_t)m * DM) + Ls.lane;
#pragma unroll
          for (int j = 0; j < 8; ++j) { const f32x4 g = ((const f32x4*)F.g_mix)[Ls.lane + 64 * j];
              o4[64 * j] = pk4_fp8(v[j][0] * rstd * g[0], v[j][1] * rstd * g[1], v[j][2] * rstd * g[2], v[j][3] * rstd * g[3]); } } }
}

namespace att {
#define KSWZ(row, colB) ((row) * 256 + ((colB) ^ (((row) & 7) << 4)))
__device__ __forceinline__ int crow(int r, int hi) { return (r & 3) + 8 * (r >> 2) + 4 * hi; }
__device__ __forceinline__ void qkt(f32x16& p0, f32x16& p1, const char* Ks, const bf16x8* qr, int r32, int hi) {
    p0 = f32x16{}; p1 = f32x16{};
#pragma unroll
    for (int d0 = 0; d0 < 8; ++d0) { const int cb = (d0 * 16 + hi * 8) * 2;
        const bf16x8 b0 = *reinterpret_cast<const bf16x8*>(Ks + KSWZ(r32, cb));
        const bf16x8 b1 = *reinterpret_cast<const bf16x8*>(Ks + KSWZ(32 + r32, cb));
        p0 = __builtin_amdgcn_mfma_f32_32x32x16_bf16(b0, qr[d0], p0, 0, 0, 0);
        p1 = __builtin_amdgcn_mfma_f32_32x32x16_bf16(b1, qr[d0], p1, 0, 0, 0); }
}
__device__ __forceinline__ int v_st(int k, int c) { const int kk = (k & ~0xC) | ((k & 4) << 1) | ((k & 8) >> 1); return ((kk >> 3) * 4 + (c >> 5)) * 512 + ((kk & 7) * 32 + (c & 31)) * 2; }
__device__ __forceinline__ int v_rd_base(int lane) { return ((lane & 3) << 3) | (((lane >> 2) & 3) << 6) | (((lane >> 4) & 1) << 5) | (((lane >> 5) & 1) << 8); }
constexpr int v_rd_off(int d0, int ks, int half) { return d0 * 512 + ks * 4096 + half * 2048; }
template <int OFF> __device__ __forceinline__ s16x4 tr_read(int vb) {
    s16x4 r; asm volatile("ds_read_b64_tr_b16 %0, %1 offset:%2" : "=&v"(r) : "v"(vb), "i"(OFF) : "memory"); return r;
}
template <int D0> __device__ __forceinline__ void pv_one(f32x16& od, int vb, bf16x8 pa0, bf16x8 pa1, bf16x8 pa2, bf16x8 pa3) {
    const s16x4 l0 = tr_read<v_rd_off(D0, 0, 0)>(vb), h0 = tr_read<v_rd_off(D0, 0, 1)>(vb), l1 = tr_read<v_rd_off(D0, 1, 0)>(vb), h1 = tr_read<v_rd_off(D0, 1, 1)>(vb);
    const s16x4 l2 = tr_read<v_rd_off(D0, 2, 0)>(vb), h2 = tr_read<v_rd_off(D0, 2, 1)>(vb), l3 = tr_read<v_rd_off(D0, 3, 0)>(vb), h3 = tr_read<v_rd_off(D0, 3, 1)>(vb);
    asm volatile("s_waitcnt lgkmcnt(0)" ::: "memory"); SBAR();
#define PK(L, H) (bf16x8){L[0], L[1], L[2], L[3], H[0], H[1], H[2], H[3]}
    od = __builtin_amdgcn_mfma_f32_32x32x16_bf16(pa0, PK(l0, h0), od, 0, 0, 0);
    od = __builtin_amdgcn_mfma_f32_32x32x16_bf16(pa1, PK(l1, h1), od, 0, 0, 0);
    od = __builtin_amdgcn_mfma_f32_32x32x16_bf16(pa2, PK(l2, h2), od, 0, 0, 0);
    od = __builtin_amdgcn_mfma_f32_32x32x16_bf16(pa3, PK(l3, h3), od, 0, 0, 0);
#undef PK
}
__device__ __forceinline__ void pv_d0(f32x16* o, int vb, bf16x8 pa0, bf16x8 pa1, bf16x8 pa2, bf16x8 pa3) {
    pv_one<0>(o[0], vb, pa0, pa1, pa2, pa3); pv_one<1>(o[1], vb, pa0, pa1, pa2, pa3); pv_one<2>(o[2], vb, pa0, pa1, pa2, pa3); pv_one<3>(o[3], vb, pa0, pa1, pa2, pa3);
}
__device__ __forceinline__ int t5_bucket(int rel) {
    const int n = rel < 0 ? -rel : rel; int b;
    if (n < 8) b = n; else { b = 8 + (n >= 15) + (n >= 27) + (n >= 50) + (n >= 91) + (n >= 166) + (n >= 305) + (n >= 559); b = b > 15 ? 15 : b; }
    return b + (rel > 0 ? 16 : 0);
}
constexpr int ATT_WS_OFF = RSTD_OFF + 1024, ATT_BT_OFF = ATT_WS_OFF + 2048;
static_assert(ATT_BT_OFF + 2 * 1040 <= LDS_BYTES, "attention scratch above the stage region");
template <int W, bool SINK>
__device__ __forceinline__ void attn_unit(char* lds, const bf16* proj, int b, int qcol, int kcol, int vcol, int d, int r, int m0u,
                                          const float* bias_col, float sinkv, bf16* O, int ldo, int ocol, float* lse, int lse_j) {
    int tid_ = threadIdx.x; asm volatile("" : "+v"(tid_));
    const int tid = tid_, wid = __builtin_amdgcn_readfirstlane(tid >> 6), lane = tid & 63, r32 = lane & 31, hi = lane >> 5;
    const int hh = wid >> 2, wq = wid & 3, htid = tid & 255;
    constexpr int NT = (128 + 2 * W) / 64;
    const int L = SEQ / d, m0 = m0u + 128 * hh;
    char* hbase = lds + hh * 65536;
    float* ws = (float*)(lds + ATT_WS_OFF) + wid * 64; float* li_l = ws; float* al_l = ws + 32;
    float* btab = (float*)(lds + ATT_BT_OFF + hh * 1040);
    __syncthreads();
    for (int i = htid; i <= 2 * W; i += 256) btab[i] = bias_col[t5_bucket((i - W) * d) * NBIAS];
    const int qm = m0 + wq * 32 + r32;
    const size_t tok0 = (size_t)b * SEQ + r;
    bf16x8 qr[8];
    { const bf16* Qw = proj + ((size_t)(qcol >> 7) * T + tok0 + (size_t)qm * d) * 128 + hi * 8;
#pragma unroll
      for (int d0 = 0; d0 < 8; ++d0) qr[d0] = *reinterpret_cast<const bf16x8*>(Qw + d0 * 16); }
    float m_run = SINK ? sinkv : -1e29f, l_run = SINK ? 1.f : 0.f;
    f32x16 o[4] = {};
    const int sr = htid >> 4, sc = (htid & 15) * 8;
    const int t_lo = wq >> 1, t_hi = (32 * wq + 31 + 2 * W) >> 6;
    bf16x8 vs[4], ks[4];
#define SLOAD(t) do { const int tm = m0 - W + 64 * (t); if (tm + 63 >= 0 && tm < L) { _Pragma("unroll") for (int i_ = 0; i_ < 4; ++i_) { int k_ = tm + sr + 16 * i_; k_ = k_ < 0 ? 0 : (k_ > L - 1 ? L - 1 : k_); \
        const size_t tk_ = tok0 + (size_t)k_ * d; vs[i_] = *reinterpret_cast<const bf16x8*>(proj + ((size_t)(vcol >> 7) * T + tk_) * 128 + sc); ks[i_] = *reinterpret_cast<const bf16x8*>(proj + ((size_t)(kcol >> 7) * T + tk_) * 128 + sc); } } } while (0)
#define SWRITE(t) do { const int tm = m0 - W + 64 * (t); if (tm + 63 >= 0 && tm < L) { char* vb_ = hbase + ((t) & 1) * 32768; char* kb_ = vb_ + 16384; _Pragma("unroll") for (int i_ = 0; i_ < 4; ++i_) { \
        *(bf16x8*)(vb_ + v_st(sr + 16 * i_, sc)) = vs[i_]; *(bf16x8*)(kb_ + KSWZ(sr + 16 * i_, sc * 2)) = ks[i_]; } } } while (0)
    SLOAD(0);
#pragma unroll 1
    for (int t = 0; t < NT; ++t) {
        SWRITE(t);
        __syncthreads();
        if (t + 1 < NT) SLOAD(t + 1);
        const int tm0 = m0 - W + 64 * t;
        if (t >= t_lo && t <= t_hi && tm0 + 63 >= 0 && tm0 < L) {
            const char* V_lds = hbase + (t & 1) * 32768; const char* K_lds = V_lds + 16384;
            const int vb0 = (int)(uintptr_t)V_lds + v_rd_base(lane);
            f32x16 p0, p1; qkt(p0, p1, K_lds, qr, r32, hi);
            const int base = tm0 - qm + W;
            float pmax = -1e30f;
#pragma unroll
            for (int q = 0; q < 16; ++q) { const int key = crow(q, hi), idx = base + key, km = tm0 + key;
                const bool ok = (unsigned)idx <= (unsigned)(2 * W) && (unsigned)km < (unsigned)L;
                const float bv = btab[ok ? idx : 0]; const float s = ok ? fmaf(p0[q], SM_SCALE, bv) : -1e30f; p0[q] = s; pmax = fmaxf(pmax, s); }
#pragma unroll
            for (int q = 0; q < 16; ++q) { const int key = 32 + crow(q, hi), idx = base + key, km = tm0 + key;
                const bool ok = (unsigned)idx <= (unsigned)(2 * W) && (unsigned)km < (unsigned)L;
                const float bv = btab[ok ? idx : 0]; const float s = ok ? fmaf(p1[q], SM_SCALE, bv) : -1e30f; p1[q] = s; pmax = fmaxf(pmax, s); }
            { auto rr = __builtin_amdgcn_permlane32_swap(__float_as_uint(pmax), __float_as_uint(pmax), false, false);
              pmax = fmaxf(__uint_as_float(rr[0]), __uint_as_float(rr[1])); }
            const float mn = fmaxf(m_run, pmax), alpha = __builtin_amdgcn_exp2f((m_run - mn) * LOG2E); m_run = mn;
            const float mnc = -mn * LOG2E; float ps = 0.f;
#pragma unroll
            for (int q = 0; q < 16; ++q) { p0[q] = __builtin_amdgcn_exp2f(fmaf(p0[q], LOG2E, mnc)); ps += p0[q]; }
#pragma unroll
            for (int q = 0; q < 16; ++q) { p1[q] = __builtin_amdgcn_exp2f(fmaf(p1[q], LOG2E, mnc)); ps += p1[q]; }
            { auto rr = __builtin_amdgcn_permlane32_swap(__float_as_uint(ps), __float_as_uint(ps), false, false);
              ps = __uint_as_float(rr[0]) + __uint_as_float(rr[1]); }
            l_run = l_run * alpha + ps;
            if (__any(alpha < 1.f)) { if (hi == 0) al_l[r32] = alpha; asm volatile("s_waitcnt lgkmcnt(0)" ::: "memory");
#pragma unroll
                for (int dd = 0; dd < 4; ++dd)
#pragma unroll
                    for (int q = 0; q < 16; ++q) o[dd][q] *= al_l[crow(q, hi)]; }
            bf16x8 pa0, pa1, pa2, pa3;
#define PK4(P, BASE, OUT) do { unsigned a0 = cvtpk(P[BASE + 0], P[BASE + 1]), a1 = cvtpk(P[BASE + 2], P[BASE + 3]);   \
    unsigned b0 = cvtpk(P[BASE + 4], P[BASE + 5]), b1 = cvtpk(P[BASE + 6], P[BASE + 7]);                              \
    auto r0 = __builtin_amdgcn_permlane32_swap(a0, b0, false, false); auto r1 = __builtin_amdgcn_permlane32_swap(a1, b1, false, false); \
    v4u w = {r0[0], r1[0], r0[1], r1[1]}; OUT = *reinterpret_cast<bf16x8*>(&w); } while (0)
            PK4(p0, 0, pa0); PK4(p0, 8, pa1); PK4(p1, 0, pa2); PK4(p1, 8, pa3);
#undef PK4
            pv_d0(o, vb0, pa0, pa1, pa2, pa3);
        }
    }
#undef SLOAD
#undef SWRITE
    if (hi == 0) li_l[r32] = l_run; asm volatile("s_waitcnt lgkmcnt(0)" ::: "memory");
    if (!SINK && hi == 0) lse[(tok0 + (size_t)qm * d) * 4 + lse_j] = m_run + __logf(l_run);
    __syncthreads();
    if constexpr (SINK) {
      char* ost = lds + wid * 8704; unsigned char* O8 = (unsigned char*)O;
#pragma unroll
      for (int q = 0; q < 16; ++q) { const float rl = __builtin_amdgcn_rcpf(li_l[crow(q, hi)]) * A_SCALE; unsigned char* orow = (unsigned char*)(ost + crow(q, hi) * 144) + r32;
#pragma unroll
          for (int dd = 0; dd < 4; ++dd) { const float v = fminf(fmaxf(o[dd][q] * rl, -448.f), 448.f); orow[dd * 32] = (unsigned char)(__builtin_amdgcn_cvt_pk_fp8_f32(v, v, 0, false) & 0xff); } }
      asm volatile("s_waitcnt lgkmcnt(0)" ::: "memory");
      const int rr = lane >> 3, cc = lane & 7;
#pragma unroll
      for (int k = 0; k < 4; ++k) { const int row = rr + 8 * k; const v4u w = *(const v4u*)(ost + row * 144 + cc * 16);
          *(v4u*)(O8 + (tok0 + (size_t)(m0 + wq * 32 + row) * d) * ldo + ocol + cc * 16) = w; }
    } else {
      char* ost = lds + wid * 8704;
#pragma unroll
      for (int q = 0; q < 16; ++q) { const float rl = __builtin_amdgcn_rcpf(li_l[crow(q, hi)]); unsigned short* orow = (unsigned short*)(ost + crow(q, hi) * 272) + r32;
#pragma unroll
          for (int dd = 0; dd < 4; ++dd) { const float v = o[dd][q] * rl; orow[dd * 32] = (unsigned short)(cvtpk(v, v) & 0xffffu); } }
      asm volatile("s_waitcnt lgkmcnt(0)" ::: "memory");
      const int rr = lane >> 4, cc = lane & 15;
#pragma unroll
      for (int k = 0; k < 8; ++k) { const int row = rr + 4 * k; const v4u w = *(const v4u*)(ost + row * 272 + cc * 16);
          *(v4u*)(O + (tok0 + (size_t)(m0 + wq * 32 + row) * d) * ldo + ocol + cc * 8) = w; } }
}
}

__device__ __forceinline__ void p2_attention(Frame& F) {
    const bf16* proj = (const bf16*)(F.ws + WS_PROJ);
    bf16* attA = (bf16*)(F.ws + WS_ATTA); bf16* oB = (bf16*)(F.ws + WS_OB); float* lseB = (float*)(F.ws + WS_LSE);
    const int vcu = (F.G & 7) ? (int)blockIdx.x : (int)(blockIdx.x & 7) * (F.G >> 3) + (int)(blockIdx.x >> 3);
    const bool bal = F.G == 256; const int nmine = bal ? (vcu < 128 ? 2 : 3) : (640 - vcu + F.G - 1) / F.G;
    for (int ui = 0; ui < nmine; ++ui) { const int uid = bal ? (vcu < 128 ? 2 * vcu + ui : 256 + 3 * (vcu - 128) + ui) : vcu + ui * F.G;
        if (uid < 256) {
            const int b = uid >> 7, rem = uid & 127, blk = rem >> 3, hq = rem & 7, kvh = hq >> 2;
            att::attn_unit<128, true>(F.ldsg, proj, b, C_QA + hq * HD, C_KA + kvh * HD, C_VA + kvh * HD, 1, 0, blk * 256,
                                      F.rel_bias + hq, F.sink_a[hq], attA, AQW, hq * HD, nullptr, 0);
        } else {
            const int u2 = uid - 256, gi = u2 >> 7, rem = u2 & 127, b = rem >> 6, blk = (rem >> 2) & 15, j = rem & 3;
            const int d = gi == 0 ? 1 : (gi == 1 ? 4 : 16), nbr = 16 / d, r = blk / nbr, m0 = (blk % nbr) * 256, hb = gi * 4 + j;
            att::attn_unit<64, false>(F.ldsg, proj, b, C_QB + hb * HD, C_KB + hb * HD, C_VB + hb * HD, d, r, m0,
                                      F.rel_bias + 8 + hb, 0.f, oB + (size_t)gi * T * BOW, BOW, j * HD, lseB + (size_t)gi * T * 4, j);
        }
    }
}
__device__ __forceinline__ void p3_combine(Frame& F) {
    const Lane Ls = lane_state();
    const bf16* oB = (const bf16*)(F.ws + WS_OB); const float* lseB = (const float*)(F.ws + WS_LSE); bf16* attB = (bf16*)(F.ws + WS_ATTB);
    for (int t = Ls.gw; t < T; t += F.NGW) {
        const int j = Ls.lane >> 4;
        const float l0 = lseB[(size_t)t * 4 + j], l1 = lseB[(size_t)(T + t) * 4 + j], l2 = lseB[(size_t)(2 * T + t) * 4 + j];
        const float mx = fmaxf(l0, fmaxf(l1, l2)); const float e0 = __expf(l0 - mx), e1 = __expf(l1 - mx), e2 = __expf(l2 - mx); const float inv = 1.f / (e0 + e1 + e2);
        const float w0 = e0 * inv, w1 = e1 * inv, w2 = e2 * inv;
        const v4u a = *(const v4u*)(oB + (size_t)t * BOW + Ls.lane * 8), bq = *(const v4u*)(oB + ((size_t)T + t) * BOW + Ls.lane * 8), c = *(const v4u*)(oB + ((size_t)2 * T + t) * BOW + Ls.lane * 8);
        float cv[8];
#pragma unroll
        for (int k = 0; k < 4; ++k) { cv[2 * k] = (w0 * bflo(a[k]) + w1 * bflo(bq[k]) + w2 * bflo(c[k])) * A_SCALE; cv[2 * k + 1] = (w0 * bfhi(a[k]) + w1 * bfhi(bq[k]) + w2 * bfhi(c[k])) * A_SCALE; }
        v2u o; o.x = pk4_fp8(cv[0], cv[1], cv[2], cv[3]); o.y = pk4_fp8(cv[4], cv[5], cv[6], cv[7]);
        *(v2u*)((unsigned char*)attB + (size_t)t * BOW + Ls.lane * 8) = o;
    }
}

__device__ __forceinline__ float gelu_erf(float v) {
    const float av = fabsf(v), t = __builtin_amdgcn_rcpf(fmaf(av, 0.2316418882f, 1.0f));
    float q = fmaf(t, 0.5307027145f, -0.7265760135f); q = fmaf(q, t, 0.7107068705f); q = fmaf(q, t, -0.142248368f); q = fmaf(q, t, 0.127414796f); q = q * t;
    const float e = __builtin_amdgcn_exp2f(v * v * -0.72134752044f);
    const float m = v * (q * e);
    return v < 0.f ? m : v - m;
}
typedef float f32x2 __attribute__((ext_vector_type(2)));
#define PIN16(A, B) asm volatile("" : "+v"(A[(B) + 0]), "+v"(A[(B) + 1]), "+v"(A[(B) + 2]), "+v"(A[(B) + 3]), "+v"(A[(B) + 4]), "+v"(A[(B) + 5]), "+v"(A[(B) + 6]), "+v"(A[(B) + 7]), \
    "+v"(A[(B) + 8]), "+v"(A[(B) + 9]), "+v"(A[(B) + 10]), "+v"(A[(B) + 11]), "+v"(A[(B) + 12]), "+v"(A[(B) + 13]), "+v"(A[(B) + 14]), "+v"(A[(B) + 15]) :: "memory")
#ifndef P8_DU
#define P8_DU 4
#endif
#ifndef P8_DV
#define P8_DV 8
#endif
constexpr int P8_CH = 8 / P8_NP;
constexpr int P8_ST = 16 * P8_CH;
constexpr int P8_PB = 256 * P8_CH;
template <int D> __device__ __forceinline__ void issue_part(v4u (&buf)[P8_CH], const unsigned char* tab, unsigned e, int gl) {
    const unsigned char* p = tab + (size_t)e * P8_PB + 16 * gl;
#pragma unroll
    for (int jj = 0; jj < P8_CH; ++jj) buf[jj] = *(const v4u*)(p + 256 * jj);
}
template <int D> __device__ __forceinline__ void sweep_u(const unsigned char* tab, const LAS unsigned* entg, LAS float* awg, int gl, int part, const float (&hv)[P8_ST]) {
    static_assert(128 % D == 0 && D % 4 == 0 && D <= 16, "block size");
    v4u buf[D][P8_CH];
    tab += (size_t)part * ((size_t)NEXP * P8_PB);
    { v4u e4[D / 4];
#pragma unroll
      for (int q = 0; q < D / 4; ++q) e4[q] = *(const LAS v4u*)(entg + 4 * q);
#pragma unroll
      for (int j = 0; j < D; ++j) issue_part<D>(buf[j], tab, e4[j >> 2][j & 3], gl); }
#pragma unroll 1
    for (int k0 = 0; k0 < 128; k0 += D) {
        v4u e4[D / 4]; const int kb = (k0 + D < 128) ? k0 + D : 128 - D;
#pragma unroll
        for (int q = 0; q < D / 4; ++q) e4[q] = *(const LAS v4u*)(entg + kb + 4 * q);
#pragma unroll
        for (int q = 0; q < D / 4; ++q) asm volatile("" : "+v"(e4[q]));
        float racc[D];
#pragma unroll
        for (int j = 0; j < D; ++j) {
            float a0 = 0.f, a1 = 0.f;
#pragma unroll
            for (int jj = 0; jj < P8_CH; ++jj)
#pragma unroll
                for (int c = 0; c < 4; ++c) { const f32x2 lo = __builtin_amdgcn_cvt_pk_f32_fp8((int)buf[j][jj][c], false), hi = __builtin_amdgcn_cvt_pk_f32_fp8((int)buf[j][jj][c], true);
                    a0 = fmaf(lo.x, hv[16 * jj + 4 * c + 0], a0); a1 = fmaf(lo.y, hv[16 * jj + 4 * c + 1], a1); a0 = fmaf(hi.x, hv[16 * jj + 4 * c + 2], a0); a1 = fmaf(hi.y, hv[16 * jj + 4 * c + 3], a1); }
            racc[j] = a0 + a1; asm volatile("" : "+v"(racc[j]) :: "memory");
            issue_part<D>(buf[j], tab, e4[j >> 2][j & 3], gl);
        }
#pragma unroll
        for (int st = D / 2; st >= 1; st >>= 1) { const bool up_ = (gl & st) != 0;
#pragma unroll
            for (int i = 0; i < st; ++i) { const float keep = up_ ? racc[i + st] : racc[i], send = up_ ? racc[i] : racc[i + st]; racc[i] = keep + __shfl_xor(send, st); } }
        float r = racc[0];
#pragma unroll
        for (int st = D; st < 16; st <<= 1) r += __shfl_xor(r, st);
        if (gl < D) awg[part * 512 + k0 + gl] = r;
    }
}
template <int D> __device__ __forceinline__ void sweep_v(const unsigned char* tab, const LAS unsigned* entg, const LAS float* awg, int gl, int part, float (&po)[P8_ST]) {
    static_assert(128 % D == 0 && D % 4 == 0 && D <= 16, "block size");
    v4u buf[D][P8_CH];
    tab += (size_t)part * ((size_t)NEXP * P8_PB);
    { v4u e4[D / 4];
#pragma unroll
      for (int q = 0; q < D / 4; ++q) e4[q] = *(const LAS v4u*)(entg + 4 * q);
#pragma unroll
      for (int j = 0; j < D; ++j) issue_part<D>(buf[j], tab, e4[j >> 2][j & 3], gl); }
#pragma unroll 1
    for (int k0 = 0; k0 < 128; k0 += D) {
        v4u e4[D / 4]; f32x4 w4[D / 4]; const int kb = (k0 + D < 128) ? k0 + D : 128 - D;
#pragma unroll
        for (int q = 0; q < D / 4; ++q) { e4[q] = *(const LAS v4u*)(entg + kb + 4 * q); w4[q] = *(const LAS f32x4*)(awg + k0 + 4 * q); }
#pragma unroll
        for (int q = 0; q < D / 4; ++q) asm volatile("" : "+v"(e4[q]), "+v"(w4[q]));
#pragma unroll
        for (int j = 0; j < D; ++j) {
            const float wk = w4[j >> 2][j & 3];
#pragma unroll
            for (int jj = 0; jj < P8_CH; ++jj)
#pragma unroll
                for (int c = 0; c < 4; ++c) { const f32x2 lo = __builtin_amdgcn_cvt_pk_f32_fp8((int)buf[j][jj][c], false), hi = __builtin_amdgcn_cvt_pk_f32_fp8((int)buf[j][jj][c], true);
                    po[16 * jj + 4 * c + 0] = fmaf(wk, lo.x, po[16 * jj + 4 * c + 0]); po[16 * jj + 4 * c + 1] = fmaf(wk, lo.y, po[16 * jj + 4 * c + 1]);
                    po[16 * jj + 4 * c + 2] = fmaf(wk, hi.x, po[16 * jj + 4 * c + 2]); po[16 * jj + 4 * c + 3] = fmaf(wk, hi.y, po[16 * jj + 4 * c + 3]); }
#pragma unroll
            for (int jj = 0; jj < P8_CH; ++jj) PIN16(po, 16 * jj);
            issue_part<D>(buf[j], tab, e4[j >> 2][j & 3], gl);
        }
    }
}
__device__ __forceinline__ void p8_expert(Frame& F) {
    const Lane Ls = lane_state();
    const unsigned char* U8 = F.ws + WS_U; const unsigned char* V8 = F.ws + WS_V; const float* esc = (const float*)(F.ws + WS_ESC);
    const float* part = (const float*)(F.ws + WS_PART); const int* tki = (const int*)(F.ws + WS_TKI); const float* tkg = (const float*)(F.ws + WS_TKG);
    bf16* X1b = (bf16*)(F.ws + WS_X1B);
    LAS unsigned* key = (LAS unsigned*)(F.lds + RING_OFF + Ls.wave * 16384); LAS unsigned* ent = key + 512; LAS float* gsv = (LAS float*)(ent + 512); LAS float* sus = gsv + 512; LAS float* aw = sus + 512;
    const int vw0 = ((int)(blockIdx.x & 7) * (F.G >> 3) + (int)(blockIdx.x >> 3)) * NWAVES + Ls.wave;
    for (int v = (F.G & 7) ? Ls.gw : vw0; v < T / 4; v += F.NGW) {
        unsigned zz = 0u; asm volatile("" : "+s"(zz));
        int lane = (int)__builtin_amdgcn_mbcnt_hi(~0u, __builtin_amdgcn_mbcnt_lo(~0u, zz)); asm volatile("" : "+v"(lane));
        const int sg = lane >> 4, gl = lane & 15, tok = 4 * v + sg;
        LAS unsigned* keyg = key + sg * 128; LAS unsigned* entg = ent + sg * 128; LAS float* gsvg = gsv + sg * 128; LAS float* susg = sus + sg * 128; LAS float* awg = aw + sg * 128;
        { unsigned mk[8]; float mg[8];
#pragma unroll
          for (int q = 0; q < 8; ++q) { const int j = gl + 16 * q; const int e = tki[(size_t)tok * 128 + j]; mg[q] = tkg[(size_t)tok * 128 + j]; mk[q] = ((unsigned)e << 7) | (unsigned)j; keyg[j] = mk[q]; }
          asm volatile("s_waitcnt lgkmcnt(0)" ::: "memory");
          int rk[8];
#pragma unroll
          for (int q = 0; q < 8; ++q) rk[q] = 0;
#pragma unroll 4
          for (int jj = 0; jj < 32; ++jj) { const v4u kk = *(const LAS v4u*)(keyg + 4 * jj);
#pragma unroll
              for (int c = 0; c < 4; ++c)
#pragma unroll
                  for (int q = 0; q < 8; ++q) rk[q] += (kk[c] < mk[q]) ? 1 : 0; }
#pragma unroll
          for (int q = 0; q < 8; ++q) { const int e = (int)(mk[q] >> 7); entg[rk[q]] = (unsigned)e; gsvg[rk[q]] = mg[q] * esc[NEXP + e]; susg[rk[q]] = esc[e]; }
          asm volatile("s_waitcnt lgkmcnt(0)" ::: "memory"); }
        float rstd;
        { float ps = part[(size_t)tok * 32 + gl] + part[(size_t)tok * 32 + 16 + gl];
          ps += __shfl_xor(ps, 1); ps += __shfl_xor(ps, 2); ps += __shfl_xor(ps, 4); ps += __shfl_xor(ps, 8);
          rstd = rsqrtf(ps * (1.f / DM) + EPS); }
#pragma unroll
        for (int pt = 0; pt < P8_NP; ++pt) {
            float hv[P8_ST];
            { int tok2 = tok; asm volatile("" : "+v"(tok2)); const bf16* xr = X1b + (size_t)tok2 * DM + P8_PB * pt + 16 * gl; const float* gp = F.g_ffn + P8_PB * pt + 16 * gl;
#pragma unroll
              for (int jj = 0; jj < P8_CH; ++jj) { const v4u a0 = *(const v4u*)(xr + 256 * jj), a1 = *(const v4u*)(xr + 256 * jj + 8);
#pragma unroll
                  for (int q = 0; q < 4; ++q) { const f32x4 g = *(const f32x4*)(gp + 256 * jj + 4 * q); const unsigned w0 = q < 2 ? a0[2 * q] : a1[2 * q - 4], w1 = q < 2 ? a0[2 * q + 1] : a1[2 * q - 3];
                      hv[16 * jj + 4 * q + 0] = bflo(w0) * rstd * g[0]; hv[16 * jj + 4 * q + 1] = bfhi(w0) * rstd * g[1]; hv[16 * jj + 4 * q + 2] = bflo(w1) * rstd * g[2]; hv[16 * jj + 4 * q + 3] = bfhi(w1) * rstd * g[3]; }
                  PIN16(hv, 16 * jj); } }
            sweep_u<P8_DU>(U8, entg, awg, gl, pt, hv);
            asm volatile("s_waitcnt lgkmcnt(0)" ::: "memory");
        }
#pragma unroll
        for (int q = 0; q < 8; ++q) { const int j = gl + 16 * q; const float x = ((awg[j] + awg[512 + j]) + (awg[1024 + j] + awg[1536 + j])) * susg[j]; awg[j] = gsvg[j] * gelu_erf(x); }
        asm volatile("s_waitcnt lgkmcnt(0)" ::: "memory");
        float s2 = 0.f;
#pragma unroll
        for (int pt = 0; pt < P8_NP; ++pt) {
            float po[P8_ST];
#pragma unroll
            for (int q = 0; q < P8_ST; ++q) po[q] = 0.f;
            sweep_v<P8_DV>(V8, entg, awg, gl, pt, po);
            { int tok2 = tok; asm volatile("" : "+v"(tok2)); bf16* xb = X1b + (size_t)tok2 * DM + P8_PB * pt + 16 * gl;
#pragma unroll
              for (int jj = 0; jj < P8_CH; ++jj) { const v4u a0 = *(const v4u*)(xb + 256 * jj), a1 = *(const v4u*)(xb + 256 * jj + 8); v4u o0, o1;
#pragma unroll
                  for (int q = 0; q < 4; ++q) { const unsigned w0 = q < 2 ? a0[2 * q] : a1[2 * q - 4], w1 = q < 2 ? a0[2 * q + 1] : a1[2 * q - 3]; f32x4 o;
                      o[0] = bflo(w0) + po[16 * jj + 4 * q + 0]; o[1] = bfhi(w0) + po[16 * jj + 4 * q + 1]; o[2] = bflo(w1) + po[16 * jj + 4 * q + 2]; o[3] = bfhi(w1) + po[16 * jj + 4 * q + 3];
#pragma unroll
                      for (int e = 0; e < 4; ++e) s2 = fmaf(o[e], o[e], s2);
                      const unsigned p0 = cvtpk(o[0], o[1]), p1 = cvtpk(o[2], o[3]);
                      if (q < 2) { o0[2 * q] = p0; o0[2 * q + 1] = p1; } else { o1[2 * q - 4] = p0; o1[2 * q - 3] = p1; } }
                  *(v4u*)(xb + 256 * jj) = o0; *(v4u*)(xb + 256 * jj + 8) = o1;
                  asm volatile("" : "+v"(s2) :: "memory"); } }
        }
        { s2 += __shfl_xor(s2, 1); s2 += __shfl_xor(s2, 2); s2 += __shfl_xor(s2, 4); s2 += __shfl_xor(s2, 8);
          const float r2 = rsqrtf(s2 * (1.f / DM) + EPS);
          int tok2 = tok; asm volatile("" : "+v"(tok2)); float* xr = F.out + (size_t)tok2 * DM + 16 * gl; const float* gf = F.g_fin + 16 * gl; const bf16* xb = X1b + (size_t)tok2 * DM + 16 * gl;
#pragma unroll
          for (int jj = 0; jj < 8; ++jj) { const v4u a0 = *(const v4u*)(xb + 256 * jj), a1 = *(const v4u*)(xb + 256 * jj + 8);
#pragma unroll
              for (int q = 0; q < 4; ++q) { const f32x4 g = *(const f32x4*)(gf + 256 * jj + 4 * q); const unsigned w0 = q < 2 ? a0[2 * q] : a1[2 * q - 4], w1 = q < 2 ? a0[2 * q + 1] : a1[2 * q - 3];
                  const f32x4 a = {bflo(w0), bfhi(w0), bflo(w1), bfhi(w1)};
                  *(f32x4*)(xr + 256 * jj + 4 * q) = a * r2 * g; }
              asm volatile("" ::: "memory"); } }
    }
}

constexpr int N_PHASES = 9;
struct Args { const float* in[14]; float* out; unsigned char* ws; int ph_lo, ph_hi; };
__global__ void __launch_bounds__(NWAVES * 64, 2) fwd_kernel(Args args) {
    extern __shared__ __attribute__((aligned(16))) unsigned char lds[];
    Frame F;
    F.lds = (LAS unsigned char*)lds; F.ldsg = (char*)lds;
    F.G = gridDim.x; F.NGW = F.G * NWAVES;
    F.x = args.in[0]; F.rel_bias = args.in[1]; F.g_mix = args.in[2]; F.w_in = args.in[3]; F.sink_a = args.in[4]; F.w_oa = args.in[5]; F.w_ob = args.in[6]; F.w_out = args.in[7];
    F.g_ffn = args.in[8]; F.w_pq = args.in[9]; F.keys = args.in[10]; F.eu = args.in[11]; F.ev = args.in[12]; F.g_fin = args.in[13];
    F.out = args.out; F.ws = args.ws;
    volatile LAS unsigned* MISC = (volatile LAS unsigned*)(F.lds + MISC_OFF);
    for (int u = threadIdx.x; u < (LDS_BYTES - LDSCTL_OFF) / 4; u += NWAVES * 64) ((LAS unsigned*)(F.lds + LDSCTL_OFF))[u] = 0u;
    __syncthreads();
    const int lo = args.ph_lo, hi = args.ph_hi;
    const bool multi = !MK_SPLIT || (hi - lo) > 1;
    XcdBarrier bar; bar.bar = (unsigned*)(F.ws + WS_CTL) + CW_BAR; bar.x = 0; bar.st = nullptr;
    if (multi) bar = xcd_barrier_post((unsigned*)(F.ws + WS_CTL) + CW_BAR, MISC + 8);
#ifndef PH_OFF
#define PH_OFF 0
#endif
#if MK_SPLIT
#define IN(k) (lo <= (k) && (k) < hi && !((PH_OFF >> (k)) & 1))
#else
#define IN(k) (!((PH_OFF >> (k)) & 1))
#endif
#define GRID_BAR() do { XcdBarrier b_ = bar; asm volatile("" : "+s"(b_.bar)); xcd_barrier(b_); } while (0)
#define SEAM(k) do { if (IN(k) && IN((k) + 1)) GRID_BAR(); } while (0)
#ifndef PH_REP
#define PH_REP 0
#endif
#define NREP(k) (IN(k) ? 1 + ((PH_REP >> (k)) & 1) : 0)
#define REPEAT(k) _Pragma("unroll") for (int r_ = 0; r_ < NREP(k); ++r_)
#define REBAR() do { if (r_) GRID_BAR(); } while (0)
    bf16* WinT = (bf16*)(F.ws + WS_WIN); bf16* WoaT = (bf16*)(F.ws + WS_WOA); bf16* WobT = (bf16*)(F.ws + WS_WOB); bf16* WoutT = (bf16*)(F.ws + WS_WOUT); bf16* W2T = (bf16*)(F.ws + WS_W2);
    bf16* proj = (bf16*)(F.ws + WS_PROJ); bf16* Hb = (bf16*)(F.ws + WS_H); bf16* mrg = (bf16*)(F.ws + WS_MRG);
    bf16* attA = (bf16*)(F.ws + WS_ATTA); bf16* attB = (bf16*)(F.ws + WS_ATTB); bf16* x1b = (bf16*)(F.ws + WS_X1B);
    float* part = (float*)(F.ws + WS_PART); float* scores = (float*)(F.ws + WS_SC);

    REPEAT(0) { REBAR(); p0_prologue(F); } SEAM(0);
    REPEAT(1) { REBAR();
        pg8::Gemm g{Hb, WinT, T, INW, DM / 2}; pg8::StaticOrder S; S.init(T, INW, F.G, (int)blockIdx.x);
        pg8::EpiProj E{proj, T, C_GA / 256, 1.f / W_SCALE};
        pg8::gemm_phase<pg8::EpiProj, pg8::StaticOrder, true, true, true>(F.lds + RING_OFF, g, S, E);
    } SEAM(1);
    REPEAT(2) { REBAR(); p2_attention(F); } SEAM(2);
    for (int r34 = 0; r34 < 1 + ((PH_REP >> 3) & 1); ++r34) {
    if (r34) GRID_BAR();
    if (IN(3)) {
        p3_combine(F);
        pg8::Gemm g{attA, WoaT, T, DM, AQW / 2}; pg8::StaticOrder S; S.init(T, DM, F.G, (int)blockIdx.x);
        pg8::EpiGate<false> E{proj + (size_t)(C_GA / 128) * T * 128, T, mrg, DM, 1.f / (A_SCALE * W_SCALE)};
        pg8::gemm_phase<pg8::EpiGate<false>, pg8::StaticOrder, false, true, true>(F.lds + RING_OFF, g, S, E);
    } SEAM(3);
    if (IN(4)) {
        pg8::Gemm g{attB, WobT, T, DM, BOW / 2}; pg8::StaticOrder S; S.init(T, DM, F.G, (int)blockIdx.x);
        pg8::EpiGateF8 E{proj + (size_t)(C_GB / 128) * T * 128, T, mrg, DM, F.ws + WS_MRG8, DM, M_SCALE, 1.f / (A_SCALE * W_SCALE)};
        pg8::gemm_phase<pg8::EpiGateF8, pg8::StaticOrder, false, true, true>(F.lds + RING_OFF, g, S, E);
    }
    }
    SEAM(4);
    REPEAT(5) { REBAR();
        pg8::Gemm g{(const bf16*)(F.ws + WS_MRG8), WoutT, T, DM, DM / 2}; pg8::StaticOrder S; S.init(T, DM, F.G, (int)blockIdx.x);
        pg8::EpiResid E{F.x, x1b, part, DM, 1.f / (M_SCALE * W_SCALE)};
        pg8::gemm_phase<pg8::EpiResid, pg8::StaticOrder, false, true, true>(F.lds + RING_OFF, g, S, E);
    } SEAM(5);
    const bool tab_first = ((blockIdx.x >> 3) & 1) == 0;
    if (IN(6) && tab_first) p6_tables(F);
    REPEAT(6) { REBAR();
        pg8::Gemm g{x1b, W2T, T, DM, DM}; pg8::StaticOrder S; S.init(T, DM, F.G, (int)blockIdx.x);
        LAS float* rs = (LAS float*)(F.lds + RSTD_OFF);
        const Lane Ls = lane_state();
        pg8::Unit u0; if (S.next(0, u0) && Ls.tid < 256) { const f32x4* pp = (const f32x4*)(part + (size_t)(u0.pm * 256 + Ls.tid) * 32); float s = 0.f;
#pragma unroll
            for (int i = 0; i < 8; ++i) { const f32x4 v = pp[i]; s += (v[0] + v[1]) + (v[2] + v[3]); }
            rs[Ls.tid] = rsqrtf(s * (1.f / DM) + EPS); }
        __syncthreads();
        pg8::EpiTopk E{rs, (int*)(F.ws + WS_TKI), (float*)(F.ws + WS_TKG), PHEADS, scores, DM};
        pg8::gemm_phase<pg8::EpiTopk, pg8::StaticOrder, false, true>(F.lds + RING_OFF, g, S, E);
    }
    if (IN(6) && !tab_first) p6_tables(F);
    if (IN(6) && IN(8)) GRID_BAR();
    if (IN(8)) { p8_expert(F); }
#undef IN
#undef SEAM
}

extern "C" void kernel_launch(void* const* d_in, const int* in_sizes, int n_in, void* d_out, int out_size, void* d_ws, size_t ws_size, hipStream_t stream) {
    static int grid = 0;
    if (grid == 0) {
        if (n_in != 14 || in_sizes[0] != T * DM || out_size != T * DM || ws_size < WS_END) {
            fprintf(stderr, "kernel_launch: unexpected shapes: n_in %d in0 %d out %d ws %zu (need >= %zu); nothing launched\n", n_in, n_in > 0 ? in_sizes[0] : -1, out_size, ws_size, (size_t)WS_END); grid = -1; return; }
        int dev = 0, cus = 0, per_cu = 0;
        if (hipGetDevice(&dev) != hipSuccess || hipDeviceGetAttribute(&cus, hipDeviceAttributeMultiprocessorCount, dev) != hipSuccess) { grid = -1; return; }
        if (hipFuncSetAttribute((const void*)fwd_kernel, hipFuncAttributeMaxDynamicSharedMemorySize, LDS_BYTES) != hipSuccess) { fprintf(stderr, "kernel_launch: hipFuncSetAttribute failed\n"); grid = -1; return; }
        if (hipOccupancyMaxActiveBlocksPerMultiprocessor(&per_cu, (const void*)fwd_kernel, NWAVES * 64, LDS_BYTES) != hipSuccess || per_cu < 1)
            fprintf(stderr, "kernel_launch: note: occupancy query reports %d workgroups per CU\n", per_cu);
        (void)hipGetLastError();
        grid = cus;
        if (grid != 256) fprintf(stderr, "kernel_launch: note: %d CUs (built for 256)\n", grid);
    }
    if (grid < 0) return;
    (void)hipMemsetAsync((char*)d_ws + WS_CTL, 0, CTL_ZERO_BYTES, stream);
    Args a{};
    for (int i = 0; i < 14; ++i) a.in[i] = (const float*)d_in[i];
    a.out = (float*)d_out; a.ws = (unsigned char*)d_ws;
#if MK_SPLIT
    for (int p = 0; p < N_PHASES; ++p) { a.ph_lo = p; a.ph_hi = p + 1; hipLaunchKernelGGL(fwd_kernel, dim3(grid), dim3(NWAVES * 64), LDS_BYTES, stream, a); }
#else
    a.ph_lo = 0; a.ph_hi = N_PHASES; hipLaunchKernelGGL(fwd_kernel, dim3(grid), dim3(NWAVES * 64), LDS_BYTES, stream, a);
#endif
    const hipError_t le = hipPeekAtLastError();
    if (le != hipSuccess) fprintf(stderr, "kernel_launch: launch failed: %s\n", hipGetErrorName(le));
}
```

```cpp
#include <hip/hip_runtime.h>
#include <cstdio>
#include <cstdint>
namespace pg8 {
#define PG8_LAS __attribute__((address_space(3)))
typedef unsigned short bf16_t;
typedef short bf16x8 __attribute__((ext_vector_type(8)));
typedef float f32x4 __attribute__((ext_vector_type(4)));
typedef unsigned u32x4 __attribute__((ext_vector_type(4)));
typedef int v4i_t __attribute__((ext_vector_type(4)));
typedef int v8i_t __attribute__((ext_vector_type(8)));
constexpr int BM = 256, BK = 64, HALF = 128, HTB = HALF * BK * 2  , STAGE_BYTES = 8 * HTB, NXCD = 8, WGM = 8;

__host__ __device__ __forceinline__ int lds_byte(int r, int c) { const int st = (r >> 4) * 2 + (c >> 5), rr = r & 15, cc = c & 31, ob = rr * 64 + cc * 2; return st * 1024 + (ob ^ (((ob >> 9) & 1) << 5)); }
__host__ __device__ __forceinline__ void stage_rc(int b, int& R, int& C) { const int st = b / 1024, sb = b % 1024, swz = sb ^ (((sb >> 9) & 1) << 5); R = (st >> 1) * 16 + swz / 64; C = (st & 1) * 32 + (swz % 64) / 2; }
__host__ __device__ __forceinline__ int perm32(int rho) { const int n = rho >> 4, i = rho & 15; return 8 * (i >> 2) + 4 * n + (i & 3); }

struct Unit { int pm, pn; };
struct Gemm { const bf16_t* A; const bf16_t* Bt; int M, N, K; };

struct StaticOrder {
    int nM, nN, nwg, G, c;
    __host__ __device__ void init(int M, int N, int G_, int c_) { nM = M / BM; nN = N / BM; nwg = nM * nN; G = G_; c = c_; }
    __host__ __device__ bool next(int i, Unit& u) const {
        const long L = (long)i * G + c; if (L >= nwg) return false;
        int wgid = (int)L; { const int q = nwg / NXCD, r = nwg % NXCD, xcd = wgid % NXCD, off = wgid / NXCD; wgid = (xcd < r ? xcd * (q + 1) : r * (q + 1) + (xcd - r) * q) + off; }
        const int nig = WGM * nN, gid = wgid / nig, fm = gid * WGM, gsz = (nM - fm) < WGM ? (nM - fm) : WGM;
        u.pm = fm + ((wgid % nig) % gsz); u.pn = (wgid % nig) / gsz; return true;
    }
    __device__ __forceinline__ void a_ready(const Unit&) const {}
    __device__ __forceinline__ void done(const Unit&) const {}
};

typedef unsigned u32x2 __attribute__((ext_vector_type(2)));
__device__ __forceinline__ unsigned cvt_pk_bf16(float lo, float hi) { unsigned r; asm volatile("v_cvt_pk_bf16_f32 %0, %1, %2" : "=v"(r) : "v"(lo), "v"(hi)); return r; }
__device__ __forceinline__ float sigm(float v) { return __builtin_amdgcn_rcpf(1.0f + __builtin_amdgcn_exp2f(-1.4426950408889634f * v)); }
__device__ __forceinline__ float bflo(unsigned w) { return __builtin_bit_cast(float, w << 16); }
__device__ __forceinline__ float bfhi(unsigned w) { return __builtin_bit_cast(float, w & 0xffff0000u); }

struct EpiProj {
    static constexpr bool PERM = true, AFTER_DRAIN = false;
    bf16_t* O; int ldc; int gate_pn; float osc;
    __device__ __forceinline__ void operator()(const f32x4 (&acc)[2][2][4][2], const Unit& u, int wr, int wc, int fr_, int fq_) const {
        (void)fr_; (void)fq_; int ln_ = (int)__builtin_amdgcn_mbcnt_hi(~0u, __builtin_amdgcn_mbcnt_lo(~0u, 0u)); asm volatile("" : "+v"(ln_));
        const int fr = ln_ & 15, fq = ln_ >> 4;
        const int row0 = u.pm * BM + wr * 64 + fr, col0 = u.pn * BM + wc * 32 + 8 * fq; const bool gate = u.pn >= gate_pn;
#pragma unroll
        for (int ai = 0; ai < 2; ++ai)
#pragma unroll
            for (int m = 0; m < 4; ++m) { bf16_t* rowp = O + ((size_t)(2 * u.pn) * ldc + (row0 + ai * HALF + m * 16)) * 128 + wc * 32 + 8 * fq;
#pragma unroll
                for (int bj = 0; bj < 2; ++bj) { f32x4 v0 = acc[ai][bj][m][0] * osc, v1 = acc[ai][bj][m][1] * osc;
                    if (gate) {
#pragma unroll
                        for (int j = 0; j < 4; ++j) { v0[j] = sigm(v0[j]); v1[j] = sigm(v1[j]); } }
                    u32x4 w; w.x = cvt_pk_bf16(v0[0], v0[1]); w.y = cvt_pk_bf16(v0[2], v0[3]); w.z = cvt_pk_bf16(v1[0], v1[1]); w.w = cvt_pk_bf16(v1[2], v1[3]);
                    *(u32x4*)(rowp + (size_t)bj * ldc * 128) = w; } }
    }
};
template <bool ACCUM> struct EpiGate {
    static constexpr bool PERM = true, AFTER_DRAIN = false;
    const bf16_t* G; int ldg; bf16_t* O; int ldc; float osc;
    __device__ __forceinline__ void operator()(const f32x4 (&acc)[2][2][4][2], const Unit& u, int wr, int wc, int fr_, int fq_) const {
        (void)fr_; (void)fq_; int ln_ = (int)__builtin_amdgcn_mbcnt_hi(~0u, __builtin_amdgcn_mbcnt_lo(~0u, 0u)); asm volatile("" : "+v"(ln_));
        const int fr = ln_ & 15, fq = ln_ >> 4;
        const int row0 = u.pm * BM + wr * 64 + fr, col0 = u.pn * BM + wc * 32 + 8 * fq;
#pragma unroll
        for (int ai = 0; ai < 2; ++ai)
#pragma unroll
            for (int m = 0; m < 4; ++m) { const int row = row0 + ai * HALF + m * 16; const bf16_t* gp = G + ((size_t)(2 * u.pn) * ldg + row) * 128 + wc * 32 + 8 * fq; bf16_t* op = O + (size_t)row * ldc + col0;
#pragma unroll
                for (int bj = 0; bj < 2; ++bj) { const u32x4 gw = *(const u32x4*)(gp + (size_t)bj * ldg * 128);
                    f32x4 v0 = acc[ai][bj][m][0] * osc, v1 = acc[ai][bj][m][1] * osc;
                    v0[0] *= bflo(gw.x); v0[1] *= bfhi(gw.x); v0[2] *= bflo(gw.y); v0[3] *= bfhi(gw.y);
                    v1[0] *= bflo(gw.z); v1[1] *= bfhi(gw.z); v1[2] *= bflo(gw.w); v1[3] *= bfhi(gw.w);
                    if (ACCUM) { const u32x4 mw = *(const u32x4*)(op + bj * HALF);
                        v0[0] += bflo(mw.x); v0[1] += bfhi(mw.x); v0[2] += bflo(mw.y); v0[3] += bfhi(mw.y);
                        v1[0] += bflo(mw.z); v1[1] += bfhi(mw.z); v1[2] += bflo(mw.w); v1[3] += bfhi(mw.w); }
                    u32x4 w; w.x = cvt_pk_bf16(v0[0], v0[1]); w.y = cvt_pk_bf16(v0[2], v0[3]); w.z = cvt_pk_bf16(v1[0], v1[1]); w.w = cvt_pk_bf16(v1[2], v1[3]);
                    *(u32x4*)(op + bj * HALF) = w; } }
    }
};
__device__ __forceinline__ unsigned pk4_fp8e(float a, float b, float c, float d) { int p = __builtin_amdgcn_cvt_pk_fp8_f32(fminf(fmaxf(a, -448.f), 448.f), fminf(fmaxf(b, -448.f), 448.f), 0, false);
    return (unsigned)__builtin_amdgcn_cvt_pk_fp8_f32(fminf(fmaxf(c, -448.f), 448.f), fminf(fmaxf(d, -448.f), 448.f), p, true); }
struct EpiGateF8 {
    static constexpr bool PERM = true, AFTER_DRAIN = false;
    const bf16_t* G; int ldg; const bf16_t* M1; int ldm; unsigned char* O8; int ldc; float oscale; float osc;
    __device__ __forceinline__ void operator()(const f32x4 (&acc)[2][2][4][2], const Unit& u, int wr, int wc, int fr_, int fq_) const {
        (void)fr_; (void)fq_; int ln_ = (int)__builtin_amdgcn_mbcnt_hi(~0u, __builtin_amdgcn_mbcnt_lo(~0u, 0u)); asm volatile("" : "+v"(ln_));
        const int fr = ln_ & 15, fq = ln_ >> 4;
        const int row0 = u.pm * BM + wr * 64 + fr, col0 = u.pn * BM + wc * 32 + 8 * fq;
#pragma unroll
        for (int ai = 0; ai < 2; ++ai)
#pragma unroll
            for (int m = 0; m < 4; ++m) { const int row = row0 + ai * HALF + m * 16; const bf16_t* gp = G + ((size_t)(2 * u.pn) * ldg + row) * 128 + wc * 32 + 8 * fq; const bf16_t* mp = M1 + (size_t)row * ldm + col0; unsigned char* op = O8 + (size_t)row * ldc + col0;
#pragma unroll
                for (int bj = 0; bj < 2; ++bj) { const u32x4 gw = *(const u32x4*)(gp + (size_t)bj * ldg * 128), mw = *(const u32x4*)(mp + bj * HALF);
                    f32x4 v0 = acc[ai][bj][m][0] * osc, v1 = acc[ai][bj][m][1] * osc;
                    v0[0] = (v0[0] * bflo(gw.x) + bflo(mw.x)) * oscale; v0[1] = (v0[1] * bfhi(gw.x) + bfhi(mw.x)) * oscale; v0[2] = (v0[2] * bflo(gw.y) + bflo(mw.y)) * oscale; v0[3] = (v0[3] * bfhi(gw.y) + bfhi(mw.y)) * oscale;
                    v1[0] = (v1[0] * bflo(gw.z) + bflo(mw.z)) * oscale; v1[1] = (v1[1] * bfhi(gw.z) + bfhi(mw.z)) * oscale; v1[2] = (v1[2] * bflo(gw.w) + bflo(mw.w)) * oscale; v1[3] = (v1[3] * bfhi(gw.w) + bfhi(mw.w)) * oscale;
                    u32x2 w; w.x = pk4_fp8e(v0[0], v0[1], v0[2], v0[3]); w.y = pk4_fp8e(v1[0], v1[1], v1[2], v1[3]);
                    *(u32x2*)(op + bj * HALF) = w; } }
    }
};

struct EpiResid {
    static constexpr bool PERM = false, AFTER_DRAIN = false;
    const float* X; bf16_t* X1b; float* part; int ld; float osc;
    __device__ __forceinline__ void operator()(const f32x4 (&acc)[2][2][4][2], const Unit& u, int wr, int wc, int fr_, int fq_) const {
        (void)fr_; (void)fq_; int ln_ = (int)__builtin_amdgcn_mbcnt_hi(~0u, __builtin_amdgcn_mbcnt_lo(~0u, 0u)); asm volatile("" : "+v"(ln_));
        const int fr = ln_ & 15, fq = ln_ >> 4;
        const int row0 = u.pm * BM + wr * 64 + fr, col0 = u.pn * BM + wc * 32 + 4 * fq;
#pragma unroll
        for (int ai = 0; ai < 2; ++ai)
#pragma unroll
            for (int m = 0; m < 4; ++m) { const int row = row0 + ai * HALF + m * 16; float ss = 0.f;
#pragma unroll
                for (int bj = 0; bj < 2; ++bj)
#pragma unroll
                    for (int n = 0; n < 2; ++n) { const size_t off = (size_t)row * ld + col0 + bj * HALF + n * 16;
                        const f32x4 x = *(const f32x4*)(X + off); const f32x4 v = x + acc[ai][bj][m][n] * osc;
                        u32x2 w; w.x = cvt_pk_bf16(v[0], v[1]); w.y = cvt_pk_bf16(v[2], v[3]); *(u32x2*)(X1b + off) = w;
                        ss += (v[0] * v[0] + v[1] * v[1]) + (v[2] * v[2] + v[3] * v[3]); }
                ss += __shfl_xor(ss, 16); ss += __shfl_xor(ss, 32);
                if (fq == 0) part[(size_t)row * 32 + u.pn * 4 + wc] = ss; }
    }
};
__device__ __forceinline__ int tk_enc(float s) { const int b = __builtin_bit_cast(int, s); return b ^ ((b >> 31) & 0x7fffffff); }
__device__ __forceinline__ float tk_dec(int k) { return __builtin_bit_cast(float, k ^ ((k >> 31) & 0x7fffffff)); }
#define TK_INS16(Lst, X) do { int x_ = (X); _Pragma("unroll") for (int i_ = 0; i_ < 16; ++i_) { const int h_ = Lst[i_] > x_ ? Lst[i_] : x_; x_ = Lst[i_] > x_ ? x_ : Lst[i_]; Lst[i_] = h_; } } while (0)
__device__ __forceinline__ void tk_sort16(int (&v)[16]) {
#pragma unroll
    for (int k = 2; k <= 16; k <<= 1)
#pragma unroll
        for (int j = k >> 1; j > 0; j >>= 1)
#pragma unroll
            for (int i = 0; i < 16; ++i) { const int l = i ^ j; if (l > i) { const int a = v[i], b = v[l]; const int hi = a > b ? a : b, lo = a > b ? b : a; const bool desc = (i & k) == 0; v[i] = desc ? hi : lo; v[l] = desc ? lo : hi; } }
}
__device__ __forceinline__ void tk_merge16(int (&a)[16], const int (&b)[16]) {
#pragma unroll
    for (int i = 0; i < 16; ++i) a[i] = a[i] > b[15 - i] ? a[i] : b[15 - i];
#pragma unroll
    for (int j = 8; j > 0; j >>= 1)
#pragma unroll
        for (int i = 0; i < 16; ++i) { const int l = i ^ j; if (l > i) { const int x = a[i], y = a[l]; a[i] = x > y ? x : y; a[l] = x > y ? y : x; } }
}
#define TK_BAR() do { asm volatile("s_waitcnt lgkmcnt(0)" ::: "memory"); __builtin_amdgcn_s_barrier(); asm volatile("" ::: "memory"); } while (0)
struct EpiTopk {
    static constexpr bool PERM = false, AFTER_DRAIN = true;
    const PG8_LAS float* rs; int* tki; float* tkg; int nheads; float* S; int ld;
    __device__ __forceinline__ void fused(f32x4 (&acc)[2][2][4][2], const Unit& u, int wr, int wc, int fr_, int fq_, PG8_LAS unsigned char* lds, int wid, int lane_) const {
        (void)fr_; (void)fq_; (void)lane_; int lane = (int)__builtin_amdgcn_mbcnt_hi(~0u, __builtin_amdgcn_mbcnt_lo(~0u, 0u)); asm volatile("" : "+v"(lane));
        const int fr = lane & 15, fq = lane >> 4;
        PG8_LAS float* img = (PG8_LAS float*)lds;
        PG8_LAS int* lst = (PG8_LAS int*)lds;
        PG8_LAS int* mrg = (PG8_LAS int*)(lds + 32768);
#pragma unroll
        for (int ai = 0; ai < 2; ++ai)
#pragma unroll
            for (int m = 0; m < 4; ++m) { const int row = ai * HALF + wr * 64 + m * 16 + fr; const float s = rs[row]; float* rowp = S + (size_t)(u.pm * BM + row) * ld + u.pn * BM + wc * 32 + 4 * fq;
#pragma unroll
                for (int bj = 0; bj < 2; ++bj)
#pragma unroll
                    for (int n = 0; n < 2; ++n) *(f32x4*)(rowp + bj * HALF + n * 16) = acc[ai][bj][m][n] * s; }
        asm volatile("s_waitcnt vmcnt(0)" ::: "memory");
        TK_BAR();
#ifndef TK_REP
#define TK_REP 0
#endif
#pragma unroll 1
        for (int ai_ = 0; ai_ < 2 * (1 + TK_REP); ++ai_) { const int ai = ai_ & 1;
            asm volatile("" : "+v"(lane) :: "memory");
            const int tid = wid * 64 + lane;
            { const float* src = S + (size_t)(u.pm * BM + ai * HALF) * ld + u.pn * BM;
#pragma unroll 4
              for (int i = 0; i < 16; ++i) { const int idx = tid + 512 * i, row = idx >> 6, q = idx & 63; *(PG8_LAS f32x4*)(img + row * 256 + ((q ^ (row & 63)) << 2)) = *(const f32x4*)(src + (size_t)row * ld + 4 * q); } }
            TK_BAR();
            const int row = tid & 127, c = (tid >> 7) & 1, kh = tid >> 8;
            int Lk[16];
#pragma unroll 1
            for (int g = 0; g < 4; ++g) {
                int Nk[16];
#pragma unroll
                for (int i = 0; i < 4; ++i) { const int q = 32 * c + 16 * kh + 4 * g + i; const f32x4 v = *(const PG8_LAS f32x4*)(img + row * 256 + ((q ^ (row & 63)) << 2));
#pragma unroll
                    for (int e = 0; e < 4; ++e) Nk[4 * i + e] = (tk_enc(v[e]) & ~127) | (127 - (64 * kh + 16 * g + 4 * i + e)); }
                tk_sort16(Nk);
                if (g == 0) {
#pragma unroll
                    for (int i = 0; i < 16; ++i) Lk[i] = Nk[i]; }
                else tk_merge16(Lk, Nk);
            }
            TK_BAR();
            { PG8_LAS int* d = lst + ((row * 2 + c) * 2 + kh) * 16;
#pragma unroll
              for (int i = 0; i < 4; ++i) *(PG8_LAS v4i_t*)(d + 4 * i) = (v4i_t){Lk[4 * i], Lk[4 * i + 1], Lk[4 * i + 2], Lk[4 * i + 3]}; }
            TK_BAR();
            if (kh == 0) {
                const PG8_LAS int* o = lst + ((row * 2 + c) * 2 + 1) * 16; int Ok[16];
#pragma unroll
                for (int i = 0; i < 4; ++i) { const v4i_t w = *(const PG8_LAS v4i_t*)(o + 4 * i); Ok[4 * i] = w[0]; Ok[4 * i + 1] = w[1]; Ok[4 * i + 2] = w[2]; Ok[4 * i + 3] = w[3]; }
                tk_merge16(Lk, Ok);
                PG8_LAS int* d = mrg + (row * 2 + c) * 16;
#pragma unroll
                for (int i = 0; i < 4; ++i) *(PG8_LAS v4i_t*)(d + 4 * i) = (v4i_t){Lk[4 * i], Lk[4 * i + 1], Lk[4 * i + 2], Lk[4 * i + 3]};
            }
            TK_BAR();
            if (tid < 128) {
                const PG8_LAS int* A = mrg + (tid * 2 + 0) * 16; const PG8_LAS int* B = mrg + (tid * 2 + 1) * 16;
                float s0[16], s1[16];
#pragma unroll
                for (int i = 0; i < 4; ++i) { const v4i_t a = *(const PG8_LAS v4i_t*)(A + 4 * i), b = *(const PG8_LAS v4i_t*)(B + 4 * i);
#pragma unroll
                    for (int e = 0; e < 4; ++e) { s0[4 * i + e] = tk_dec(a[e] & ~127); s1[4 * i + e] = tk_dec(b[e] & ~127); } }
                int Mk[16], Ck[16];
                int cnt = 0;
#pragma unroll
                for (int i = 0; i < 16; ++i)
#pragma unroll
                    for (int j = 0; j < 16; ++j) if ((i + 1) * (j + 1) <= 16) {
                        Ck[cnt & 15] = (tk_enc(s0[i] + s1[j]) & ~255) | (i << 4) | j; ++cnt;
                        if ((cnt & 15) == 0 || cnt == 50) {
                            if (cnt == 50) {
#pragma unroll
                                for (int z = 2; z < 16; ++z) Ck[z] = (int)0x80000000; }
                            tk_sort16(Ck);
                            if (cnt == 16) {
#pragma unroll
                                for (int z = 0; z < 16; ++z) Mk[z] = Ck[z]; }
                            else tk_merge16(Mk, Ck);
                        } }
                const float smax = tk_dec(Mk[0] & ~255); float ev[16], den = 0.f;
#pragma unroll
                for (int q = 0; q < 16; ++q) { ev[q] = __expf(tk_dec(Mk[q] & ~255) - smax); den += ev[q]; }
                const float inv = 1.f / den; const size_t ob = ((size_t)(u.pm * BM + ai * HALF + tid) * nheads + u.pn) * 16;
#pragma unroll
                for (int q4 = 0; q4 < 4; ++q4) { v4i_t ei; f32x4 gv;
#pragma unroll
                    for (int e = 0; e < 4; ++e) { const int k = Mk[4 * q4 + e]; ei[e] = (127 - (A[(k >> 4) & 15] & 127)) * 128 + (127 - (B[k & 15] & 127)); gv[e] = ev[4 * q4 + e] * inv; }
                    *(v4i_t*)(tki + ob + 4 * q4) = ei; *(f32x4*)(tkg + ob + 4 * q4) = gv; }
            }
            TK_BAR();
        }
    }
};

template <class Epi, class Sched, bool ALIGN_EPI = false, bool SP2 = false, bool F8 = false>
__device__ __forceinline__ void gemm_phase(PG8_LAS unsigned char* lds, const Gemm g, const Sched& S, const Epi& E) {
    int tid_ = threadIdx.x; asm volatile("" : "+v"(tid_));
    const int tid = tid_, wid = __builtin_amdgcn_readfirstlane(tid >> 6), lane = tid & 63, wr = wid >> 2, wc = wid & 3, fr = lane & 15, fq = lane >> 4;
    const int K = g.K, nt = K / BK;
    unsigned voffA[2], voffB[2];
#pragma unroll
    for (int i = 0; i < 2; ++i) { int R, C; stage_rc(tid * 16 + i * 8192, R, C); const int Rb = Epi::PERM ? ((R & ~31) + perm32(R & 31)) : R;
        voffA[i] = (unsigned)(R * K + C) * 2u; voffB[i] = (unsigned)(Rb * K + C) * 2u; }
    const size_t kstep = (size_t)(BK * 2);
    const size_t hstep = (size_t)HALF * K * 2;
    const size_t tstep = 2 * hstep;
    const unsigned ldsw = (unsigned)__builtin_amdgcn_readfirstlane((int)((unsigned)(__SIZE_TYPE__)lds + (unsigned)wid * 1024u));
    const int aoff = lds_byte(wr * 64 + fr, fq * 8), boff = lds_byte(wc * 32 + fr, fq * 8);
#define PG8_SA(b, h) (((b) * 2 + (h)) * HTB)
#define PG8_SB(b, h) ((4 + (b) * 2 + (h)) * HTB)
#define PG8_STAGE(bufoff, gbase, voff) do { _Pragma("unroll") for (int _i = 0; _i < 2; ++_i) \
        __builtin_amdgcn_global_load_lds((const unsigned*)((const char*)(gbase) + (voff)[_i]), (PG8_LAS unsigned*)(__SIZE_TYPE__)(ldsw + (unsigned)((bufoff) + _i * 8192)), 16, 0, 0); } while (0)
    PG8_LAS unsigned char* ldsA = lds + aoff; PG8_LAS unsigned char* ldsB = lds + 4 * HTB + boff; asm volatile("" : "+v"(ldsA), "+v"(ldsB));
#define PG8_LD8(p) __builtin_shufflevector(*(const PG8_LAS v4i_t*)(p), *(const PG8_LAS v4i_t*)((p) + 1024), 0, 1, 2, 3, 4, 5, 6, 7)
#define PG8_LDA(dst, b, h) do { _Pragma("unroll") for (int m = 0; m < 4; ++m) dst[m] = PG8_LD8(ldsA + ((b) * 2 + (h)) * HTB + m * 2048); } while (0)
#define PG8_LDB(dst, b, h) do { _Pragma("unroll") for (int n = 0; n < 2; ++n) dst[n] = PG8_LD8(ldsB + ((b) * 2 + (h)) * HTB + n * 2048); } while (0)
#define PG8_H(X, k) __builtin_bit_cast(bf16x8, __builtin_shufflevector(X, X, 4 * (k), 4 * (k) + 1, 4 * (k) + 2, 4 * (k) + 3))
#define PG8_MMA(ai, bj, At, Bt) do { __builtin_amdgcn_s_setprio(1); _Pragma("unroll") for (int m = 0; m < 4; ++m) _Pragma("unroll") for (int n = 0; n < 2; ++n) { \
        if constexpr (F8) asm volatile("v_mfma_scale_f32_16x16x128_f8f6f4 %0, %1, %2, %0, %3, %3 op_sel_hi:[0,0,0]" : "+v"(acc[ai][bj][m][n]) : "v"(Bt[n]), "v"(At[m]), "v"(mxs));   \
        else { acc[ai][bj][m][n] = __builtin_amdgcn_mfma_f32_16x16x32_bf16(PG8_H(Bt[n], 0), PG8_H(At[m], 0), acc[ai][bj][m][n], 0, 0, 0); \
               acc[ai][bj][m][n] = __builtin_amdgcn_mfma_f32_16x16x32_bf16(PG8_H(Bt[n], 1), PG8_H(At[m], 1), acc[ai][bj][m][n], 0, 0, 0); } } __builtin_amdgcn_s_setprio(0); } while (0)
#define PG8_WAIT_V(n) asm volatile("s_waitcnt vmcnt(" #n ")" ::: "memory")
#define PG8_WAIT_L(n) asm volatile("s_waitcnt lgkmcnt(" #n ")" ::: "memory")
#define PG8_BAR __builtin_amdgcn_s_barrier()
#define PG8_SCHED __builtin_amdgcn_sched_barrier(0)
    Unit cur, nxt; int ui = 0;
    if (!S.next(0, cur)) return;
    f32x4 acc[2][2][4][2];
#pragma unroll
    for (int a = 0; a < 2; ++a)
#pragma unroll
        for (int b = 0; b < 2; ++b)
#pragma unroll
            for (int m = 0; m < 4; ++m)
#pragma unroll
                for (int n = 0; n < 2; ++n) acc[a][b][m][n] = (f32x4){0.f, 0.f, 0.f, 0.f};
    int mxs = 0x7f7f7f7f; asm volatile("" : "+v"(mxs));
    v8i_t At[4], B0[2], B1[2];
    const char* cA = (const char*)g.A + (size_t)cur.pm * tstep; const char* cB = (const char*)g.Bt + (size_t)cur.pn * tstep;
    S.a_ready(cur);
    if constexpr (SP2) {
        PG8_STAGE(PG8_SB(0, 0), cB, voffB); PG8_STAGE(PG8_SB(0, 1), cB + hstep, voffB); PG8_STAGE(PG8_SA(0, 0), cA, voffA); PG8_STAGE(PG8_SA(0, 1), cA + hstep, voffA);
        if (wr == 1) PG8_BAR;
        PG8_WAIT_V(2); PG8_BAR;
        PG8_STAGE(PG8_SB(1, 0), cB + kstep, voffB); PG8_STAGE(PG8_SA(1, 0), cA + kstep, voffA); PG8_STAGE(PG8_SB(1, 1), cB + hstep + kstep, voffB);
        PG8_WAIT_V(6); PG8_BAR;
    } else {
        PG8_STAGE(PG8_SB(0, 0), cB, voffB); PG8_STAGE(PG8_SA(0, 0), cA, voffA); PG8_STAGE(PG8_SB(0, 1), cB + hstep, voffB); PG8_STAGE(PG8_SA(0, 1), cA + hstep, voffA);
        if (wr == 1) PG8_BAR;
        PG8_WAIT_V(4); PG8_BAR;
        PG8_STAGE(PG8_SB(1, 0), cB + kstep, voffB); PG8_STAGE(PG8_SA(1, 0), cA + kstep, voffA); PG8_STAGE(PG8_SB(1, 1), cB + hstep + kstep, voffB);
        PG8_WAIT_V(6); PG8_BAR;
    }
    for (;;) {
        const bool has_next = S.next(ui + 1, nxt);
        const char* nA = has_next ? (const char*)g.A + (size_t)nxt.pm * tstep : cA; const char* nB = has_next ? (const char*)g.Bt + (size_t)nxt.pn * tstep : cB;
        for (int t = 0; t < nt; t += 2) {
            const bool last = (t == nt - 2);
            const char* a1 = cA + (size_t)(t + 1) * kstep;
            const char* a2 = last ? nA : cA + (size_t)(t + 2) * kstep; const char* b2 = last ? nB : cB + (size_t)(t + 2) * kstep;
            const char* a3 = a2 + kstep; const char* b3 = b2 + kstep;
            if (last && has_next) S.a_ready(nxt);
            if constexpr (SP2) {
            PG8_LDB(B0, 0, 0); PG8_LDB(B1, 0, 1); PG8_SCHED; PG8_LDA(At, 0, 0); PG8_STAGE(PG8_SA(1, 1), a1 + hstep, voffA);
            PG8_WAIT_V(8); PG8_WAIT_L(0); PG8_BAR; PG8_MMA(0, 0, At, B0); PG8_MMA(0, 1, At, B1); PG8_BAR; PG8_SCHED;
            PG8_LDA(At, 0, 1); PG8_STAGE(PG8_SB(0, 0), b2, voffB); PG8_STAGE(PG8_SB(0, 1), b2 + hstep, voffB); PG8_STAGE(PG8_SA(0, 0), a2, voffA);
            PG8_WAIT_V(8); PG8_WAIT_L(0); PG8_BAR; PG8_MMA(1, 0, At, B0); PG8_MMA(1, 1, At, B1); PG8_BAR; PG8_SCHED;
            PG8_LDB(B0, 1, 0); PG8_LDB(B1, 1, 1); PG8_SCHED; PG8_LDA(At, 1, 0); PG8_STAGE(PG8_SA(0, 1), a2 + hstep, voffA);
            PG8_WAIT_V(8); PG8_WAIT_L(0); PG8_BAR; PG8_MMA(0, 0, At, B0); PG8_MMA(0, 1, At, B1); PG8_BAR; PG8_SCHED;
            PG8_LDA(At, 1, 1); PG8_STAGE(PG8_SB(1, 0), b3, voffB); PG8_STAGE(PG8_SB(1, 1), b3 + hstep, voffB); PG8_STAGE(PG8_SA(1, 0), a3, voffA);
            PG8_WAIT_V(8); PG8_WAIT_L(0); PG8_BAR; PG8_MMA(1, 0, At, B0); PG8_MMA(1, 1, At, B1); PG8_BAR; PG8_SCHED;
            } else {
            PG8_LDB(B0, 0, 0); PG8_SCHED; PG8_LDA(At, 0, 0); PG8_STAGE(PG8_SA(1, 1), a1 + hstep, voffA);
            PG8_WAIT_L(8); PG8_BAR; PG8_WAIT_L(0); PG8_MMA(0, 0, At, B0); PG8_BAR; PG8_SCHED;
            PG8_LDB(B1, 0, 1); PG8_STAGE(PG8_SB(0, 0), b2, voffB);
            PG8_BAR; PG8_WAIT_L(0); PG8_MMA(0, 1, At, B1); PG8_BAR;
            PG8_LDA(At, 0, 1); PG8_STAGE(PG8_SA(0, 0), a2, voffA);
            PG8_BAR; PG8_WAIT_L(0); PG8_MMA(1, 0, At, B0); PG8_BAR; PG8_SCHED;
            PG8_STAGE(PG8_SB(0, 1), b2 + hstep, voffB);
            PG8_WAIT_V(6); PG8_BAR; PG8_MMA(1, 1, At, B1); PG8_BAR;
            PG8_LDB(B0, 1, 0); PG8_SCHED; PG8_LDA(At, 1, 0); PG8_STAGE(PG8_SA(0, 1), a2 + hstep, voffA);
            PG8_WAIT_L(8); PG8_BAR; PG8_WAIT_L(0); PG8_MMA(0, 0, At, B0); PG8_BAR; PG8_SCHED;
            PG8_LDB(B1, 1, 1); PG8_STAGE(PG8_SB(1, 0), b3, voffB);
            PG8_BAR; PG8_WAIT_L(0); PG8_MMA(0, 1, At, B1); PG8_BAR;
            PG8_LDA(At, 1, 1); PG8_STAGE(PG8_SA(1, 0), a3, voffA);
            PG8_BAR; PG8_WAIT_L(0); PG8_MMA(1, 0, At, B0); PG8_BAR; PG8_SCHED;
            PG8_STAGE(PG8_SB(1, 1), b3 + hstep, voffB);
            PG8_WAIT_V(6); PG8_BAR; PG8_MMA(1, 1, At, B1); PG8_BAR;
            }
        }
        if constexpr (F8) asm volatile("s_nop 15\n\ts_nop 7" ::: "memory");
        if constexpr (ALIGN_EPI) { if (wr == 0) PG8_BAR; }
        if constexpr (!Epi::AFTER_DRAIN) { E(acc, cur, wr, wc, fr, fq); S.done(cur); }
        if (!has_next) break;
#pragma unroll
        for (int a = 0; a < 2; ++a)
#pragma unroll
            for (int b = 0; b < 2; ++b)
#pragma unroll
                for (int m = 0; m < 4; ++m)
#pragma unroll
                    for (int n = 0; n < 2; ++n) acc[a][b][m][n] = (f32x4){0.f, 0.f, 0.f, 0.f};
        cur = nxt; cA = nA; cB = nB; ++ui;
        if constexpr (ALIGN_EPI) { if (wr == 1) PG8_BAR; }
    }
    PG8_WAIT_V(0);
    if constexpr (!ALIGN_EPI) { if (wr == 0) PG8_BAR; }
    PG8_BAR;
    if constexpr (Epi::AFTER_DRAIN) { E.fused(acc, cur, wr, wc, fr, fq, lds, wid, lane); S.done(cur); }
#undef PG8_SA
#undef PG8_SB
#undef PG8_STAGE
#undef PG8_LDA
#undef PG8_LDB
#undef PG8_MMA
#undef PG8_H
#undef PG8_LD8
#undef PG8_WAIT_V
#undef PG8_WAIT_L
#undef PG8_BAR
#undef PG8_SCHED
}
}
#define GAS __attribute__((address_space(1)))
#define LAS __attribute__((address_space(3)))
#define XB_TMO      128
#define XB_XCNT(j)  (256  + 64 * (j))
#define XB_XSUB(j)  (1280 + 64 * (j))
#define XB_XGEN(j)  (2304 + 64 * (j))
#define XB_TOP      3328
#define XB_TOPGEN   3392
#define XCD_BAR_WORDS 3456
#define XB_SPIN_CAP (1u << 18)

__device__ __forceinline__ unsigned xb_ld(unsigned* p)              { return __hip_atomic_load(p, __ATOMIC_RELAXED, __HIP_MEMORY_SCOPE_AGENT); }
__device__ __forceinline__ unsigned xb_add(unsigned* p, unsigned v) { return __hip_atomic_fetch_add(p, v, __ATOMIC_RELAXED, __HIP_MEMORY_SCOPE_AGENT); }
__device__ __forceinline__ unsigned xb_xcc_id() { return (unsigned)__builtin_amdgcn_s_getreg((3 << 11) | 20) & 0xFu; }
#define XB_SPIN(cond, bar) do { unsigned _sp = 0; while (cond) { __builtin_amdgcn_s_sleep(1); \
    if ((++_sp & 255u) == 0u) { if (xb_ld(&(bar)[XB_TMO])) break; if (_sp > XB_SPIN_CAP) { atomicAdd(&(bar)[XB_TMO], 1u); break; } } } } while (0)

struct XcdBarrier {
    unsigned* bar; unsigned x;
    volatile LAS unsigned* st;
};

__device__ __forceinline__ XcdBarrier xcd_barrier_post(unsigned* bar, volatile LAS unsigned* st) {
    XcdBarrier b; b.bar = bar; b.x = xb_xcc_id(); b.st = st;
    if (threadIdx.x == 0) (void)xb_add(&bar[XB_XCNT(b.x)], 1u);
    return b;
}
__device__ __forceinline__ void xcd_barrier_complete(unsigned* bar, unsigned x, unsigned& nloc, unsigned& nx) {
    const unsigned G = gridDim.x * gridDim.y * gridDim.z;
    unsigned sum, cnt, mine, sp = 0u;
    for (;;) {
        sum = 0u; cnt = 0u; mine = 0u;
#pragma unroll
        for (unsigned j = 0; j < 16; ++j) { const unsigned c = xb_ld(&bar[XB_XCNT(j)]); sum += c; cnt += (c > 0u) ? 1u : 0u; mine = (j == x) ? c : mine; }
        if (sum == G) break;
        __builtin_amdgcn_s_sleep(1);
        if ((++sp & 255u) == 0u) { if (xb_ld(&bar[XB_TMO])) break; if (sp > XB_SPIN_CAP) { atomicAdd(&bar[XB_TMO], 1u); break; } }
    }
    nloc = mine > 0u ? mine : 1u; nx = cnt > 0u ? cnt : 1u;
}

__device__ __forceinline__ void xcd_barrier(const XcdBarrier& b) {
    asm volatile("s_waitcnt vmcnt(0)" ::: "memory");
    __syncthreads();
    if (threadIdx.x == 0) {
        unsigned* bar = b.bar;
        __builtin_amdgcn_s_waitcnt(0);
        unsigned nloc = b.st[0], nx = b.st[1];
        if (nloc == 0u) { xcd_barrier_complete(bar, b.x, nloc, nx); b.st[0] = nloc; b.st[1] = nx; }
        const unsigned old = xb_add(&bar[XB_XSUB(b.x)], 1u);
        const unsigned gen = old / nloc;
        if (old + 1u == (gen + 1u) * nloc) {
            __builtin_amdgcn_fence(__ATOMIC_RELEASE, "agent");
            asm volatile("s_waitcnt vmcnt(0)" ::: "memory");
            const unsigned og = xb_add(&bar[XB_TOP], 1u);
            const unsigned tg = og / nx;
            if (og + 1u == (tg + 1u) * nx) xb_add(&bar[XB_TOPGEN], 1u);
            else XB_SPIN(xb_ld(&bar[XB_TOPGEN]) == tg, bar);
            __builtin_amdgcn_fence(__ATOMIC_ACQUIRE, "agent");
            xb_add(&bar[XB_XGEN(b.x)], 1u);
            asm volatile("s_waitcnt vmcnt(0)" ::: "memory");
        } else {
            XB_SPIN(xb_ld(&bar[XB_XGEN(b.x)]) == gen, bar);
            __builtin_amdgcn_fence(__ATOMIC_ACQUIRE, "agent");
            asm volatile("s_waitcnt vmcnt(0)" ::: "memory");
        }
    }
    __syncthreads();
}

#ifndef MK_SPLIT
#define MK_SPLIT 0
#endif
#ifndef P8_NP
#define P8_NP 2
#endif
constexpr int NWAVES = 8;
constexpr int NB = 2, SEQ = 4096, DM = 2048, T = NB * SEQ, HD = 128;
constexpr int INW = 10240;
constexpr int C_QA = 0, C_KA = 1024, C_VA = 1280, C_QB = 1536, C_KB = 3072, C_VB = 4608, C_GA = 6144, C_GB = 8192;
constexpr int AQW = 1024, BOW = 512;
constexpr int NEXP = 16384, PHEADS = 8, NKEYS = 128, TOPK = 16;
constexpr int NBIAS = 20;
constexpr float EPS = 1e-6f;
constexpr float SM_SCALE = 0.088388347648318440f;
constexpr float LOG2E = 1.4426950408889634f;
constexpr float A_SCALE = 16.f;
constexpr float M_SCALE = 64.f;
constexpr float W_SCALE = 512.f;

constexpr size_t MiB = 1u << 20;
constexpr size_t WS_CTL = 0, CTL_ZERO_BYTES = 16384;
constexpr size_t WS_WIN = 1 * MiB;
constexpr size_t WS_WOA = 41 * MiB;
constexpr size_t WS_WOB = 45 * MiB;
constexpr size_t WS_WOUT = 47 * MiB;
constexpr size_t WS_W2 = 55 * MiB;
constexpr size_t WS_U = 63 * MiB;
constexpr size_t WS_V = 87 * MiB;
constexpr size_t WS_ESC = 127 * MiB;
constexpr size_t WS_PROJ = 191 * MiB;
constexpr size_t WS_SC = WS_PROJ;
constexpr size_t WS_H = 351 * MiB;
constexpr size_t WS_MRG = WS_H;
constexpr size_t WS_ATTA = 383 * MiB;
constexpr size_t WS_OB = 399 * MiB;
constexpr size_t WS_X1B = WS_ATTA;
constexpr size_t WS_ATTB = 423 * MiB;
constexpr size_t WS_LSE = 431 * MiB;
constexpr size_t WS_PART = 432 * MiB;
constexpr size_t WS_TKI = 433 * MiB;
constexpr size_t WS_TKG = 437 * MiB;
constexpr size_t WS_MRG8 = 441 * MiB;
constexpr size_t WS_END = 457 * MiB;
constexpr int CW_BAR = 0;

constexpr int RING_OFF = 0, RING_BYTES = 131072;
constexpr int LDSCTL_OFF = RING_BYTES, MISC_OFF = LDSCTL_OFF + 320;
constexpr int RSTD_OFF = RING_BYTES + 1024;
constexpr int LDS_BYTES = 147456;
static_assert(RSTD_OFF + 1024 <= LDS_BYTES && XCD_BAR_WORDS * 4 <= (int)CTL_ZERO_BYTES, "maps");

typedef unsigned short bf16;
typedef unsigned v4u __attribute__((ext_vector_type(4)));
typedef unsigned v2u __attribute__((ext_vector_type(2)));
typedef float f32x4 __attribute__((ext_vector_type(4)));
typedef float f32x16 __attribute__((ext_vector_type(16)));
typedef short bf16x8 __attribute__((ext_vector_type(8)));
typedef short s16x4 __attribute__((ext_vector_type(4)));
typedef __bf16 bf16x2 __attribute__((ext_vector_type(2)));
#define LDS_WAIT() asm volatile("s_waitcnt lgkmcnt(0)" ::: "memory")
#define VM_WAIT() asm volatile("s_waitcnt vmcnt(0)" ::: "memory")
#define SBAR() __builtin_amdgcn_sched_barrier(0)
__device__ __forceinline__ unsigned cvtpk(float lo, float hi) { unsigned r; asm volatile("v_cvt_pk_bf16_f32 %0, %1, %2" : "=v"(r) : "v"(lo), "v"(hi)); return r; }
__device__ __forceinline__ float bflo(unsigned w) { return __builtin_bit_cast(float, w << 16); }
__device__ __forceinline__ float bfhi(unsigned w) { return __builtin_bit_cast(float, w & 0xffff0000u); }
__device__ __forceinline__ float dot2_bf16(unsigned w, unsigned x, float acc) { return __builtin_amdgcn_fdot2_f32_bf16(__builtin_bit_cast(bf16x2, w), __builtin_bit_cast(bf16x2, x), acc, false); }
__device__ __forceinline__ float wave_sum(float v) {
#pragma unroll
    for (int o = 1; o < 64; o <<= 1) v += __shfl_xor(v, o);
    return v;
}

struct Lane { int tid, lane, wave, gw; };
__device__ __forceinline__ Lane lane_state() { int t = threadIdx.x; asm volatile("" : "+v"(t)); Lane L; L.tid = t; L.lane = t & 63; L.wave = __builtin_amdgcn_readfirstlane(t >> 6); L.gw = blockIdx.x * 8 + L.wave; return L; }
struct Frame {
    LAS unsigned char* lds; char* ldsg;
    int G, NGW;
    const float *x, *rel_bias, *g_mix, *w_in, *sink_a, *w_oa, *w_ob, *w_out, *g_ffn, *w_pq, *keys, *eu, *ev, *g_fin;
    float* out; unsigned char* ws;
};

__device__ __forceinline__ unsigned pk4_fp8(float a, float b, float c, float d) { int p = __builtin_amdgcn_cvt_pk_fp8_f32(fminf(fmaxf(a, -448.f), 448.f), fminf(fmaxf(b, -448.f), 448.f), 0, false);
    return (unsigned)__builtin_amdgcn_cvt_pk_fp8_f32(fminf(fmaxf(c, -448.f), 448.f), fminf(fmaxf(d, -448.f), 448.f), p, true); }
__device__ __forceinline__ void p0_transpose_item_f8(const float* W, int K, int N, unsigned char* WT, float scale, LAS float* scr, int item, int lane) {
    const int nblk = N / 32, kb = item / nblk, nb = item % nblk, k0 = 64 * kb, n0 = 32 * nb;
    { f32x4 v[8];
#pragma unroll
      for (int i = 0; i < 8; ++i) v[i] = *(const f32x4*)(W + (size_t)(k0 + 8 * i + (lane >> 3)) * N + n0 + 4 * (lane & 7));
#pragma unroll
      for (int i = 0; i < 8; ++i) { LAS float* d = scr + (8 * i + (lane >> 3)) * 33 + 4 * (lane & 7); d[0] = v[i][0] * scale; d[1] = v[i][1] * scale; d[2] = v[i][2] * scale; d[3] = v[i][3] * scale; } }
    LDS_WAIT(); asm volatile("" ::: "memory");
    const int c = lane & 7;
#pragma unroll
    for (int j = 0; j < 4; ++j) { const int n = (lane >> 3) + 8 * j; const LAS float* s = scr + (8 * c) * 33 + n;
        v2u o; o.x = pk4_fp8(s[0 * 33], s[1 * 33], s[2 * 33], s[3 * 33]); o.y = pk4_fp8(s[4 * 33], s[5 * 33], s[6 * 33], s[7 * 33]);
        *(v2u*)(WT + (size_t)(n0 + n) * K + k0 + 8 * c) = o; }
    LDS_WAIT(); asm volatile("" ::: "memory");
}
__device__ __forceinline__ void p0_transpose_item(const float* W, int K, int N, bf16* WT, LAS float* scr, int item, int lane) {
    const int nblk = N / 32, kb = item / nblk, nb = item % nblk, k0 = 64 * kb, n0 = 32 * nb;
    { f32x4 v[8];
#pragma unroll
      for (int i = 0; i < 8; ++i) v[i] = *(const f32x4*)(W + (size_t)(k0 + 8 * i + (lane >> 3)) * N + n0 + 4 * (lane & 7));
#pragma unroll
      for (int i = 0; i < 8; ++i) { LAS float* d = scr + (8 * i + (lane >> 3)) * 33 + 4 * (lane & 7); d[0] = v[i][0]; d[1] = v[i][1]; d[2] = v[i][2]; d[3] = v[i][3]; } }
    LDS_WAIT(); asm volatile("" ::: "memory");
    const int c = lane & 7;
#pragma unroll
    for (int j = 0; j < 4; ++j) { const int n = (lane >> 3) + 8 * j; const LAS float* s = scr + (8 * c) * 33 + n;
        v4u o; o.x = cvtpk(s[0 * 33], s[1 * 33]); o.y = cvtpk(s[2 * 33], s[3 * 33]); o.z = cvtpk(s[4 * 33], s[5 * 33]); o.w = cvtpk(s[6 * 33], s[7 * 33]);
        *(v4u*)(WT + (size_t)(n0 + n) * K + k0 + 8 * c) = o; }
    LDS_WAIT(); asm volatile("" ::: "memory");
}
__device__ __forceinline__ void p0_w2_item(Frame& F, bf16* W2T, int item, int tid) {
    const int hc = item >> 5, j0 = (item & 31) * 64;
    LAS float* Ks = (LAS float*)F.lds; LAS float* Ws = Ks + 128 * 129;
    const f32x4* kp = (const f32x4*)(F.keys + (size_t)hc * 16384);
#pragma unroll
    for (int q = 0; q < 8; ++q) { const int idx = tid + 512 * q, row = idx >> 5, c4 = idx & 31; const f32x4 v = kp[idx];
        LAS float* d = Ks + row * 129 + c4 * 4; d[0] = v[0]; d[1] = v[1]; d[2] = v[2]; d[3] = v[3]; }
#pragma unroll
    for (int q = 0; q < 4; ++q) { const int idx = tid + 512 * q, row = idx >> 5, c4 = idx & 31; const f32x4 v = *(const f32x4*)(F.w_pq + (size_t)(j0 + row) * DM + hc * 128 + c4 * 4);
        LAS float* d = Ws + row * 129 + c4 * 4; d[0] = v[0]; d[1] = v[1]; d[2] = v[2]; d[3] = v[3]; }
    __syncthreads();
    { const int wv = tid >> 6, ln = tid & 63, kt = wv & 3, jt = wv >> 2, r = ln & 31, h2 = ln >> 5;
      const LAS float* ap = Ks + (kt * 32 + r) * 129 + h2; const LAS float* bp = Ws + (jt * 32 + r) * 129 + h2;
      f32x16 acc = {};
#pragma unroll 8
      for (int d0 = 0; d0 < 128; d0 += 2) acc = __builtin_amdgcn_mfma_f32_32x32x2f32(ap[d0], bp[d0], acc, 0, 0, 0);
      const int j = j0 + jt * 32 + r; const float g = F.g_ffn[j];
#pragma unroll
      for (int q = 0; q < 16; ++q) { const int k = kt * 32 + (q & 3) + 8 * (q >> 2) + 4 * h2; const float v = acc[q] * g;
          W2T[(size_t)(hc * 128 + k) * DM + j] = (bf16)(cvtpk(v, v) & 0xffffu); } }
    __syncthreads();
}
typedef float v16f __attribute__((ext_vector_type(16)));
typedef float v32f __attribute__((ext_vector_type(32)));
typedef unsigned v6u __attribute__((ext_vector_type(6)));
__device__ __forceinline__ void tab_issue(const Frame& F, int row, int lane, f32x4 (&v)[8]) {
    const float* src = (row < NEXP ? F.eu + (size_t)row * DM : F.ev + (size_t)(row - NEXP) * DM) + 4 * lane;
#pragma unroll
    for (int j = 0; j < 8; ++j) v[j] = *(const f32x4*)(src + 256 * j);
}
__device__ __forceinline__ void tab_finish(const Frame& F, int row, int lane, const f32x4 (&v)[8]) {
    static_assert(P8_NP == 2 && WS_V == WS_U + (size_t)NEXP * 1536, "table layout");
    float am = 0.f;
#pragma unroll
    for (int j = 0; j < 8; ++j) am = fmaxf(am, fmaxf(fmaxf(fabsf(v[j][0]), fabsf(v[j][1])), fmaxf(fabsf(v[j][2]), fabsf(v[j][3]))));
#pragma unroll
    for (int o = 1; o < 64; o <<= 1) am = fmaxf(am, __shfl_xor(am, o));
    const float inv = am > 0.f ? 7.5f / am : 0.f;
    v16f x, y;
#pragma unroll
    for (int j = 0; j < 8; ++j) { x[2 * j] = v[j][0] * inv; y[2 * j] = v[j][1] * inv; x[2 * j + 1] = v[j][2] * inv; y[2 * j + 1] = v[j][3] * inv; }
    const v6u pk = __builtin_amdgcn_cvt_scalef32_2xpk16_fp6_f32(x, y, 1.0f);
    const int p = lane >> 5, gl = (lane >> 1) & 15, g = lane & 1;
    unsigned char* dst = F.ws + WS_U + (size_t)(row >= NEXP) * ((size_t)NEXP * 1536) + (size_t)p * ((size_t)NEXP * 768) + (size_t)(row & (NEXP - 1)) * 768 + 16 * gl;
    const v4u a16 = g ? (v4u){pk[2], pk[3], pk[4], pk[5]} : (v4u){pk[0], pk[1], pk[2], pk[3]};
    const v2u b8 = g ? (v2u){pk[0], pk[1]} : (v2u){pk[4], pk[5]};
    *(v4u*)(dst + (g ? 512 : 0)) = a16; *(v2u*)(dst + 256 + 8 * g) = b8;
    if (lane == 0) ((float*)(F.ws + WS_ESC))[row] = am * (1.f / 7.5f);
}
__device__ __forceinline__ void p6_tables(Frame& F) {
    const Lane Ls = lane_state();
    for (int row = Ls.gw; row < 2 * NEXP; row += 2 * F.NGW) { f32x4 v0[8], v1[8]; const int row1 = row + F.NGW;
        tab_issue(F, row, Ls.lane, v0); if (row1 < 2 * NEXP) tab_issue(F, row1, Ls.lane, v1);
        tab_finish(F, row, Ls.lane, v0); if (row1 < 2 * NEXP) tab_finish(F, row1, Ls.lane, v1); }
}
__device__ __forceinline__ void p0_prologue(Frame& F) {
    const Lane Ls = lane_state();
    LAS float* scr = (LAS float*)(F.lds + RING_OFF + Ls.wave * 16384);
    bf16* WinT = (bf16*)(F.ws + WS_WIN); bf16* WoaT = (bf16*)(F.ws + WS_WOA); bf16* WobT = (bf16*)(F.ws + WS_WOB); bf16* WoutT = (bf16*)(F.ws + WS_WOUT);
    constexpr int I_IN = (DM / 64) * (INW / 32), I_OA = (AQW / 64) * (DM / 32), I_OB = (BOW / 64) * (DM / 32), I_OUT = (DM / 64) * (DM / 32);
    constexpr int NITEMS = I_IN + I_OA + I_OB + I_OUT;
    for (int it = Ls.gw; it < NITEMS; it += F.NGW) {
        int r = it;
        if (r < I_IN) { p0_transpose_item_f8(F.w_in, DM, INW, (unsigned char*)WinT, W_SCALE, scr, r, Ls.lane); continue; } r -= I_IN;
        if (r < I_OA) { p0_transpose_item_f8(F.w_oa, AQW, DM, (unsigned char*)WoaT, W_SCALE, scr, r, Ls.lane); continue; } r -= I_OA;
        if (r < I_OB) { p0_transpose_item_f8(F.w_ob, BOW, DM, (unsigned char*)WobT, W_SCALE, scr, r, Ls.lane); continue; } r -= I_OB;
        p0_transpose_item_f8(F.w_out, DM, DM, (unsigned char*)WoutT, W_SCALE, scr, r, Ls.lane);
    }
    __syncthreads();
    for (int it = blockIdx.x; it < 512; it += F.G) p0_w2_item(F, (bf16*)(F.ws + WS_W2), it, Ls.tid);
    { bf16* Hb = (bf16*)(F.ws + WS_H);
      for (int m = Ls.gw; m < T; m += F.NGW) {
          const f32x4* xr = (const f32x4*)(F.x + (size_t)m * DM) + Ls.lane; f32x4 v[8]; float s = 0.f;
#pragma unroll
          for (int j = 0; j < 8; ++j) { v[j] = xr[64 * j]; s += (v[j][0] * v[j][0] + v[j][1] * v[j][1]) + (v[j][2] * v[j][2] + v[j][3] * v[j][3]); }
          const float rstd = rsqrtf(wave_sum(s) * (1.f / DM) + EPS);
          unsigned* o4 = (unsigned*)((unsigned char*)Hb + (size_t)m * DM) + Ls.lane;
#pragma unroll
          for (int j = 0; j < 8; ++j) { const f32x4 g = ((const f32x4*)F.g_mix)[Ls.lane + 64 * j];
              o4[64 * j] = pk4_fp8(v[j][0] * rstd * g[0], v[j][1] * rstd * g[1], v[j][2] * rstd * g[2], v[j][3] * rstd * g[3]); } } }
}

namespace att {
#define KSWZ(row, colB) ((row) * 256 + ((colB) ^ (((row) & 7) << 4)))
__device__ __forceinline__ int crow(int r, int hi) { return (r & 3) + 8 * (r >> 2) + 4 * hi; }
__device__ __forceinline__ void qkt(f32x16& p0, f32x16& p1, const char* Ks, const bf16x8* qr, int r32, int hi) {
    p0 = f32x16{}; p1 = f32x16{};
#pragma unroll
    for (int d0 = 0; d0 < 8; ++d0) { const int cb = (d0 * 16 + hi * 8) * 2;
        const bf16x8 b0 = *reinterpret_cast<const bf16x8*>(Ks + KSWZ(r32, cb));
        const bf16x8 b1 = *reinterpret_cast<const bf16x8*>(Ks + KSWZ(32 + r32, cb));
        p0 = __builtin_amdgcn_mfma_f32_32x32x16_bf16(b0, qr[d0], p0, 0, 0, 0);
        p1 = __builtin_amdgcn_mfma_f32_32x32x16_bf16(b1, qr[d0], p1, 0, 0, 0); }
}
__device__ __forceinline__ int v_st(int k, int c) { const int kk = (k & ~0xC) | ((k & 4) << 1) | ((k & 8) >> 1); return ((kk >> 3) * 4 + (c >> 5)) * 512 + ((kk & 7) * 32 + (c & 31)) * 2; }
__device__ __forceinline__ int v_rd_base(int lane) { return ((lane & 3) << 3) | (((lane >> 2) & 3) << 6) | (((lane >> 4) & 1) << 5) | (((lane >> 5) & 1) << 8); }
constexpr int v_rd_off(int d0, int ks, int half) { return d0 * 512 + ks * 4096 + half * 2048; }
template <int OFF> __device__ __forceinline__ s16x4 tr_read(int vb) {
    s16x4 r; asm volatile("ds_read_b64_tr_b16 %0, %1 offset:%2" : "=&v"(r) : "v"(vb), "i"(OFF) : "memory"); return r;
}
template <int D0> __device__ __forceinline__ void pv_one(f32x16& od, int vb, bf16x8 pa0, bf16x8 pa1, bf16x8 pa2, bf16x8 pa3) {
    const s16x4 l0 = tr_read<v_rd_off(D0, 0, 0)>(vb), h0 = tr_read<v_rd_off(D0, 0, 1)>(vb), l1 = tr_read<v_rd_off(D0, 1, 0)>(vb), h1 = tr_read<v_rd_off(D0, 1, 1)>(vb);
    const s16x4 l2 = tr_read<v_rd_off(D0, 2, 0)>(vb), h2 = tr_read<v_rd_off(D0, 2, 1)>(vb), l3 = tr_read<v_rd_off(D0, 3, 0)>(vb), h3 = tr_read<v_rd_off(D0, 3, 1)>(vb);
    asm volatile("s_waitcnt lgkmcnt(0)" ::: "memory"); SBAR();
#define PK(L, H) (bf16x8){L[0], L[1], L[2], L[3], H[0], H[1], H[2], H[3]}
    od = __builtin_amdgcn_mfma_f32_32x32x16_bf16(pa0, PK(l0, h0), od, 0, 0, 0);
    od = __builtin_amdgcn_mfma_f32_32x32x16_bf16(pa1, PK(l1, h1), od, 0, 0, 0);
    od = __builtin_amdgcn_mfma_f32_32x32x16_bf16(pa2, PK(l2, h2), od, 0, 0, 0);
    od = __builtin_amdgcn_mfma_f32_32x32x16_bf16(pa3, PK(l3, h3), od, 0, 0, 0);
#undef PK
}
__device__ __forceinline__ void pv_d0(f32x16* o, int vb, bf16x8 pa0, bf16x8 pa1, bf16x8 pa2, bf16x8 pa3) {
    pv_one<0>(o[0], vb, pa0, pa1, pa2, pa3); pv_one<1>(o[1], vb, pa0, pa1, pa2, pa3); pv_one<2>(o[2], vb, pa0, pa1, pa2, pa3); pv_one<3>(o[3], vb, pa0, pa1, pa2, pa3);
}
__device__ __forceinline__ int t5_bucket(int rel) {
    const int n = rel < 0 ? -rel : rel; int b;
    if (n < 8) b = n; else { b = 8 + (n >= 15) + (n >= 27) + (n >= 50) + (n >= 91) + (n >= 166) + (n >= 305) + (n >= 559); b = b > 15 ? 15 : b; }
    return b + (rel > 0 ? 16 : 0);
}
constexpr int ATT_WS_OFF = RSTD_OFF + 1024, ATT_BT_OFF = ATT_WS_OFF + 2048;
static_assert(ATT_BT_OFF + 2 * 1040 <= LDS_BYTES, "attention scratch above the stage region");
template <int W, bool SINK>
__device__ __forceinline__ void attn_unit(char* lds, const bf16* proj, int b, int qcol, int kcol, int vcol, int d, int r, int m0u,
                                          const float* bias_col, float sinkv, bf16* O, int ldo, int ocol, float* lse, int lse_j) {
    int tid_ = threadIdx.x; asm volatile("" : "+v"(tid_));
    const int tid = tid_, wid = __builtin_amdgcn_readfirstlane(tid >> 6), lane = tid & 63, r32 = lane & 31, hi = lane >> 5;
    const int hh = wid >> 2, wq = wid & 3, htid = tid & 255;
    constexpr int NT = (128 + 2 * W) / 64;
    const int L = SEQ / d, m0 = m0u + 128 * hh;
    char* hbase = lds + hh * 65536;
    float* ws = (float*)(lds + ATT_WS_OFF) + wid * 64; float* li_l = ws; float* al_l = ws + 32;
    float* btab = (float*)(lds + ATT_BT_OFF + hh * 1040);
    __syncthreads();
    for (int i = htid; i <= 2 * W; i += 256) btab[i] = bias_col[t5_bucket((i - W) * d) * NBIAS];
    const int qm = m0 + wq * 32 + r32;
    const size_t tok0 = (size_t)b * SEQ + r;
    bf16x8 qr[8];
    { const bf16* Qw = proj + ((size_t)(qcol >> 7) * T + tok0 + (size_t)qm * d) * 128 + hi * 8;
#pragma unroll
      for (int d0 = 0; d0 < 8; ++d0) qr[d0] = *reinterpret_cast<const bf16x8*>(Qw + d0 * 16); }
    float m_run = SINK ? sinkv : -1e29f, l_run = SINK ? 1.f : 0.f;
    f32x16 o[4] = {};
    const int sr = htid >> 4, sc = (htid & 15) * 8;
    const int t_lo = wq >> 1, t_hi = (32 * wq + 31 + 2 * W) >> 6;
    bf16x8 vs[4], ks[4];
#define SLOAD(t) do { const int tm = m0 - W + 64 * (t); if (tm + 63 >= 0 && tm < L) { _Pragma("unroll") for (int i_ = 0; i_ < 4; ++i_) { int k_ = tm + sr + 16 * i_; k_ = k_ < 0 ? 0 : (k_ > L - 1 ? L - 1 : k_); \
        const size_t tk_ = tok0 + (size_t)k_ * d; vs[i_] = *reinterpret_cast<const bf16x8*>(proj + ((size_t)(vcol >> 7) * T + tk_) * 128 + sc); ks[i_] = *reinterpret_cast<const bf16x8*>(proj + ((size_t)(kcol >> 7) * T + tk_) * 128 + sc); } } } while (0)
#define SWRITE(t) do { const int tm = m0 - W + 64 * (t); if (tm + 63 >= 0 && tm < L) { char* vb_ = hbase + ((t) & 1) * 32768; char* kb_ = vb_ + 16384; _Pragma("unroll") for (int i_ = 0; i_ < 4; ++i_) { \
        *(bf16x8*)(vb_ + v_st(sr + 16 * i_, sc)) = vs[i_]; *(bf16x8*)(kb_ + KSWZ(sr + 16 * i_, sc * 2)) = ks[i_]; } } } while (0)
    SLOAD(0);
#pragma unroll 1
    for (int t = 0; t < NT; ++t) {
        SWRITE(t);
        __syncthreads();
        if (t + 1 < NT) SLOAD(t + 1);
        const int tm0 = m0 - W + 64 * t;
        if (t >= t_lo && t <= t_hi && tm0 + 63 >= 0 && tm0 < L) {
            const char* V_lds = hbase + (t & 1) * 32768; const char* K_lds = V_lds + 16384;
            const int vb0 = (int)(uintptr_t)V_lds + v_rd_base(lane);
            f32x16 p0, p1; qkt(p0, p1, K_lds, qr, r32, hi);
            const int base = tm0 - qm + W;
            float pmax = -1e30f;
#pragma unroll
            for (int q = 0; q < 16; ++q) { const int key = crow(q, hi), idx = base + key, km = tm0 + key;
                const bool ok = (unsigned)idx <= (unsigned)(2 * W) && (unsigned)km < (unsigned)L;
                const float bv = btab[ok ? idx : 0]; const float s = ok ? fmaf(p0[q], SM_SCALE, bv) : -1e30f; p0[q] = s; pmax = fmaxf(pmax, s); }
#pragma unroll
            for (int q = 0; q < 16; ++q) { const int key = 32 + crow(q, hi), idx = base + key, km = tm0 + key;
                const bool ok = (unsigned)idx <= (unsigned)(2 * W) && (unsigned)km < (unsigned)L;
                const float bv = btab[ok ? idx : 0]; const float s = ok ? fmaf(p1[q], SM_SCALE, bv) : -1e30f; p1[q] = s; pmax = fmaxf(pmax, s); }
            { auto rr = __builtin_amdgcn_permlane32_swap(__float_as_uint(pmax), __float_as_uint(pmax), false, false);
              pmax = fmaxf(__uint_as_float(rr[0]), __uint_as_float(rr[1])); }
            const float mn = fmaxf(m_run, pmax), alpha = __builtin_amdgcn_exp2f((m_run - mn) * LOG2E); m_run = mn;
            const float mnc = -mn * LOG2E; float ps = 0.f;
#pragma unroll
            for (int q = 0; q < 16; ++q) { p0[q] = __builtin_amdgcn_exp2f(fmaf(p0[q], LOG2E, mnc)); ps += p0[q]; }
#pragma unroll
            for (int q = 0; q < 16; ++q) { p1[q] = __builtin_amdgcn_exp2f(fmaf(p1[q], LOG2E, mnc)); ps += p1[q]; }
            { auto rr = __builtin_amdgcn_permlane32_swap(__float_as_uint(ps), __float_as_uint(ps), false, false);
              ps = __uint_as_float(rr[0]) + __uint_as_float(rr[1]); }
            l_run = l_run * alpha + ps;
            if (__any(alpha < 1.f)) { if (hi == 0) al_l[r32] = alpha; asm volatile("s_waitcnt lgkmcnt(0)" ::: "memory");
#pragma unroll
                for (int dd = 0; dd < 4; ++dd)
#pragma unroll
                    for (int q = 0; q < 16; ++q) o[dd][q] *= al_l[crow(q, hi)]; }
            bf16x8 pa0, pa1, pa2, pa3;
#define PK4(P, BASE, OUT) do { unsigned a0 = cvtpk(P[BASE + 0], P[BASE + 1]), a1 = cvtpk(P[BASE + 2], P[BASE + 3]);   \
    unsigned b0 = cvtpk(P[BASE + 4], P[BASE + 5]), b1 = cvtpk(P[BASE + 6], P[BASE + 7]);                              \
    auto r0 = __builtin_amdgcn_permlane32_swap(a0, b0, false, false); auto r1 = __builtin_amdgcn_permlane32_swap(a1, b1, false, false); \
    v4u w = {r0[0], r1[0], r0[1], r1[1]}; OUT = *reinterpret_cast<bf16x8*>(&w); } while (0)
            PK4(p0, 0, pa0); PK4(p0, 8, pa1); PK4(p1, 0, pa2); PK4(p1, 8, pa3);
#undef PK4
            pv_d0(o, vb0, pa0, pa1, pa2, pa3);
        }
    }
#undef SLOAD
#undef SWRITE
    if (hi == 0) li_l[r32] = l_run; asm volatile("s_waitcnt lgkmcnt(0)" ::: "memory");
    if (!SINK && hi == 0) lse[(tok0 + (size_t)qm * d) * 4 + lse_j] = m_run + __logf(l_run);
    __syncthreads();
    if constexpr (SINK) {
      char* ost = lds + wid * 8704; unsigned char* O8 = (unsigned char*)O;
#pragma unroll
      for (int q = 0; q < 16; ++q) { const float rl = __builtin_amdgcn_rcpf(li_l[crow(q, hi)]) * A_SCALE; unsigned char* orow = (unsigned char*)(ost + crow(q, hi) * 144) + r32;
#pragma unroll
          for (int dd = 0; dd < 4; ++dd) { const float v = fminf(fmaxf(o[dd][q] * rl, -448.f), 448.f); orow[dd * 32] = (unsigned char)(__builtin_amdgcn_cvt_pk_fp8_f32(v, v, 0, false) & 0xff); } }
      asm volatile("s_waitcnt lgkmcnt(0)" ::: "memory");
      const int rr = lane >> 3, cc = lane & 7;
#pragma unroll
      for (int k = 0; k < 4; ++k) { const int row = rr + 8 * k; const v4u w = *(const v4u*)(ost + row * 144 + cc * 16);
          *(v4u*)(O8 + (tok0 + (size_t)(m0 + wq * 32 + row) * d) * ldo + ocol + cc * 16) = w; }
    } else {
      char* ost = lds + wid * 8704;
#pragma unroll
      for (int q = 0; q < 16; ++q) { const float rl = __builtin_amdgcn_rcpf(li_l[crow(q, hi)]); unsigned short* orow = (unsigned short*)(ost + crow(q, hi) * 272) + r32;
#pragma unroll
          for (int dd = 0; dd < 4; ++dd) { const float v = o[dd][q] * rl; orow[dd * 32] = (unsigned short)(cvtpk(v, v) & 0xffffu); } }
      asm volatile("s_waitcnt lgkmcnt(0)" ::: "memory");
      const int rr = lane >> 4, cc = lane & 15;
#pragma unroll
      for (int k = 0; k < 8; ++k) { const int row = rr + 4 * k; const v4u w = *(const v4u*)(ost + row * 272 + cc * 16);
          *(v4u*)(O + (tok0 + (size_t)(m0 + wq * 32 + row) * d) * ldo + ocol + cc * 8) = w; } }
}
}

__device__ __forceinline__ void p2_attention(Frame& F) {
    const bf16* proj = (const bf16*)(F.ws + WS_PROJ);
    bf16* attA = (bf16*)(F.ws + WS_ATTA); bf16* oB = (bf16*)(F.ws + WS_OB); float* lseB = (float*)(F.ws + WS_LSE);
    const int vcu = (F.G & 7) ? (int)blockIdx.x : (int)(blockIdx.x & 7) * (F.G >> 3) + (int)(blockIdx.x >> 3);
    const bool bal = F.G == 256; const int nmine = bal ? (vcu < 128 ? 2 : 3) : (640 - vcu + F.G - 1) / F.G;
    for (int ui = 0; ui < nmine; ++ui) { const int uid = bal ? (vcu < 128 ? 2 * vcu + ui : 256 + 3 * (vcu - 128) + ui) : vcu + ui * F.G;
        if (uid < 256) {
            const int b = uid >> 7, rem = uid & 127, blk = rem >> 3, hq = rem & 7, kvh = hq >> 2;
            att::attn_unit<128, true>(F.ldsg, proj, b, C_QA + hq * HD, C_KA + kvh * HD, C_VA + kvh * HD, 1, 0, blk * 256,
                                      F.rel_bias + hq, F.sink_a[hq], attA, AQW, hq * HD, nullptr, 0);
        } else {
            const int u2 = uid - 256, gi = u2 >> 7, rem = u2 & 127, b = rem >> 6, blk = (rem >> 2) & 15, j = rem & 3;
            const int d = gi == 0 ? 1 : (gi == 1 ? 4 : 16), nbr = 16 / d, r = blk / nbr, m0 = (blk % nbr) * 256, hb = gi * 4 + j;
            att::attn_unit<64, false>(F.ldsg, proj, b, C_QB + hb * HD, C_KB + hb * HD, C_VB + hb * HD, d, r, m0,
                                      F.rel_bias + 8 + hb, 0.f, oB + (size_t)gi * T * BOW, BOW, j * HD, lseB + (size_t)gi * T * 4, j);
        }
    }
}
__device__ __forceinline__ void p3_combine(Frame& F) {
    const Lane Ls = lane_state();
    const bf16* oB = (const bf16*)(F.ws + WS_OB); const float* lseB = (const float*)(F.ws + WS_LSE); bf16* attB = (bf16*)(F.ws + WS_ATTB);
    for (int t = Ls.gw; t < T; t += F.NGW) {
        const int j = Ls.lane >> 4;
        const float l0 = lseB[(size_t)t * 4 + j], l1 = lseB[(size_t)(T + t) * 4 + j], l2 = lseB[(size_t)(2 * T + t) * 4 + j];
        const float mx = fmaxf(l0, fmaxf(l1, l2)); const float e0 = __expf(l0 - mx), e1 = __expf(l1 - mx), e2 = __expf(l2 - mx); const float inv = 1.f / (e0 + e1 + e2);
        const float w0 = e0 * inv, w1 = e1 * inv, w2 = e2 * inv;
        const v4u a = *(const v4u*)(oB + (size_t)t * BOW + Ls.lane * 8), bq = *(const v4u*)(oB + ((size_t)T + t) * BOW + Ls.lane * 8), c = *(const v4u*)(oB + ((size_t)2 * T + t) * BOW + Ls.lane * 8);
        float cv[8];
#pragma unroll
        for (int k = 0; k < 4; ++k) { cv[2 * k] = (w0 * bflo(a[k]) + w1 * bflo(bq[k]) + w2 * bflo(c[k])) * A_SCALE; cv[2 * k + 1] = (w0 * bfhi(a[k]) + w1 * bfhi(bq[k]) + w2 * bfhi(c[k])) * A_SCALE; }
        v2u o; o.x = pk4_fp8(cv[0], cv[1], cv[2], cv[3]); o.y = pk4_fp8(cv[4], cv[5], cv[6], cv[7]);
        *(v2u*)((unsigned char*)attB + (size_t)t * BOW + Ls.lane * 8) = o;
    }
}

__device__ __forceinline__ float gelu_erf(float v) {
    const float av = fabsf(v), t = __builtin_amdgcn_rcpf(fmaf(av, 0.2316418882f, 1.0f));
    float q = fmaf(t, 0.5307027145f, -0.7265760135f); q = fmaf(q, t, 0.7107068705f); q = fmaf(q, t, -0.142248368f); q = fmaf(q, t, 0.127414796f); q = q * t;
    const float e = __builtin_amdgcn_exp2f(v * v * -0.72134752044f);
    const float m = v * (q * e);
    return v < 0.f ? m : v - m;
}
typedef float f32x2 __attribute__((ext_vector_type(2)));
template <int K> __device__ __forceinline__ float xor_lane(float x) {
    static_assert(K == 1 || K == 2 || K == 4 || K == 8, "xor distance");
    const int xi = __builtin_bit_cast(int, x);
    if constexpr (K == 1) return __builtin_bit_cast(float, __builtin_amdgcn_mov_dpp(xi, 0xB1, 0xf, 0xf, true));
    else if constexpr (K == 2) return __builtin_bit_cast(float, __builtin_amdgcn_mov_dpp(xi, 0x4E, 0xf, 0xf, true));
    else return __builtin_bit_cast(float, __builtin_amdgcn_ds_swizzle(xi, (K << 10) | 0x1f));
}
#define PIN16(A, B) asm volatile("" : "+v"(A[(B) + 0]), "+v"(A[(B) + 1]), "+v"(A[(B) + 2]), "+v"(A[(B) + 3]), "+v"(A[(B) + 4]), "+v"(A[(B) + 5]), "+v"(A[(B) + 6]), "+v"(A[(B) + 7]), \
    "+v"(A[(B) + 8]), "+v"(A[(B) + 9]), "+v"(A[(B) + 10]), "+v"(A[(B) + 11]), "+v"(A[(B) + 12]), "+v"(A[(B) + 13]), "+v"(A[(B) + 14]), "+v"(A[(B) + 15]) :: "memory")
#ifndef P8_DU
#define P8_DU 4
#endif
#ifndef P8_DV
#define P8_DV 4
#endif
constexpr int P8_CH = 3;
constexpr int P8_ST = 64;
constexpr int P8_PB = 768;
__device__ __forceinline__ v32f unpack_lo(const v4u (&b)[P8_CH]) { return __builtin_amdgcn_cvt_scalef32_pk32_f32_fp6((v6u){b[0][0], b[0][1], b[0][2], b[0][3], b[1][0], b[1][1]}, 1.0f); }
__device__ __forceinline__ v32f unpack_hi(const v4u (&b)[P8_CH]) { return __builtin_amdgcn_cvt_scalef32_pk32_f32_fp6((v6u){b[1][2], b[1][3], b[2][0], b[2][1], b[2][2], b[2][3]}, 1.0f); }
template <int D> __device__ __forceinline__ void issue_part(v4u (&buf)[P8_CH], const unsigned char* tab, unsigned e, int gl) {
    const unsigned char* p = tab + (size_t)e * P8_PB + 16 * gl;
#pragma unroll
    for (int jj = 0; jj < P8_CH; ++jj) buf[jj] = *(const v4u*)(p + 256 * jj);
}
template <int D> __device__ __forceinline__ void sweep_u(const unsigned char* tab, const LAS unsigned* entg, LAS float* awg, int gl, int part, const float (&hv)[P8_ST]) {
    static_assert(128 % D == 0 && D % 4 == 0 && D <= 16, "block size");
    v4u buf[D][P8_CH];
    tab += (size_t)part * ((size_t)NEXP * P8_PB);
    { v4u e4[D / 4];
#pragma unroll
      for (int q = 0; q < D / 4; ++q) e4[q] = *(const LAS v4u*)(entg + 4 * q);
#pragma unroll
      for (int j = 0; j < D; ++j) issue_part<D>(buf[j], tab, e4[j >> 2][j & 3], gl); }
#pragma unroll 1
    for (int k0 = 0; k0 < 128; k0 += D) {
        v4u e4[D / 4]; const int kb = (k0 + D < 128) ? k0 + D : 128 - D;
#pragma unroll
        for (int q = 0; q < D / 4; ++q) e4[q] = *(const LAS v4u*)(entg + kb + 4 * q);
#pragma unroll
        for (int q = 0; q < D / 4; ++q) asm volatile("" : "+v"(e4[q]));
        float racc[D];
#pragma unroll
        for (int j = 0; j < D; ++j) {
            float a0 = 0.f, a1 = 0.f;
            { const v32f r = unpack_lo(buf[j]);
#pragma unroll
              for (int i = 0; i < 32; i += 2) { a0 = fmaf(r[i], hv[i], a0); a1 = fmaf(r[i + 1], hv[i + 1], a1); } }
            { const v32f r = unpack_hi(buf[j]);
#pragma unroll
              for (int i = 0; i < 32; i += 2) { a0 = fmaf(r[i], hv[32 + i], a0); a1 = fmaf(r[i + 1], hv[33 + i], a1); } }
            racc[j] = a0 + a1; asm volatile("" : "+v"(racc[j]) :: "memory");
            issue_part<D>(buf[j], tab, e4[j >> 2][j & 3], gl);
        }
        static_assert(D == 4, "the butterfly below is written for blocks of 4 steps");
        { const bool up_ = (gl & 2) != 0;
#pragma unroll
          for (int i = 0; i < 2; ++i) { const float keep = up_ ? racc[i + 2] : racc[i], send = up_ ? racc[i] : racc[i + 2]; racc[i] = keep + xor_lane<2>(send); } }
        { const bool up_ = (gl & 1) != 0; const float keep = up_ ? racc[1] : racc[0], send = up_ ? racc[0] : racc[1]; racc[0] = keep + xor_lane<1>(send); }
        float r = racc[0];
        r += xor_lane<4>(r); r += xor_lane<8>(r);
        if (gl < D) awg[part * 512 + k0 + gl] = r;
    }
}
template <int D> __device__ __forceinline__ void sweep_v(const unsigned char* tab, const LAS unsigned* entg, const LAS float* awg, int gl, int part, float (&po)[P8_ST]) {
    static_assert(128 % D == 0 && D % 4 == 0 && D <= 16, "block size");
    v4u buf[D][P8_CH];
    tab += (size_t)part * ((size_t)NEXP * P8_PB);
    { v4u e4[D / 4];
#pragma unroll
      for (int q = 0; q < D / 4; ++q) e4[q] = *(const LAS v4u*)(entg + 4 * q);
#pragma unroll
      for (int j = 0; j < D; ++j) issue_part<D>(buf[j], tab, e4[j >> 2][j & 3], gl); }
#pragma unroll 1
    for (int k0 = 0; k0 < 128; k0 += D) {
        v4u e4[D / 4]; f32x4 w4[D / 4]; const int kb = (k0 + D < 128) ? k0 + D : 128 - D;
#pragma unroll
        for (int q = 0; q < D / 4; ++q) { e4[q] = *(const LAS v4u*)(entg + kb + 4 * q); w4[q] = *(const LAS f32x4*)(awg + k0 + 4 * q); }
#pragma unroll
        for (int q = 0; q < D / 4; ++q) asm volatile("" : "+v"(e4[q]), "+v"(w4[q]));
#pragma unroll
        for (int j = 0; j < D; ++j) {
            const float wk = w4[j >> 2][j & 3];
            { const v32f r = unpack_lo(buf[j]);
#pragma unroll
              for (int i = 0; i < 32; ++i) po[i] = fmaf(wk, r[i], po[i]);
              PIN16(po, 0); PIN16(po, 16); }
            { const v32f r = unpack_hi(buf[j]);
#pragma unroll
              for (int i = 0; i < 32; ++i) po[32 + i] = fmaf(wk, r[i], po[32 + i]);
              PIN16(po, 32); PIN16(po, 48); }
            issue_part<D>(buf[j], tab, e4[j >> 2][j & 3], gl);
        }
    }
}
__device__ __forceinline__ void p8_expert(Frame& F) {
    const Lane Ls = lane_state();
    const unsigned char* U8 = F.ws + WS_U; const unsigned char* V8 = F.ws + WS_V; const float* esc = (const float*)(F.ws + WS_ESC);
    const float* part = (const float*)(F.ws + WS_PART); const int* tki = (const int*)(F.ws + WS_TKI); const float* tkg = (const float*)(F.ws + WS_TKG);
    bf16* X1b = (bf16*)(F.ws + WS_X1B);
    LAS unsigned* key = (LAS unsigned*)(F.lds + RING_OFF + Ls.wave * 16384); LAS unsigned* ent = key + 512; LAS float* gsv = (LAS float*)(ent + 512); LAS float* sus = gsv + 512; LAS float* aw = sus + 512;
    const int vw0 = ((int)(blockIdx.x & 7) * (F.G >> 3) + (int)(blockIdx.x >> 3)) * NWAVES + Ls.wave;
    for (int v = (F.G & 7) ? Ls.gw : vw0; v < T / 4; v += F.NGW) {
        unsigned zz = 0u; asm volatile("" : "+s"(zz));
        int lane = (int)__builtin_amdgcn_mbcnt_hi(~0u, __builtin_amdgcn_mbcnt_lo(~0u, zz)); asm volatile("" : "+v"(lane));
        const int sg = lane >> 4, gl = lane & 15, tok = 4 * v + sg;
        LAS unsigned* keyg = key + sg * 128; LAS unsigned* entg = ent + sg * 128; LAS float* gsvg = gsv + sg * 128; LAS float* susg = sus + sg * 128; LAS float* awg = aw + sg * 128;
        { unsigned mk[8]; float mg[8];
#pragma unroll
          for (int q = 0; q < 8; ++q) { const int j = gl + 16 * q; const int e = tki[(size_t)tok * 128 + j]; mg[q] = tkg[(size_t)tok * 128 + j]; mk[q] = ((unsigned)e << 7) | (unsigned)j; keyg[j] = mk[q]; }
          asm volatile("s_waitcnt lgkmcnt(0)" ::: "memory");
          int rk[8];
#pragma unroll
          for (int q = 0; q < 8; ++q) rk[q] = 0;
#pragma unroll 4
          for (int jj = 0; jj < 32; ++jj) { const v4u kk = *(const LAS v4u*)(keyg + 4 * jj);
#pragma unroll
              for (int c = 0; c < 4; ++c)
#pragma unroll
                  for (int q = 0; q < 8; ++q) rk[q] += (kk[c] < mk[q]) ? 1 : 0; }
#pragma unroll
          for (int q = 0; q < 8; ++q) { const int e = (int)(mk[q] >> 7); entg[rk[q]] = (unsigned)e; gsvg[rk[q]] = mg[q] * esc[NEXP + e]; susg[rk[q]] = esc[e]; }
          asm volatile("s_waitcnt lgkmcnt(0)" ::: "memory"); }
        float rstd;
        { float ps = part[(size_t)tok * 32 + gl] + part[(size_t)tok * 32 + 16 + gl];
          ps += xor_lane<1>(ps); ps += xor_lane<2>(ps); ps += xor_lane<4>(ps); ps += xor_lane<8>(ps);
          rstd = rsqrtf(ps * (1.f / DM) + EPS); }
#pragma unroll
        for (int pt = 0; pt < P8_NP; ++pt) {
            float hv[P8_ST];
            { int tok2 = tok, gl2 = gl; asm volatile("" : "+v"(tok2), "+v"(gl2)); const bf16* xr = X1b + (size_t)tok2 * DM + 128 * pt + 8 * gl2; const float* gp = F.g_ffn + 128 * pt + 8 * gl2;
#pragma unroll
              for (int j = 0; j < 8; ++j) { const v4u a = *(const v4u*)(xr + 256 * j); const f32x4 g0 = *(const f32x4*)(gp + 256 * j), g1 = *(const f32x4*)(gp + 256 * j + 4);
                  hv[4 * j + 0] = bflo(a[0]) * rstd * g0[0]; hv[4 * j + 1] = bfhi(a[0]) * rstd * g0[1]; hv[4 * j + 2] = bflo(a[1]) * rstd * g0[2]; hv[4 * j + 3] = bfhi(a[1]) * rstd * g0[3];
                  hv[32 + 4 * j + 0] = bflo(a[2]) * rstd * g1[0]; hv[32 + 4 * j + 1] = bfhi(a[2]) * rstd * g1[1]; hv[32 + 4 * j + 2] = bflo(a[3]) * rstd * g1[2]; hv[32 + 4 * j + 3] = bfhi(a[3]) * rstd * g1[3];
                  if (j == 3) { PIN16(hv, 0); PIN16(hv, 32); } if (j == 7) { PIN16(hv, 16); PIN16(hv, 48); } } }
            sweep_u<P8_DU>(U8, entg, awg, gl, pt, hv);
            asm volatile("s_waitcnt lgkmcnt(0)" ::: "memory");
        }
#pragma unroll
        for (int q = 0; q < 8; ++q) { const int j = gl + 16 * q; const float x = (awg[j] + awg[512 + j]) * susg[j]; awg[j] = gsvg[j] * gelu_erf(x); }
        asm volatile("s_waitcnt lgkmcnt(0)" ::: "memory");
        float s2 = 0.f;
#pragma unroll
        for (int pt = 0; pt < P8_NP; ++pt) {
            float po[P8_ST];
#pragma unroll
            for (int q = 0; q < P8_ST; ++q) po[q] = 0.f;
            sweep_v<P8_DV>(V8, entg, awg, gl, pt, po);
            { int tok2 = tok, gl2 = gl; asm volatile("" : "+v"(tok2), "+v"(gl2)); bf16* xb = X1b + (size_t)tok2 * DM + 128 * pt + 8 * gl2;
#pragma unroll
              for (int j = 0; j < 8; ++j) { const v4u a = *(const v4u*)(xb + 256 * j); v4u o4;
#pragma unroll
                  for (int g = 0; g < 2; ++g) { const unsigned w0 = a[2 * g], w1 = a[2 * g + 1]; f32x4 o;
                      o[0] = bflo(w0) + po[32 * g + 4 * j + 0]; o[1] = bfhi(w0) + po[32 * g + 4 * j + 1]; o[2] = bflo(w1) + po[32 * g + 4 * j + 2]; o[3] = bfhi(w1) + po[32 * g + 4 * j + 3];
#pragma unroll
                      for (int e = 0; e < 4; ++e) s2 = fmaf(o[e], o[e], s2);
                      o4[2 * g] = cvtpk(o[0], o[1]); o4[2 * g + 1] = cvtpk(o[2], o[3]); }
                  *(v4u*)(xb + 256 * j) = o4;
                  if (j & 1) asm volatile("" : "+v"(s2) :: "memory"); } }
        }
        { s2 += xor_lane<1>(s2); s2 += xor_lane<2>(s2); s2 += xor_lane<4>(s2); s2 += xor_lane<8>(s2);
          const float r2 = rsqrtf(s2 * (1.f / DM) + EPS);
          int tok2 = tok; asm volatile("" : "+v"(tok2)); float* xr = F.out + (size_t)tok2 * DM + 16 * gl; const float* gf = F.g_fin + 16 * gl; const bf16* xb = X1b + (size_t)tok2 * DM + 16 * gl;
#pragma unroll
          for (int jj = 0; jj < 8; ++jj) { const v4u a0 = *(const v4u*)(xb + 256 * jj), a1 = *(const v4u*)(xb + 256 * jj + 8);
#pragma unroll
              for (int q = 0; q < 4; ++q) { const f32x4 g = *(const f32x4*)(gf + 256 * jj + 4 * q); const unsigned w0 = q < 2 ? a0[2 * q] : a1[2 * q - 4], w1 = q < 2 ? a0[2 * q + 1] : a1[2 * q - 3];
                  const f32x4 a = {bflo(w0), bfhi(w0), bflo(w1), bfhi(w1)};
                  *(f32x4*)(xr + 256 * jj + 4 * q) = a * r2 * g; }
              asm volatile("" ::: "memory"); } }
    }
}

constexpr int N_PHASES = 9;
struct Args { const float* in[14]; float* out; unsigned char* ws; int ph_lo, ph_hi; };
__global__ void __launch_bounds__(NWAVES * 64, 2) fwd_kernel(Args args) {
    extern __shared__ __attribute__((aligned(16))) unsigned char lds[];
    Frame F;
    F.lds = (LAS unsigned char*)lds; F.ldsg = (char*)lds;
    F.G = gridDim.x; F.NGW = F.G * NWAVES;
    F.x = args.in[0]; F.rel_bias = args.in[1]; F.g_mix = args.in[2]; F.w_in = args.in[3]; F.sink_a = args.in[4]; F.w_oa = args.in[5]; F.w_ob = args.in[6]; F.w_out = args.in[7];
    F.g_ffn = args.in[8]; F.w_pq = args.in[9]; F.keys = args.in[10]; F.eu = args.in[11]; F.ev = args.in[12]; F.g_fin = args.in[13];
    F.out = args.out; F.ws = args.ws;
    volatile LAS unsigned* MISC = (volatile LAS unsigned*)(F.lds + MISC_OFF);
    for (int u = threadIdx.x; u < (LDS_BYTES - LDSCTL_OFF) / 4; u += NWAVES * 64) ((LAS unsigned*)(F.lds + LDSCTL_OFF))[u] = 0u;
    __syncthreads();
    const int lo = args.ph_lo, hi = args.ph_hi;
    const bool multi = !MK_SPLIT || (hi - lo) > 1;
    XcdBarrier bar; bar.bar = (unsigned*)(F.ws + WS_CTL) + CW_BAR; bar.x = 0; bar.st = nullptr;
    if (multi) bar = xcd_barrier_post((unsigned*)(F.ws + WS_CTL) + CW_BAR, MISC + 8);
#ifndef PH_OFF
#define PH_OFF 0
#endif
#if MK_SPLIT
#define IN(k) (lo <= (k) && (k) < hi && !((PH_OFF >> (k)) & 1))
#else
#define IN(k) (!((PH_OFF >> (k)) & 1))
#endif
#define GRID_BAR() do { XcdBarrier b_ = bar; asm volatile("" : "+s"(b_.bar)); xcd_barrier(b_); } while (0)
#define SEAM(k) do { if (IN(k) && IN((k) + 1)) GRID_BAR(); } while (0)
#ifndef PH_REP
#define PH_REP 0
#endif
#define NREP(k) (IN(k) ? 1 + ((PH_REP >> (k)) & 1) : 0)
#define REPEAT(k) _Pragma("unroll") for (int r_ = 0; r_ < NREP(k); ++r_)
#define REBAR() do { if (r_) GRID_BAR(); } while (0)
    bf16* WinT = (bf16*)(F.ws + WS_WIN); bf16* WoaT = (bf16*)(F.ws + WS_WOA); bf16* WobT = (bf16*)(F.ws + WS_WOB); bf16* WoutT = (bf16*)(F.ws + WS_WOUT); bf16* W2T = (bf16*)(F.ws + WS_W2);
    bf16* proj = (bf16*)(F.ws + WS_PROJ); bf16* Hb = (bf16*)(F.ws + WS_H); bf16* mrg = (bf16*)(F.ws + WS_MRG);
    bf16* attA = (bf16*)(F.ws + WS_ATTA); bf16* attB = (bf16*)(F.ws + WS_ATTB); bf16* x1b = (bf16*)(F.ws + WS_X1B);
    float* part = (float*)(F.ws + WS_PART); float* scores = (float*)(F.ws + WS_SC);

    REPEAT(0) { REBAR(); p0_prologue(F); } SEAM(0);
    REPEAT(1) { REBAR();
        pg8::Gemm g{Hb, WinT, T, INW, DM / 2}; pg8::StaticOrder S; S.init(T, INW, F.G, (int)blockIdx.x);
        pg8::EpiProj E{proj, T, C_GA / 256, 1.f / W_SCALE};
        pg8::gemm_phase<pg8::EpiProj, pg8::StaticOrder, true, true, true>(F.lds + RING_OFF, g, S, E);
    } SEAM(1);
    REPEAT(2) { REBAR(); p2_attention(F); } SEAM(2);
    for (int r34 = 0; r34 < 1 + ((PH_REP >> 3) & 1); ++r34) {
    if (r34) GRID_BAR();
    if (IN(3)) {
        p3_combine(F);
        pg8::Gemm g{attA, WoaT, T, DM, AQW / 2}; pg8::StaticOrder S; S.init(T, DM, F.G, (int)blockIdx.x);
        pg8::EpiGate<false> E{proj + (size_t)(C_GA / 128) * T * 128, T, mrg, DM, 1.f / (A_SCALE * W_SCALE)};
        pg8::gemm_phase<pg8::EpiGate<false>, pg8::StaticOrder, false, true, true>(F.lds + RING_OFF, g, S, E);
    } SEAM(3);
    if (IN(4)) {
        pg8::Gemm g{attB, WobT, T, DM, BOW / 2}; pg8::StaticOrder S; S.init(T, DM, F.G, (int)blockIdx.x);
        pg8::EpiGateF8 E{proj + (size_t)(C_GB / 128) * T * 128, T, mrg, DM, F.ws + WS_MRG8, DM, M_SCALE, 1.f / (A_SCALE * W_SCALE)};
        pg8::gemm_phase<pg8::EpiGateF8, pg8::StaticOrder, false, true, true>(F.lds + RING_OFF, g, S, E);
    }
    }
    SEAM(4);
    REPEAT(5) { REBAR();
        pg8::Gemm g{(const bf16*)(F.ws + WS_MRG8), WoutT, T, DM, DM / 2}; pg8::StaticOrder S; S.init(T, DM, F.G, (int)blockIdx.x);
        pg8::EpiResid E{F.x, x1b, part, DM, 1.f / (M_SCALE * W_SCALE)};
        pg8::gemm_phase<pg8::EpiResid, pg8::StaticOrder, false, true, true>(F.lds + RING_OFF, g, S, E);
    } SEAM(5);
    const bool tab_first = ((blockIdx.x >> 3) & 1) == 0;
    if (IN(6) && tab_first) p6_tables(F);
    REPEAT(6) { REBAR();
        pg8::Gemm g{x1b, W2T, T, DM, DM}; pg8::StaticOrder S; S.init(T, DM, F.G, (int)blockIdx.x);
        LAS float* rs = (LAS float*)(F.lds + RSTD_OFF);
        const Lane Ls = lane_state();
        pg8::Unit u0; if (S.next(0, u0) && Ls.tid < 256) { const f32x4* pp = (const f32x4*)(part + (size_t)(u0.pm * 256 + Ls.tid) * 32); float s = 0.f;
#pragma unroll
            for (int i = 0; i < 8; ++i) { const f32x4 v = pp[i]; s += (v[0] + v[1]) + (v[2] + v[3]); }
            rs[Ls.tid] = rsqrtf(s * (1.f / DM) + EPS); }
        __syncthreads();
        pg8::EpiTopk E{rs, (int*)(F.ws + WS_TKI), (float*)(F.ws + WS_TKG), PHEADS, scores, DM};
        pg8::gemm_phase<pg8::EpiTopk, pg8::StaticOrder, false, true>(F.lds + RING_OFF, g, S, E);
    }
    if (IN(6) && !tab_first) p6_tables(F);
    if (IN(6) && IN(8)) GRID_BAR();
    if (IN(8)) { p8_expert(F); }
#undef IN
#undef SEAM
}

extern "C" void kernel_launch(void* const* d_in, const int* in_sizes, int n_in, void* d_out, int out_size, void* d_ws, size_t ws_size, hipStream_t stream) {
    static int grid = 0;
    if (grid == 0) {
        if (n_in != 14 || in_sizes[0] != T * DM || out_size != T * DM || ws_size < WS_END) {
            fprintf(stderr, "kernel_launch: unexpected shapes: n_in %d in0 %d out %d ws %zu (need >= %zu); nothing launched\n", n_in, n_in > 0 ? in_sizes[0] : -1, out_size, ws_size, (size_t)WS_END); grid = -1; return; }
        int dev = 0, cus = 0, per_cu = 0;
        if (hipGetDevice(&dev) != hipSuccess || hipDeviceGetAttribute(&cus, hipDeviceAttributeMultiprocessorCount, dev) != hipSuccess) { grid = -1; return; }
        if (hipFuncSetAttribute((const void*)fwd_kernel, hipFuncAttributeMaxDynamicSharedMemorySize, LDS_BYTES) != hipSuccess) { fprintf(stderr, "kernel_launch: hipFuncSetAttribute failed\n"); grid = -1; return; }
        if (hipOccupancyMaxActiveBlocksPerMultiprocessor(&per_cu, (const void*)fwd_kernel, NWAVES * 64, LDS_BYTES) != hipSuccess || per_cu < 1)
            fprintf(stderr, "kernel_launch: note: occupancy query reports %d workgroups per CU\n", per_cu);
        (void)hipGetLastError();
        grid = cus;
        if (grid != 256) fprintf(stderr, "kernel_launch: note: %d CUs (built for 256)\n", grid);
    }
    if (grid < 0) return;
    (void)hipMemsetAsync((char*)d_ws + WS_CTL, 0, CTL_ZERO_BYTES, stream);
    Args a{};
    for (int i = 0; i < 14; ++i) a.in[i] = (const float*)d_in[i];
    a.out = (float*)d_out; a.ws = (unsigned char*)d_ws;
#if MK_SPLIT
    for (int p = 0; p < N_PHASES; ++p) { a.ph_lo = p; a.ph_hi = p + 1; hipLaunchKernelGGL(fwd_kernel, dim3(grid), dim3(NWAVES * 64), LDS_BYTES, stream, a); }
#else
    a.ph_lo = 0; a.ph_hi = N_PHASES; hipLaunchKernelGGL(fwd_kernel, dim3(grid), dim3(NWAVES * 64), LDS_BYTES, stream, a);
#endif
    const hipError_t le = hipPeekAtLastError();
    if (le != hipSuccess) fprintf(stderr, "kernel_launch: launch failed: %s\n", hipGetErrorName(le));
}
```

```cpp
#include <hip/hip_runtime.h>
#include <cstdio>
#include <cstdint>
namespace pg8 {
#define PG8_LAS __attribute__((address_space(3)))
typedef unsigned short bf16_t;
typedef short bf16x8 __attribute__((ext_vector_type(8)));
typedef float f32x4 __attribute__((ext_vector_type(4)));
typedef unsigned u32x4 __attribute__((ext_vector_type(4)));
typedef int v4i_t __attribute__((ext_vector_type(4)));
typedef int v8i_t __attribute__((ext_vector_type(8)));
constexpr int BM = 256, BK = 64, HALF = 128, HTB = HALF * BK * 2  , STAGE_BYTES = 8 * HTB, NXCD = 8, WGM = 8;

__host__ __device__ __forceinline__ int lds_byte(int r, int c) { const int st = (r >> 4) * 2 + (c >> 5), rr = r & 15, cc = c & 31, ob = rr * 64 + cc * 2; return st * 1024 + (ob ^ (((ob >> 9) & 1) << 5)); }
__host__ __device__ __forceinline__ void stage_rc(int b, int& R, int& C) { const int st = b / 1024, sb = b % 1024, swz = sb ^ (((sb >> 9) & 1) << 5); R = (st >> 1) * 16 + swz / 64; C = (st & 1) * 32 + (swz % 64) / 2; }
__host__ __device__ __forceinline__ int perm32(int rho) { const int n = rho >> 4, i = rho & 15; return 8 * (i >> 2) + 4 * n + (i & 3); }

struct Unit { int pm, pn; };
struct Gemm { const bf16_t* A; const bf16_t* Bt; int M, N, K; };

struct StaticOrder {
    int nM, nN, nwg, G, c;
    __host__ __device__ void init(int M, int N, int G_, int c_) { nM = M / BM; nN = N / BM; nwg = nM * nN; G = G_; c = c_; }
    __host__ __device__ bool next(int i, Unit& u) const {
        const long L = (long)i * G + c; if (L >= nwg) return false;
        int wgid = (int)L; { const int q = nwg / NXCD, r = nwg % NXCD, xcd = wgid % NXCD, off = wgid / NXCD; wgid = (xcd < r ? xcd * (q + 1) : r * (q + 1) + (xcd - r) * q) + off; }
        const int nig = WGM * nN, gid = wgid / nig, fm = gid * WGM, gsz = (nM - fm) < WGM ? (nM - fm) : WGM;
        u.pm = fm + ((wgid % nig) % gsz); u.pn = (wgid % nig) / gsz; return true;
    }
    __device__ __forceinline__ void a_ready(const Unit&) const {}
    __device__ __forceinline__ void done(const Unit&) const {}
};

typedef unsigned u32x2 __attribute__((ext_vector_type(2)));
__device__ __forceinline__ unsigned cvt_pk_bf16(float lo, float hi) { unsigned r; asm volatile("v_cvt_pk_bf16_f32 %0, %1, %2" : "=v"(r) : "v"(lo), "v"(hi)); return r; }
__device__ __forceinline__ float sigm(float v) { return __builtin_amdgcn_rcpf(1.0f + __builtin_amdgcn_exp2f(-1.4426950408889634f * v)); }
__device__ __forceinline__ float bflo(unsigned w) { return __builtin_bit_cast(float, w << 16); }
__device__ __forceinline__ float bfhi(unsigned w) { return __builtin_bit_cast(float, w & 0xffff0000u); }

struct EpiProj {
    static constexpr bool PERM = true, AFTER_DRAIN = false;
    bf16_t* O; int ldc; int gate_pn; float osc;
    __device__ __forceinline__ void operator()(const f32x4 (&acc)[2][2][4][2], const Unit& u, int wr, int wc, int fr_, int fq_) const {
        (void)fr_; (void)fq_; int ln_ = (int)__builtin_amdgcn_mbcnt_hi(~0u, __builtin_amdgcn_mbcnt_lo(~0u, 0u)); asm volatile("" : "+v"(ln_));
        const int fr = ln_ & 15, fq = ln_ >> 4;
        const int row0 = u.pm * BM + wr * 64 + fr, col0 = u.pn * BM + wc * 32 + 8 * fq; const bool gate = u.pn >= gate_pn;
#pragma unroll
        for (int ai = 0; ai < 2; ++ai)
#pragma unroll
            for (int m = 0; m < 4; ++m) { bf16_t* rowp = O + ((size_t)(2 * u.pn) * ldc + (row0 + ai * HALF + m * 16)) * 128 + wc * 32 + 8 * fq;
#pragma unroll
                for (int bj = 0; bj < 2; ++bj) { f32x4 v0 = acc[ai][bj][m][0] * osc, v1 = acc[ai][bj][m][1] * osc;
                    if (gate) {
#pragma unroll
                        for (int j = 0; j < 4; ++j) { v0[j] = sigm(v0[j]); v1[j] = sigm(v1[j]); } }
                    u32x4 w; w.x = cvt_pk_bf16(v0[0], v0[1]); w.y = cvt_pk_bf16(v0[2], v0[3]); w.z = cvt_pk_bf16(v1[0], v1[1]); w.w = cvt_pk_bf16(v1[2], v1[3]);
                    *(u32x4*)(rowp + (size_t)bj * ldc * 128) = w; } }
    }
};
template <bool ACCUM> struct EpiGate {
    static constexpr bool PERM = true, AFTER_DRAIN = false;
    const bf16_t* G; int ldg; bf16_t* O; int ldc; float osc;
    __device__ __forceinline__ void operator()(const f32x4 (&acc)[2][2][4][2], const Unit& u, int wr, int wc, int fr_, int fq_) const {
        (void)fr_; (void)fq_; int ln_ = (int)__builtin_amdgcn_mbcnt_hi(~0u, __builtin_amdgcn_mbcnt_lo(~0u, 0u)); asm volatile("" : "+v"(ln_));
        const int fr = ln_ & 15, fq = ln_ >> 4;
        const int row0 = u.pm * BM + wr * 64 + fr, col0 = u.pn * BM + wc * 32 + 8 * fq;
#pragma unroll
        for (int ai = 0; ai < 2; ++ai)
#pragma unroll
            for (int m = 0; m < 4; ++m) { const int row = row0 + ai * HALF + m * 16; const bf16_t* gp = G + ((size_t)(2 * u.pn) * ldg + row) * 128 + wc * 32 + 8 * fq; bf16_t* op = O + (size_t)row * ldc + col0;
#pragma unroll
                for (int bj = 0; bj < 2; ++bj) { const u32x4 gw = *(const u32x4*)(gp + (size_t)bj * ldg * 128);
                    f32x4 v0 = acc[ai][bj][m][0] * osc, v1 = acc[ai][bj][m][1] * osc;
                    v0[0] *= bflo(gw.x); v0[1] *= bfhi(gw.x); v0[2] *= bflo(gw.y); v0[3] *= bfhi(gw.y);
                    v1[0] *= bflo(gw.z); v1[1] *= bfhi(gw.z); v1[2] *= bflo(gw.w); v1[3] *= bfhi(gw.w);
                    if (ACCUM) { const u32x4 mw = *(const u32x4*)(op + bj * HALF);
                        v0[0] += bflo(mw.x); v0[1] += bfhi(mw.x); v0[2] += bflo(mw.y); v0[3] += bfhi(mw.y);
                        v1[0] += bflo(mw.z); v1[1] += bfhi(mw.z); v1[2] += bflo(mw.w); v1[3] += bfhi(mw.w); }
                    u32x4 w; w.x = cvt_pk_bf16(v0[0], v0[1]); w.y = cvt_pk_bf16(v0[2], v0[3]); w.z = cvt_pk_bf16(v1[0], v1[1]); w.w = cvt_pk_bf16(v1[2], v1[3]);
                    *(u32x4*)(op + bj * HALF) = w; } }
    }
};
__device__ __forceinline__ unsigned pk4_fp8e(float a, float b, float c, float d) { int p = __builtin_amdgcn_cvt_pk_fp8_f32(fminf(fmaxf(a, -448.f), 448.f), fminf(fmaxf(b, -448.f), 448.f), 0, false);
    return (unsigned)__builtin_amdgcn_cvt_pk_fp8_f32(fminf(fmaxf(c, -448.f), 448.f), fminf(fmaxf(d, -448.f), 448.f), p, true); }
struct EpiGateF8 {
    static constexpr bool PERM = true, AFTER_DRAIN = false;
    const bf16_t* G; int ldg; const bf16_t* M1; int ldm; unsigned char* O8; int ldc; float oscale; float osc;
    __device__ __forceinline__ void operator()(const f32x4 (&acc)[2][2][4][2], const Unit& u, int wr, int wc, int fr_, int fq_) const {
        (void)fr_; (void)fq_; int ln_ = (int)__builtin_amdgcn_mbcnt_hi(~0u, __builtin_amdgcn_mbcnt_lo(~0u, 0u)); asm volatile("" : "+v"(ln_));
        const int fr = ln_ & 15, fq = ln_ >> 4;
        const int row0 = u.pm * BM + wr * 64 + fr, col0 = u.pn * BM + wc * 32 + 8 * fq;
#pragma unroll
        for (int ai = 0; ai < 2; ++ai)
#pragma unroll
            for (int m = 0; m < 4; ++m) { const int row = row0 + ai * HALF + m * 16; const bf16_t* gp = G + ((size_t)(2 * u.pn) * ldg + row) * 128 + wc * 32 + 8 * fq; const bf16_t* mp = M1 + (size_t)row * ldm + col0; unsigned char* op = O8 + (size_t)row * ldc + col0;
#pragma unroll
                for (int bj = 0; bj < 2; ++bj) { const u32x4 gw = *(const u32x4*)(gp + (size_t)bj * ldg * 128), mw = *(const u32x4*)(mp + bj * HALF);
                    f32x4 v0 = acc[ai][bj][m][0] * osc, v1 = acc[ai][bj][m][1] * osc;
                    v0[0] = (v0[0] * bflo(gw.x) + bflo(mw.x)) * oscale; v0[1] = (v0[1] * bfhi(gw.x) + bfhi(mw.x)) * oscale; v0[2] = (v0[2] * bflo(gw.y) + bflo(mw.y)) * oscale; v0[3] = (v0[3] * bfhi(gw.y) + bfhi(mw.y)) * oscale;
                    v1[0] = (v1[0] * bflo(gw.z) + bflo(mw.z)) * oscale; v1[1] = (v1[1] * bfhi(gw.z) + bfhi(mw.z)) * oscale; v1[2] = (v1[2] * bflo(gw.w) + bflo(mw.w)) * oscale; v1[3] = (v1[3] * bfhi(gw.w) + bfhi(mw.w)) * oscale;
                    u32x2 w; w.x = pk4_fp8e(v0[0], v0[1], v0[2], v0[3]); w.y = pk4_fp8e(v1[0], v1[1], v1[2], v1[3]);
                    *(u32x2*)(op + bj * HALF) = w; } }
    }
};

struct EpiResid {
    static constexpr bool PERM = false, AFTER_DRAIN = false;
    const float* X; bf16_t* X1b; float* part; int ld; float osc;
    __device__ __forceinline__ void operator()(const f32x4 (&acc)[2][2][4][2], const Unit& u, int wr, int wc, int fr_, int fq_) const {
        (void)fr_; (void)fq_; int ln_ = (int)__builtin_amdgcn_mbcnt_hi(~0u, __builtin_amdgcn_mbcnt_lo(~0u, 0u)); asm volatile("" : "+v"(ln_));
        const int fr = ln_ & 15, fq = ln_ >> 4;
        const int row0 = u.pm * BM + wr * 64 + fr, col0 = u.pn * BM + wc * 32 + 4 * fq;
#pragma unroll
        for (int ai = 0; ai < 2; ++ai)
#pragma unroll
            for (int m = 0; m < 4; ++m) { const int row = row0 + ai * HALF + m * 16; float ss = 0.f;
#pragma unroll
                for (int bj = 0; bj < 2; ++bj)
#pragma unroll
                    for (int n = 0; n < 2; ++n) { const size_t off = (size_t)row * ld + col0 + bj * HALF + n * 16;
                        const f32x4 x = *(const f32x4*)(X + off); const f32x4 v = x + acc[ai][bj][m][n] * osc;
                        u32x2 w; w.x = cvt_pk_bf16(v[0], v[1]); w.y = cvt_pk_bf16(v[2], v[3]); *(u32x2*)(X1b + off) = w;
                        ss += (v[0] * v[0] + v[1] * v[1]) + (v[2] * v[2] + v[3] * v[3]); }
                ss += __shfl_xor(ss, 16); ss += __shfl_xor(ss, 32);
                if (fq == 0) part[(size_t)row * 32 + u.pn * 4 + wc] = ss; }
    }
};
__device__ __forceinline__ int tk_enc(float s) { const int b = __builtin_bit_cast(int, s); return b ^ ((b >> 31) & 0x7fffffff); }
__device__ __forceinline__ float tk_dec(int k) { return __builtin_bit_cast(float, k ^ ((k >> 31) & 0x7fffffff)); }
#define TK_INS16(Lst, X) do { int x_ = (X); _Pragma("unroll") for (int i_ = 0; i_ < 16; ++i_) { const int h_ = Lst[i_] > x_ ? Lst[i_] : x_; x_ = Lst[i_] > x_ ? x_ : Lst[i_]; Lst[i_] = h_; } } while (0)
__device__ __forceinline__ void tk_sort16(int (&v)[16]) {
#pragma unroll
    for (int k = 2; k <= 16; k <<= 1)
#pragma unroll
        for (int j = k >> 1; j > 0; j >>= 1)
#pragma unroll
            for (int i = 0; i < 16; ++i) { const int l = i ^ j; if (l > i) { const int a = v[i], b = v[l]; const int hi = a > b ? a : b, lo = a > b ? b : a; const bool desc = (i & k) == 0; v[i] = desc ? hi : lo; v[l] = desc ? lo : hi; } }
}
__device__ __forceinline__ void tk_merge16(int (&a)[16], const int (&b)[16]) {
#pragma unroll
    for (int i = 0; i < 16; ++i) a[i] = a[i] > b[15 - i] ? a[i] : b[15 - i];
#pragma unroll
    for (int j = 8; j > 0; j >>= 1)
#pragma unroll
        for (int i = 0; i < 16; ++i) { const int l = i ^ j; if (l > i) { const int x = a[i], y = a[l]; a[i] = x > y ? x : y; a[l] = x > y ? y : x; } }
}
#define TK_BAR() do { asm volatile("s_waitcnt lgkmcnt(0)" ::: "memory"); __builtin_amdgcn_s_barrier(); asm volatile("" ::: "memory"); } while (0)
struct EpiTopk {
    static constexpr bool PERM = false, AFTER_DRAIN = true;
    const PG8_LAS float* rs; int* tki; float* tkg; int nheads; float* S; int ld;
    __device__ __forceinline__ void fused(f32x4 (&acc)[2][2][4][2], const Unit& u, int wr, int wc, int fr_, int fq_, PG8_LAS unsigned char* lds, int wid, int lane_) const {
        (void)fr_; (void)fq_; (void)lane_; int lane = (int)__builtin_amdgcn_mbcnt_hi(~0u, __builtin_amdgcn_mbcnt_lo(~0u, 0u)); asm volatile("" : "+v"(lane));
        const int fr = lane & 15, fq = lane >> 4;
        PG8_LAS float* img = (PG8_LAS float*)lds;
        PG8_LAS int* lst = (PG8_LAS int*)lds;
        PG8_LAS int* mrg = (PG8_LAS int*)(lds + 32768);
        TK_BAR();
#pragma unroll
        for (int m = 0; m < 4; ++m) { const int row = wr * 64 + m * 16 + fr; const float s = rs[row];
#pragma unroll
            for (int bj = 0; bj < 2; ++bj)
#pragma unroll
                for (int n = 0; n < 2; ++n) { const int q = bj * 32 + wc * 8 + n * 4 + fq; *(PG8_LAS f32x4*)(img + row * 256 + ((q ^ (row & 63)) << 2)) = acc[0][bj][m][n] * s; } }
        asm volatile("s_waitcnt vmcnt(0) lgkmcnt(0)" ::: "memory");
        TK_BAR();
#ifndef TK_REP
#define TK_REP 0
#endif
#pragma unroll 1
        for (int ai_ = 0; ai_ < 2 * (1 + TK_REP); ++ai_) { const int ai = ai_ & 1;
            asm volatile("" : "+v"(lane) :: "memory");
            const int tid = wid * 64 + lane;
            if (ai) { const int fr2 = lane & 15, fq2 = lane >> 4;
#pragma unroll
              for (int m = 0; m < 4; ++m) { const int row = wr * 64 + m * 16 + fr2; const float s = rs[HALF + row];
#pragma unroll
                  for (int bj = 0; bj < 2; ++bj)
#pragma unroll
                      for (int n = 0; n < 2; ++n) { const int q = bj * 32 + wc * 8 + n * 4 + fq2; *(PG8_LAS f32x4*)(img + row * 256 + ((q ^ (row & 63)) << 2)) = acc[1][bj][m][n] * s; } }
              TK_BAR(); }
            const int row = tid & 127, c = (tid >> 7) & 1, kh = tid >> 8;
            int Lk[16];
#pragma unroll 1
            for (int g = 0; g < 4; ++g) {
                int Nk[16];
#pragma unroll
                for (int i = 0; i < 4; ++i) { const int q = 32 * c + 16 * kh + 4 * g + i; const f32x4 v = *(const PG8_LAS f32x4*)(img + row * 256 + ((q ^ (row & 63)) << 2));
#pragma unroll
                    for (int e = 0; e < 4; ++e) Nk[4 * i + e] = (tk_enc(v[e]) & ~127) | (127 - (64 * kh + 16 * g + 4 * i + e)); }
                tk_sort16(Nk);
                if (g == 0) {
#pragma unroll
                    for (int i = 0; i < 16; ++i) Lk[i] = Nk[i]; }
                else tk_merge16(Lk, Nk);
            }
            TK_BAR();
            { PG8_LAS int* d = lst + ((row * 2 + c) * 2 + kh) * 16;
#pragma unroll
              for (int i = 0; i < 4; ++i) *(PG8_LAS v4i_t*)(d + 4 * i) = (v4i_t){Lk[4 * i], Lk[4 * i + 1], Lk[4 * i + 2], Lk[4 * i + 3]}; }
            TK_BAR();
            if (kh == 0) {
                const PG8_LAS int* o = lst + ((row * 2 + c) * 2 + 1) * 16; int Ok[16];
#pragma unroll
                for (int i = 0; i < 4; ++i) { const v4i_t w = *(const PG8_LAS v4i_t*)(o + 4 * i); Ok[4 * i] = w[0]; Ok[4 * i + 1] = w[1]; Ok[4 * i + 2] = w[2]; Ok[4 * i + 3] = w[3]; }
                tk_merge16(Lk, Ok);
                PG8_LAS int* d = mrg + (row * 2 + c) * 16;
#pragma unroll
                for (int i = 0; i < 4; ++i) *(PG8_LAS v4i_t*)(d + 4 * i) = (v4i_t){Lk[4 * i], Lk[4 * i + 1], Lk[4 * i + 2], Lk[4 * i + 3]};
            }
            TK_BAR();
            if (tid < 128) {
                const PG8_LAS int* A = mrg + (tid * 2 + 0) * 16; const PG8_LAS int* B = mrg + (tid * 2 + 1) * 16;
                float s0[16], s1[16];
#pragma unroll
                for (int i = 0; i < 4; ++i) { const v4i_t a = *(const PG8_LAS v4i_t*)(A + 4 * i), b = *(const PG8_LAS v4i_t*)(B + 4 * i);
#pragma unroll
                    for (int e = 0; e < 4; ++e) { s0[4 * i + e] = tk_dec(a[e] & ~127); s1[4 * i + e] = tk_dec(b[e] & ~127); } }
                int Mk[16], Ck[16];
                int cnt = 0;
#pragma unroll
                for (int i = 0; i < 16; ++i)
#pragma unroll
                    for (int j = 0; j < 16; ++j) if ((i + 1) * (j + 1) <= 16) {
                        Ck[cnt & 15] = (tk_enc(s0[i] + s1[j]) & ~255) | (i << 4) | j; ++cnt;
                        if ((cnt & 15) == 0 || cnt == 50) {
                            if (cnt == 50) {
#pragma unroll
                                for (int z = 2; z < 16; ++z) Ck[z] = (int)0x80000000; }
                            tk_sort16(Ck);
                            if (cnt == 16) {
#pragma unroll
                                for (int z = 0; z < 16; ++z) Mk[z] = Ck[z]; }
                            else tk_merge16(Mk, Ck);
                        } }
                const float smax = tk_dec(Mk[0] & ~255); float ev[16], den = 0.f;
#pragma unroll
                for (int q = 0; q < 16; ++q) { ev[q] = __expf(tk_dec(Mk[q] & ~255) - smax); den += ev[q]; }
                const float inv = 1.f / den; const size_t ob = ((size_t)(u.pm * BM + ai * HALF + tid) * nheads + u.pn) * 16;
#pragma unroll
                for (int q4 = 0; q4 < 4; ++q4) { v4i_t ei; f32x4 gv;
#pragma unroll
                    for (int e = 0; e < 4; ++e) { const int k = Mk[4 * q4 + e]; ei[e] = (127 - (A[(k >> 4) & 15] & 127)) * 128 + (127 - (B[k & 15] & 127)); gv[e] = ev[4 * q4 + e] * inv; }
                    *(v4i_t*)(tki + ob + 4 * q4) = ei; *(f32x4*)(tkg + ob + 4 * q4) = gv; }
            }
            TK_BAR();
        }
    }
};

template <class Epi, class Sched, bool ALIGN_EPI = false, bool SP2 = false, bool F8 = false>
__device__ __forceinline__ void gemm_phase(PG8_LAS unsigned char* lds, const Gemm g, const Sched& S, const Epi& E) {
    int tid_ = threadIdx.x; asm volatile("" : "+v"(tid_));
    const int tid = tid_, wid = __builtin_amdgcn_readfirstlane(tid >> 6), lane = tid & 63, wr = wid >> 2, wc = wid & 3, fr = lane & 15, fq = lane >> 4;
    const int K = g.K, nt = K / BK;
    unsigned voffA[2], voffB[2];
#pragma unroll
    for (int i = 0; i < 2; ++i) { int R, C; stage_rc(tid * 16 + i * 8192, R, C); const int Rb = Epi::PERM ? ((R & ~31) + perm32(R & 31)) : R;
        voffA[i] = (unsigned)(R * K + C) * 2u; voffB[i] = (unsigned)(Rb * K + C) * 2u; }
    const size_t kstep = (size_t)(BK * 2);
    const size_t hstep = (size_t)HALF * K * 2;
    const size_t tstep = 2 * hstep;
    const unsigned ldsw = (unsigned)__builtin_amdgcn_readfirstlane((int)((unsigned)(__SIZE_TYPE__)lds + (unsigned)wid * 1024u));
    const int aoff = lds_byte(wr * 64 + fr, fq * 8), boff = lds_byte(wc * 32 + fr, fq * 8);
#define PG8_SA(b, h) (((b) * 2 + (h)) * HTB)
#define PG8_SB(b, h) ((4 + (b) * 2 + (h)) * HTB)
#define PG8_STAGE(bufoff, gbase, voff) do { _Pragma("unroll") for (int _i = 0; _i < 2; ++_i) \
        __builtin_amdgcn_global_load_lds((const unsigned*)((const char*)(gbase) + (voff)[_i]), (PG8_LAS unsigned*)(__SIZE_TYPE__)(ldsw + (unsigned)((bufoff) + _i * 8192)), 16, 0, 0); } while (0)
    PG8_LAS unsigned char* ldsA = lds + aoff; PG8_LAS unsigned char* ldsB = lds + 4 * HTB + boff; asm volatile("" : "+v"(ldsA), "+v"(ldsB));
#define PG8_LD8(p) __builtin_shufflevector(*(const PG8_LAS v4i_t*)(p), *(const PG8_LAS v4i_t*)((p) + 1024), 0, 1, 2, 3, 4, 5, 6, 7)
#define PG8_LDA(dst, b, h) do { _Pragma("unroll") for (int m = 0; m < 4; ++m) dst[m] = PG8_LD8(ldsA + ((b) * 2 + (h)) * HTB + m * 2048); } while (0)
#define PG8_LDB(dst, b, h) do { _Pragma("unroll") for (int n = 0; n < 2; ++n) dst[n] = PG8_LD8(ldsB + ((b) * 2 + (h)) * HTB + n * 2048); } while (0)
#define PG8_H(X, k) __builtin_bit_cast(bf16x8, __builtin_shufflevector(X, X, 4 * (k), 4 * (k) + 1, 4 * (k) + 2, 4 * (k) + 3))
#define PG8_MMA(ai, bj, At, Bt) do { __builtin_amdgcn_s_setprio(1); _Pragma("unroll") for (int m = 0; m < 4; ++m) _Pragma("unroll") for (int n = 0; n < 2; ++n) { \
        if constexpr (F8) asm volatile("v_mfma_scale_f32_16x16x128_f8f6f4 %0, %1, %2, %0, %3, %3 op_sel_hi:[0,0,0]" : "+v"(acc[ai][bj][m][n]) : "v"(Bt[n]), "v"(At[m]), "v"(mxs));   \
        else { acc[ai][bj][m][n] = __builtin_amdgcn_mfma_f32_16x16x32_bf16(PG8_H(Bt[n], 0), PG8_H(At[m], 0), acc[ai][bj][m][n], 0, 0, 0); \
               acc[ai][bj][m][n] = __builtin_amdgcn_mfma_f32_16x16x32_bf16(PG8_H(Bt[n], 1), PG8_H(At[m], 1), acc[ai][bj][m][n], 0, 0, 0); } } __builtin_amdgcn_s_setprio(0); } while (0)
#define PG8_WAIT_V(n) asm volatile("s_waitcnt vmcnt(" #n ")" ::: "memory")
#define PG8_WAIT_L(n) asm volatile("s_waitcnt lgkmcnt(" #n ")" ::: "memory")
#define PG8_BAR __builtin_amdgcn_s_barrier()
#define PG8_SCHED __builtin_amdgcn_sched_barrier(0)
    Unit cur, nxt; int ui = 0;
    if (!S.next(0, cur)) return;
    f32x4 acc[2][2][4][2];
#pragma unroll
    for (int a = 0; a < 2; ++a)
#pragma unroll
        for (int b = 0; b < 2; ++b)
#pragma unroll
            for (int m = 0; m < 4; ++m)
#pragma unroll
                for (int n = 0; n < 2; ++n) acc[a][b][m][n] = (f32x4){0.f, 0.f, 0.f, 0.f};
    int mxs = 0x7f7f7f7f; asm volatile("" : "+v"(mxs));
    v8i_t At[4], B0[2], B1[2];
    const char* cA = (const char*)g.A + (size_t)cur.pm * tstep; const char* cB = (const char*)g.Bt + (size_t)cur.pn * tstep;
    S.a_ready(cur);
    if constexpr (SP2) {
        PG8_STAGE(PG8_SB(0, 0), cB, voffB); PG8_STAGE(PG8_SB(0, 1), cB + hstep, voffB); PG8_STAGE(PG8_SA(0, 0), cA, voffA); PG8_STAGE(PG8_SA(0, 1), cA + hstep, voffA);
        if (wr == 1) PG8_BAR;
        PG8_WAIT_V(2); PG8_BAR;
        PG8_STAGE(PG8_SB(1, 0), cB + kstep, voffB); PG8_STAGE(PG8_SA(1, 0), cA + kstep, voffA); PG8_STAGE(PG8_SB(1, 1), cB + hstep + kstep, voffB);
        PG8_WAIT_V(6); PG8_BAR;
    } else {
        PG8_STAGE(PG8_SB(0, 0), cB, voffB); PG8_STAGE(PG8_SA(0, 0), cA, voffA); PG8_STAGE(PG8_SB(0, 1), cB + hstep, voffB); PG8_STAGE(PG8_SA(0, 1), cA + hstep, voffA);
        if (wr == 1) PG8_BAR;
        PG8_WAIT_V(4); PG8_BAR;
        PG8_STAGE(PG8_SB(1, 0), cB + kstep, voffB); PG8_STAGE(PG8_SA(1, 0), cA + kstep, voffA); PG8_STAGE(PG8_SB(1, 1), cB + hstep + kstep, voffB);
        PG8_WAIT_V(6); PG8_BAR;
    }
    for (;;) {
        const bool has_next = S.next(ui + 1, nxt);
        const char* nA = has_next ? (const char*)g.A + (size_t)nxt.pm * tstep : cA; const char* nB = has_next ? (const char*)g.Bt + (size_t)nxt.pn * tstep : cB;
        for (int t = 0; t < nt; t += 2) {
            const bool last = (t == nt - 2);
            const char* a1 = cA + (size_t)(t + 1) * kstep;
            const char* a2 = last ? nA : cA + (size_t)(t + 2) * kstep; const char* b2 = last ? nB : cB + (size_t)(t + 2) * kstep;
            const char* a3 = a2 + kstep; const char* b3 = b2 + kstep;
            if (last && has_next) S.a_ready(nxt);
            if constexpr (SP2) {
            PG8_LDB(B0, 0, 0); PG8_LDB(B1, 0, 1); PG8_SCHED; PG8_LDA(At, 0, 0); PG8_STAGE(PG8_SA(1, 1), a1 + hstep, voffA);
            PG8_WAIT_V(8); PG8_WAIT_L(0); PG8_BAR; PG8_MMA(0, 0, At, B0); PG8_MMA(0, 1, At, B1); PG8_BAR; PG8_SCHED;
            PG8_LDA(At, 0, 1); PG8_STAGE(PG8_SB(0, 0), b2, voffB); PG8_STAGE(PG8_SB(0, 1), b2 + hstep, voffB); PG8_STAGE(PG8_SA(0, 0), a2, voffA);
            PG8_WAIT_V(8); PG8_WAIT_L(0); PG8_BAR; PG8_MMA(1, 0, At, B0); PG8_MMA(1, 1, At, B1); PG8_BAR; PG8_SCHED;
            PG8_LDB(B0, 1, 0); PG8_LDB(B1, 1, 1); PG8_SCHED; PG8_LDA(At, 1, 0); PG8_STAGE(PG8_SA(0, 1), a2 + hstep, voffA);
            PG8_WAIT_V(8); PG8_WAIT_L(0); PG8_BAR; PG8_MMA(0, 0, At, B0); PG8_MMA(0, 1, At, B1); PG8_BAR; PG8_SCHED;
            PG8_LDA(At, 1, 1); PG8_STAGE(PG8_SB(1, 0), b3, voffB); PG8_STAGE(PG8_SB(1, 1), b3 + hstep, voffB); PG8_STAGE(PG8_SA(1, 0), a3, voffA);
            PG8_WAIT_V(8); PG8_WAIT_L(0); PG8_BAR; PG8_MMA(1, 0, At, B0); PG8_MMA(1, 1, At, B1); PG8_BAR; PG8_SCHED;
            } else {
            PG8_LDB(B0, 0, 0); PG8_SCHED; PG8_LDA(At, 0, 0); PG8_STAGE(PG8_SA(1, 1), a1 + hstep, voffA);
            PG8_WAIT_L(8); PG8_BAR; PG8_WAIT_L(0); PG8_MMA(0, 0, At, B0); PG8_BAR; PG8_SCHED;
            PG8_LDB(B1, 0, 1); PG8_STAGE(PG8_SB(0, 0), b2, voffB);
            PG8_BAR; PG8_WAIT_L(0); PG8_MMA(0, 1, At, B1); PG8_BAR;
            PG8_LDA(At, 0, 1); PG8_STAGE(PG8_SA(0, 0), a2, voffA);
            PG8_BAR; PG8_WAIT_L(0); PG8_MMA(1, 0, At, B0); PG8_BAR; PG8_SCHED;
            PG8_STAGE(PG8_SB(0, 1), b2 + hstep, voffB);
            PG8_WAIT_V(6); PG8_BAR; PG8_MMA(1, 1, At, B1); PG8_BAR;
            PG8_LDB(B0, 1, 0); PG8_SCHED; PG8_LDA(At, 1, 0); PG8_STAGE(PG8_SA(0, 1), a2 + hstep, voffA);
            PG8_WAIT_L(8); PG8_BAR; PG8_WAIT_L(0); PG8_MMA(0, 0, At, B0); PG8_BAR; PG8_SCHED;
            PG8_LDB(B1, 1, 1); PG8_STAGE(PG8_SB(1, 0), b3, voffB);
            PG8_BAR; PG8_WAIT_L(0); PG8_MMA(0, 1, At, B1); PG8_BAR;
            PG8_LDA(At, 1, 1); PG8_STAGE(PG8_SA(1, 0), a3, voffA);
            PG8_BAR; PG8_WAIT_L(0); PG8_MMA(1, 0, At, B0); PG8_BAR; PG8_SCHED;
            PG8_STAGE(PG8_SB(1, 1), b3 + hstep, voffB);
            PG8_WAIT_V(6); PG8_BAR; PG8_MMA(1, 1, At, B1); PG8_BAR;
            }
        }
        if constexpr (F8) asm volatile("s_nop 15\n\ts_nop 7" ::: "memory");
        if constexpr (ALIGN_EPI) { if (wr == 0) PG8_BAR; }
        if constexpr (!Epi::AFTER_DRAIN) { E(acc, cur, wr, wc, fr, fq); S.done(cur); }
        if (!has_next) break;
#pragma unroll
        for (int a = 0; a < 2; ++a)
#pragma unroll
            for (int b = 0; b < 2; ++b)
#pragma unroll
                for (int m = 0; m < 4; ++m)
#pragma unroll
                    for (int n = 0; n < 2; ++n) acc[a][b][m][n] = (f32x4){0.f, 0.f, 0.f, 0.f};
        cur = nxt; cA = nA; cB = nB; ++ui;
        if constexpr (ALIGN_EPI) { if (wr == 1) PG8_BAR; }
    }
    PG8_WAIT_V(0);
    if constexpr (!ALIGN_EPI) { if (wr == 0) PG8_BAR; }
    PG8_BAR;
    if constexpr (Epi::AFTER_DRAIN) { E.fused(acc, cur, wr, wc, fr, fq, lds, wid, lane); S.done(cur); }
#undef PG8_SA
#undef PG8_SB
#undef PG8_STAGE
#undef PG8_LDA
#undef PG8_LDB
#undef PG8_MMA
#undef PG8_H
#undef PG8_LD8
#undef PG8_WAIT_V
#undef PG8_WAIT_L
#undef PG8_BAR
#undef PG8_SCHED
}
}
#define GAS __attribute__((address_space(1)))
#define LAS __attribute__((address_space(3)))
#define XB_TMO      128
#define XB_XCNT(j)  (256  + 64 * (j))
#define XB_XSUB(j)  (1280 + 64 * (j))
#define XB_XGEN(j)  (2304 + 64 * (j))
#define XB_TOP      3328
#define XB_TOPGEN   3392
#define XCD_BAR_WORDS 3456
#define XB_SPIN_CAP (1u << 18)

__device__ __forceinline__ unsigned xb_ld(unsigned* p)              { return __hip_atomic_load(p, __ATOMIC_RELAXED, __HIP_MEMORY_SCOPE_AGENT); }
__device__ __forceinline__ unsigned xb_add(unsigned* p, unsigned v) { return __hip_atomic_fetch_add(p, v, __ATOMIC_RELAXED, __HIP_MEMORY_SCOPE_AGENT); }
__device__ __forceinline__ unsigned xb_xcc_id() { return (unsigned)__builtin_amdgcn_s_getreg((3 << 11) | 20) & 0xFu; }
#define XB_SPIN(cond, bar) do { unsigned _sp = 0; while (cond) { __builtin_amdgcn_s_sleep(1); \
    if ((++_sp & 255u) == 0u) { if (xb_ld(&(bar)[XB_TMO])) break; if (_sp > XB_SPIN_CAP) { atomicAdd(&(bar)[XB_TMO], 1u); break; } } } } while (0)

struct XcdBarrier {
    unsigned* bar; unsigned x;
    volatile LAS unsigned* st;
};

__device__ __forceinline__ XcdBarrier xcd_barrier_post(unsigned* bar, volatile LAS unsigned* st) {
    XcdBarrier b; b.bar = bar; b.x = xb_xcc_id(); b.st = st;
    if (threadIdx.x == 0) (void)xb_add(&bar[XB_XCNT(b.x)], 1u);
    return b;
}
__device__ __forceinline__ void xcd_barrier_complete(unsigned* bar, unsigned x, unsigned& nloc, unsigned& nx) {
    const unsigned G = gridDim.x * gridDim.y * gridDim.z;
    unsigned sum, cnt, mine, sp = 0u;
    for (;;) {
        sum = 0u; cnt = 0u; mine = 0u;
#pragma unroll
        for (unsigned j = 0; j < 16; ++j) { const unsigned c = xb_ld(&bar[XB_XCNT(j)]); sum += c; cnt += (c > 0u) ? 1u : 0u; mine = (j == x) ? c : mine; }
        if (sum == G) break;
        __builtin_amdgcn_s_sleep(1);
        if ((++sp & 255u) == 0u) { if (xb_ld(&bar[XB_TMO])) break; if (sp > XB_SPIN_CAP) { atomicAdd(&bar[XB_TMO], 1u); break; } }
    }
    nloc = mine > 0u ? mine : 1u; nx = cnt > 0u ? cnt : 1u;
}

__device__ __forceinline__ void xcd_barrier(const XcdBarrier& b) {
    asm volatile("s_waitcnt vmcnt(0)" ::: "memory");
    __syncthreads();
    if (threadIdx.x == 0) {
        unsigned* bar = b.bar;
        __builtin_amdgcn_s_waitcnt(0);
        unsigned nloc = b.st[0], nx = b.st[1];
        if (nloc == 0u) { xcd_barrier_complete(bar, b.x, nloc, nx); b.st[0] = nloc; b.st[1] = nx; }
        const unsigned old = xb_add(&bar[XB_XSUB(b.x)], 1u);
        const unsigned gen = old / nloc;
        if (old + 1u == (gen + 1u) * nloc) {
            __builtin_amdgcn_fence(__ATOMIC_RELEASE, "agent");
            asm volatile("s_waitcnt vmcnt(0)" ::: "memory");
            const unsigned og = xb_add(&bar[XB_TOP], 1u);
            const unsigned tg = og / nx;
            if (og + 1u == (tg + 1u) * nx) xb_add(&bar[XB_TOPGEN], 1u);
            else XB_SPIN(xb_ld(&bar[XB_TOPGEN]) == tg, bar);
            __builtin_amdgcn_fence(__ATOMIC_ACQUIRE, "agent");
            xb_add(&bar[XB_XGEN(b.x)], 1u);
            asm volatile("s_waitcnt vmcnt(0)" ::: "memory");
        } else {
            XB_SPIN(xb_ld(&bar[XB_XGEN(b.x)]) == gen, bar);
            __builtin_amdgcn_fence(__ATOMIC_ACQUIRE, "agent");
            asm volatile("s_waitcnt vmcnt(0)" ::: "memory");
        }
    }
    __syncthreads();
}

#ifndef MK_SPLIT
#define MK_SPLIT 0
#endif
#ifndef P8_NP
#define P8_NP 2
#endif
constexpr int NWAVES = 8;
constexpr int NB = 2, SEQ = 4096, DM = 2048, T = NB * SEQ, HD = 128;
constexpr int INW = 10240;
constexpr int C_QA = 0, C_KA = 1024, C_VA = 1280, C_QB = 1536, C_KB = 3072, C_VB = 4608, C_GA = 6144, C_GB = 8192;
constexpr int AQW = 1024, BOW = 512;
constexpr int NEXP = 16384, PHEADS = 8, NKEYS = 128, TOPK = 16;
constexpr int NBIAS = 20;
constexpr float EPS = 1e-6f;
constexpr float SM_SCALE = 0.088388347648318440f;
constexpr float LOG2E = 1.4426950408889634f;
constexpr float A_SCALE = 16.f;
constexpr float M_SCALE = 64.f;
constexpr float W_SCALE = 512.f;

constexpr size_t MiB = 1u << 20;
constexpr size_t WS_CTL = 0, CTL_ZERO_BYTES = 16384;
constexpr size_t WS_WIN = 1 * MiB;
constexpr size_t WS_WOA = 41 * MiB;
constexpr size_t WS_WOB = 45 * MiB;
constexpr size_t WS_WOUT = 47 * MiB;
constexpr size_t WS_W2 = 55 * MiB;
constexpr size_t WS_U = 63 * MiB;
constexpr size_t WS_V = 87 * MiB;
constexpr size_t WS_ESC = 127 * MiB;
constexpr size_t WS_PROJ = 191 * MiB;
constexpr size_t WS_SC = WS_PROJ;
constexpr size_t WS_H = 351 * MiB;
constexpr size_t WS_MRG = WS_H;
constexpr size_t WS_ATTA = 383 * MiB;
constexpr size_t WS_OB = 399 * MiB;
constexpr size_t WS_X1B = WS_ATTA;
constexpr size_t WS_ATTB = 423 * MiB;
constexpr size_t WS_LSE = 431 * MiB;
constexpr size_t WS_PART = 432 * MiB;
constexpr size_t WS_TKI = 433 * MiB;
constexpr size_t WS_TKG = 437 * MiB;
constexpr size_t WS_MRG8 = 441 * MiB;
constexpr size_t WS_END = 457 * MiB;
constexpr int CW_BAR = 0;

constexpr int RING_OFF = 0, RING_BYTES = 131072;
constexpr int LDSCTL_OFF = RING_BYTES, MISC_OFF = LDSCTL_OFF + 320;
constexpr int RSTD_OFF = RING_BYTES + 1024;
constexpr int LDS_BYTES = 147456;
static_assert(RSTD_OFF + 1024 <= LDS_BYTES && XCD_BAR_WORDS * 4 <= (int)CTL_ZERO_BYTES, "maps");

typedef unsigned short bf16;
typedef unsigned v4u __attribute__((ext_vector_type(4)));
typedef unsigned v2u __attribute__((ext_vector_type(2)));
typedef float f32x4 __attribute__((ext_vector_type(4)));
typedef float f32x16 __attribute__((ext_vector_type(16)));
typedef short bf16x8 __attribute__((ext_vector_type(8)));
typedef short s16x4 __attribute__((ext_vector_type(4)));
typedef __bf16 bf16x2 __attribute__((ext_vector_type(2)));
#define LDS_WAIT() asm volatile("s_waitcnt lgkmcnt(0)" ::: "memory")
#define VM_WAIT() asm volatile("s_waitcnt vmcnt(0)" ::: "memory")
#define SBAR() __builtin_amdgcn_sched_barrier(0)
__device__ __forceinline__ unsigned cvtpk(float lo, float hi) { unsigned r; asm volatile("v_cvt_pk_bf16_f32 %0, %1, %2" : "=v"(r) : "v"(lo), "v"(hi)); return r; }
__device__ __forceinline__ float bflo(unsigned w) { return __builtin_bit_cast(float, w << 16); }
__device__ __forceinline__ float bfhi(unsigned w) { return __builtin_bit_cast(float, w & 0xffff0000u); }
__device__ __forceinline__ float dot2_bf16(unsigned w, unsigned x, float acc) { return __builtin_amdgcn_fdot2_f32_bf16(__builtin_bit_cast(bf16x2, w), __builtin_bit_cast(bf16x2, x), acc, false); }
__device__ __forceinline__ float wave_sum(float v) {
#pragma unroll
    for (int o = 1; o < 64; o <<= 1) v += __shfl_xor(v, o);
    return v;
}

struct Lane { int tid, lane, wave, gw; };
__device__ __forceinline__ Lane lane_state() { int t = threadIdx.x; asm volatile("" : "+v"(t)); Lane L; L.tid = t; L.lane = t & 63; L.wave = __builtin_amdgcn_readfirstlane(t >> 6); L.gw = blockIdx.x * 8 + L.wave; return L; }
struct Frame {
    LAS unsigned char* lds; char* ldsg;
    int G, NGW;
    const float *x, *rel_bias, *g_mix, *w_in, *sink_a, *w_oa, *w_ob, *w_out, *g_ffn, *w_pq, *keys, *eu, *ev, *g_fin;
    float* out; unsigned char* ws;
};

__device__ __forceinline__ unsigned pk4_fp8(float a, float b, float c, float d) { int p = __builtin_amdgcn_cvt_pk_fp8_f32(fminf(fmaxf(a, -448.f), 448.f), fminf(fmaxf(b, -448.f), 448.f), 0, false);
    return (unsigned)__builtin_amdgcn_cvt_pk_fp8_f32(fminf(fmaxf(c, -448.f), 448.f), fminf(fmaxf(d, -448.f), 448.f), p, true); }
__device__ __forceinline__ void p0_transpose_item_f8(const float* W, int K, int N, unsigned char* WT, float scale, LAS float* scr, int item, int lane) {
    const int nblk = N / 32, kb = item / nblk, nb = item % nblk, k0 = 64 * kb, n0 = 32 * nb;
    { f32x4 v[8];
#pragma unroll
      for (int i = 0; i < 8; ++i) v[i] = *(const f32x4*)(W + (size_t)(k0 + 8 * i + (lane >> 3)) * N + n0 + 4 * (lane & 7));
#pragma unroll
      for (int i = 0; i < 8; ++i) { LAS float* d = scr + (8 * i + (lane >> 3)) * 33 + 4 * (lane & 7); d[0] = v[i][0] * scale; d[1] = v[i][1] * scale; d[2] = v[i][2] * scale; d[3] = v[i][3] * scale; } }
    LDS_WAIT(); asm volatile("" ::: "memory");
    const int c = lane & 7;
#pragma unroll
    for (int j = 0; j < 4; ++j) { const int n = (lane >> 3) + 8 * j; const LAS float* s = scr + (8 * c) * 33 + n;
        v2u o; o.x = pk4_fp8(s[0 * 33], s[1 * 33], s[2 * 33], s[3 * 33]); o.y = pk4_fp8(s[4 * 33], s[5 * 33], s[6 * 33], s[7 * 33]);
        *(v2u*)(WT + (size_t)(n0 + n) * K + k0 + 8 * c) = o; }
    LDS_WAIT(); asm volatile("" ::: "memory");
}
__device__ __forceinline__ void p0_transpose_item(const float* W, int K, int N, bf16* WT, LAS float* scr, int item, int lane) {
    const int nblk = N / 32, kb = item / nblk, nb = item % nblk, k0 = 64 * kb, n0 = 32 * nb;
    { f32x4 v[8];
#pragma unroll
      for (int i = 0; i < 8; ++i) v[i] = *(const f32x4*)(W + (size_t)(k0 + 8 * i + (lane >> 3)) * N + n0 + 4 * (lane & 7));
#pragma unroll
      for (int i = 0; i < 8; ++i) { LAS float* d = scr + (8 * i + (lane >> 3)) * 33 + 4 * (lane & 7); d[0] = v[i][0]; d[1] = v[i][1]; d[2] = v[i][2]; d[3] = v[i][3]; } }
    LDS_WAIT(); asm volatile("" ::: "memory");
    const int c = lane & 7;
#pragma unroll
    for (int j = 0; j < 4; ++j) { const int n = (lane >> 3) + 8 * j; const LAS float* s = scr + (8 * c) * 33 + n;
        v4u o; o.x = cvtpk(s[0 * 33], s[1 * 33]); o.y = cvtpk(s[2 * 33], s[3 * 33]); o.z = cvtpk(s[4 * 33], s[5 * 33]); o.w = cvtpk(s[6 * 33], s[7 * 33]);
        *(v4u*)(WT + (size_t)(n0 + n) * K + k0 + 8 * c) = o; }
    LDS_WAIT(); asm volatile("" ::: "memory");
}
__device__ __forceinline__ void p0_w2_item(Frame& F, bf16* W2T, int item, int tid) {
    const int hc = item >> 5, j0 = (item & 31) * 64;
    LAS float* Ks = (LAS float*)F.lds; LAS float* Ws = Ks + 128 * 129;
    const f32x4* kp = (const f32x4*)(F.keys + (size_t)hc * 16384);
#pragma unroll
    for (int q = 0; q < 8; ++q) { const int idx = tid + 512 * q, row = idx >> 5, c4 = idx & 31; const f32x4 v = kp[idx];
        LAS float* d = Ks + row * 129 + c4 * 4; d[0] = v[0]; d[1] = v[1]; d[2] = v[2]; d[3] = v[3]; }
#pragma unroll
    for (int q = 0; q < 4; ++q) { const int idx = tid + 512 * q, row = idx >> 5, c4 = idx & 31; const f32x4 v = *(const f32x4*)(F.w_pq + (size_t)(j0 + row) * DM + hc * 128 + c4 * 4);
        LAS float* d = Ws + row * 129 + c4 * 4; d[0] = v[0]; d[1] = v[1]; d[2] = v[2]; d[3] = v[3]; }
    __syncthreads();
    { const int wv = tid >> 6, ln = tid & 63, kt = wv & 3, jt = wv >> 2, r = ln & 31, h2 = ln >> 5;
      const LAS float* ap = Ks + (kt * 32 + r) * 129 + h2; const LAS float* bp = Ws + (jt * 32 + r) * 129 + h2;
      f32x16 acc = {};
#pragma unroll 8
      for (int d0 = 0; d0 < 128; d0 += 2) acc = __builtin_amdgcn_mfma_f32_32x32x2f32(ap[d0], bp[d0], acc, 0, 0, 0);
      const int j = j0 + jt * 32 + r; const float g = F.g_ffn[j];
#pragma unroll
      for (int q = 0; q < 16; ++q) { const int k = kt * 32 + (q & 3) + 8 * (q >> 2) + 4 * h2; const float v = acc[q] * g;
          W2T[(size_t)(hc * 128 + k) * DM + j] = (bf16)(cvtpk(v, v) & 0xffffu); } }
    __syncthreads();
}
typedef float v16f __attribute__((ext_vector_type(16)));
typedef float v32f __attribute__((ext_vector_type(32)));
typedef unsigned v6u __attribute__((ext_vector_type(6)));
__device__ __forceinline__ void tab_issue(const Frame& F, int row, int lane, f32x4 (&v)[8]) {
    const float* src = (row < NEXP ? F.eu + (size_t)row * DM : F.ev + (size_t)(row - NEXP) * DM) + 4 * lane;
#pragma unroll
    for (int j = 0; j < 8; ++j) v[j] = *(const f32x4*)(src + 256 * j);
}
__device__ __forceinline__ void tab_finish(const Frame& F, int row, int lane, const f32x4 (&v)[8]) {
    static_assert(P8_NP == 2 && WS_V == WS_U + (size_t)NEXP * 1536, "table layout");
    float am = 0.f;
#pragma unroll
    for (int j = 0; j < 8; ++j) am = fmaxf(am, fmaxf(fmaxf(fabsf(v[j][0]), fabsf(v[j][1])), fmaxf(fabsf(v[j][2]), fabsf(v[j][3]))));
#pragma unroll
    for (int o = 1; o < 64; o <<= 1) am = fmaxf(am, __shfl_xor(am, o));
    const float inv = am > 0.f ? 7.5f / am : 0.f;
    v16f x, y;
#pragma unroll
    for (int j = 0; j < 8; ++j) { x[2 * j] = v[j][0] * inv; y[2 * j] = v[j][1] * inv; x[2 * j + 1] = v[j][2] * inv; y[2 * j + 1] = v[j][3] * inv; }
    const v6u pk = __builtin_amdgcn_cvt_scalef32_2xpk16_fp6_f32(x, y, 1.0f);
    const int p = lane >> 5, gl = (lane >> 1) & 15, g = lane & 1;
    unsigned char* dst = F.ws + WS_U + (size_t)(row >= NEXP) * ((size_t)NEXP * 1536) + (size_t)p * ((size_t)NEXP * 768) + (size_t)(row & (NEXP - 1)) * 768 + 16 * gl;
    const v4u a16 = g ? (v4u){pk[2], pk[3], pk[4], pk[5]} : (v4u){pk[0], pk[1], pk[2], pk[3]};
    const v2u b8 = g ? (v2u){pk[0], pk[1]} : (v2u){pk[4], pk[5]};
    *(v4u*)(dst + (g ? 512 : 0)) = a16; *(v2u*)(dst + 256 + 8 * g) = b8;
    if (lane == 0) ((float*)(F.ws + WS_ESC))[row] = am * (1.f / 7.5f);
}
__device__ __forceinline__ void p6_tables(Frame& F) {
    const Lane Ls = lane_state();
    for (int row = Ls.gw; row < 2 * NEXP; row += 2 * F.NGW) { f32x4 v0[8], v1[8]; const int row1 = row + F.NGW;
        tab_issue(F, row, Ls.lane, v0); if (row1 < 2 * NEXP) tab_issue(F, row1, Ls.lane, v1);
        tab_finish(F, row, Ls.lane, v0); if (row1 < 2 * NEXP) tab_finish(F, row1, Ls.lane, v1); }
}
__device__ __forceinline__ void p0_prologue(Frame& F) {
    const Lane Ls = lane_state();
    LAS float* scr = (LAS float*)(F.lds + RING_OFF + Ls.wave * 16384);
    bf16* WinT = (bf16*)(F.ws + WS_WIN); bf16* WoaT = (bf16*)(F.ws + WS_WOA); bf16* WobT = (bf16*)(F.ws + WS_WOB); bf16* WoutT = (bf16*)(F.ws + WS_WOUT);
    constexpr int I_IN = (DM / 64) * (INW / 32), I_OA = (AQW / 64) * (DM / 32), I_OB = (BOW / 64) * (DM / 32), I_OUT = (DM / 64) * (DM / 32);
    constexpr int NITEMS = I_IN + I_OA + I_OB + I_OUT;
    for (int it = Ls.gw; it < NITEMS; it += F.NGW) {
        int r = it;
        if (r < I_IN) { p0_transpose_item_f8(F.w_in, DM, INW, (unsigned char*)WinT, W_SCALE, scr, r, Ls.lane); continue; } r -= I_IN;
        if (r < I_OA) { p0_transpose_item_f8(F.w_oa, AQW, DM, (unsigned char*)WoaT, W_SCALE, scr, r, Ls.lane); continue; } r -= I_OA;
        if (r < I_OB) { p0_transpose_item_f8(F.w_ob, BOW, DM, (unsigned char*)WobT, W_SCALE, scr, r, Ls.lane); continue; } r -= I_OB;
        p0_transpose_item_f8(F.w_out, DM, DM, (unsigned char*)WoutT, W_SCALE, scr, r, Ls.lane);
    }
    __syncthreads();
    for (int it = blockIdx.x; it < 512; it += F.G) p0_w2_item(F, (bf16*)(F.ws + WS_W2), it, Ls.tid);
    { bf16* Hb = (bf16*)(F.ws + WS_H);
      for (int m = Ls.gw; m < T; m += F.NGW) {
          const f32x4* xr = (const f32x4*)(F.x + (size_t)m * DM) + Ls.lane; f32x4 v[8]; float s = 0.f;
#pragma unroll
          for (int j = 0; j < 8; ++j) { v[j] = xr[64 * j]; s += (v[j][0] * v[j][0] + v[j][1] * v[j][1]) + (v[j][2] * v[j][2] + v[j][3] * v[j][3]); }
          const float rstd = rsqrtf(wave_sum(s) * (1.f / DM) + EPS);
          unsigned* o4 = (unsigned*)((unsigned char*)Hb + (size_t)m * DM) + Ls.lane;
#pragma unroll
          for (int j = 0; j < 8; ++j) { const f32x4 g = ((const f32x4*)F.g_mix)[Ls.lane + 64 * j];
              o4[64 * j] = pk4_fp8(v[j][0] * rstd * g[0], v[j][1] * rstd * g[1], v[j][2] * rstd * g[2], v[j][3] * rstd * g[3]); } } }
}

namespace att {
#define KSWZ(row, colB) ((row) * 256 + ((colB) ^ (((row) & 7) << 4)))
__device__ __forceinline__ int crow(int r, int hi) { return (r & 3) + 8 * (r >> 2) + 4 * hi; }
__device__ __forceinline__ void qkt(f32x16& p0, f32x16& p1, const char* Ks, const bf16x8* qr, int r32, int hi) {
    p0 = f32x16{}; p1 = f32x16{};
#pragma unroll
    for (int d0 = 0; d0 < 8; ++d0) { const int cb = (d0 * 16 + hi * 8) * 2;
        const bf16x8 b0 = *reinterpret_cast<const bf16x8*>(Ks + KSWZ(r32, cb));
        const bf16x8 b1 = *reinterpret_cast<const bf16x8*>(Ks + KSWZ(32 + r32, cb));
        p0 = __builtin_amdgcn_mfma_f32_32x32x16_bf16(b0, qr[d0], p0, 0, 0, 0);
        p1 = __builtin_amdgcn_mfma_f32_32x32x16_bf16(b1, qr[d0], p1, 0, 0, 0); }
}
__device__ __forceinline__ int v_st(int k, int c) { const int kk = (k & ~0xC) | ((k & 4) << 1) | ((k & 8) >> 1); return ((kk >> 3) * 4 + (c >> 5)) * 512 + ((kk & 7) * 32 + (c & 31)) * 2; }
__device__ __forceinline__ int v_rd_base(int lane) { return ((lane & 3) << 3) | (((lane >> 2) & 3) << 6) | (((lane >> 4) & 1) << 5) | (((lane >> 5) & 1) << 8); }
constexpr int v_rd_off(int d0, int ks, int half) { return d0 * 512 + ks * 4096 + half * 2048; }
template <int OFF> __device__ __forceinline__ s16x4 tr_read(int vb) {
    s16x4 r; asm volatile("ds_read_b64_tr_b16 %0, %1 offset:%2" : "=&v"(r) : "v"(vb), "i"(OFF) : "memory"); return r;
}
template <int D0> __device__ __forceinline__ void pv_one(f32x16& od, int vb, bf16x8 pa0, bf16x8 pa1, bf16x8 pa2, bf16x8 pa3) {
    const s16x4 l0 = tr_read<v_rd_off(D0, 0, 0)>(vb), h0 = tr_read<v_rd_off(D0, 0, 1)>(vb), l1 = tr_read<v_rd_off(D0, 1, 0)>(vb), h1 = tr_read<v_rd_off(D0, 1, 1)>(vb);
    const s16x4 l2 = tr_read<v_rd_off(D0, 2, 0)>(vb), h2 = tr_read<v_rd_off(D0, 2, 1)>(vb), l3 = tr_read<v_rd_off(D0, 3, 0)>(vb), h3 = tr_read<v_rd_off(D0, 3, 1)>(vb);
    asm volatile("s_waitcnt lgkmcnt(0)" ::: "memory"); SBAR();
#define PK(L, H) (bf16x8){L[0], L[1], L[2], L[3], H[0], H[1], H[2], H[3]}
    od = __builtin_amdgcn_mfma_f32_32x32x16_bf16(pa0, PK(l0, h0), od, 0, 0, 0);
    od = __builtin_amdgcn_mfma_f32_32x32x16_bf16(pa1, PK(l1, h1), od, 0, 0, 0);
    od = __builtin_amdgcn_mfma_f32_32x32x16_bf16(pa2, PK(l2, h2), od, 0, 0, 0);
    od = __builtin_amdgcn_mfma_f32_32x32x16_bf16(pa3, PK(l3, h3), od, 0, 0, 0);
#undef PK
}
__device__ __forceinline__ void pv_d0(f32x16* o, int vb, bf16x8 pa0, bf16x8 pa1, bf16x8 pa2, bf16x8 pa3) {
    pv_one<0>(o[0], vb, pa0, pa1, pa2, pa3); pv_one<1>(o[1], vb, pa0, pa1, pa2, pa3); pv_one<2>(o[2], vb, pa0, pa1, pa2, pa3); pv_one<3>(o[3], vb, pa0, pa1, pa2, pa3);
}
__device__ __forceinline__ int t5_bucket(int rel) {
    const int n = rel < 0 ? -rel : rel; int b;
    if (n < 8) b = n; else { b = 8 + (n >= 15) + (n >= 27) + (n >= 50) + (n >= 91) + (n >= 166) + (n >= 305) + (n >= 559); b = b > 15 ? 15 : b; }
    return b + (rel > 0 ? 16 : 0);
}
constexpr int ATT_WS_OFF = RSTD_OFF + 1024, ATT_BT_OFF = ATT_WS_OFF + 2048;
static_assert(ATT_BT_OFF + 2 * 1040 <= LDS_BYTES, "attention scratch above the stage region");
template <int W, bool SINK>
__device__ __forceinline__ void attn_unit(char* lds, const bf16* proj, int b, int qcol, int kcol, int vcol, int d, int r, int m0u,
                                          const float* bias_col, float sinkv, bf16* O, int ldo, int ocol, float* lse, int lse_j) {
    int tid_ = threadIdx.x; asm volatile("" : "+v"(tid_));
    const int tid = tid_, wid = __builtin_amdgcn_readfirstlane(tid >> 6), lane = tid & 63, r32 = lane & 31, hi = lane >> 5;
    const int hh = wid >> 2, wq = wid & 3, htid = tid & 255;
    constexpr int NT = (128 + 2 * W) / 64;
    const int L = SEQ / d, m0 = m0u + 128 * hh;
    char* hbase = lds + hh * 65536;
    float* ws = (float*)(lds + ATT_WS_OFF) + wid * 64; float* li_l = ws; float* al_l = ws + 32;
    float* btab = (float*)(lds + ATT_BT_OFF + hh * 1040);
    __syncthreads();
    for (int i = htid; i <= 2 * W; i += 256) btab[i] = bias_col[t5_bucket((i - W) * d) * NBIAS];
    const int qm = m0 + wq * 32 + r32;
    const size_t tok0 = (size_t)b * SEQ + r;
    bf16x8 qr[8];
    { const bf16* Qw = proj + ((size_t)(qcol >> 7) * T + tok0 + (size_t)qm * d) * 128 + hi * 8;
#pragma unroll
      for (int d0 = 0; d0 < 8; ++d0) qr[d0] = *reinterpret_cast<const bf16x8*>(Qw + d0 * 16); }
    float m_run = SINK ? sinkv : -1e29f, l_run = SINK ? 1.f : 0.f;
    f32x16 o[4] = {};
    const int sr = htid >> 4, sc = (htid & 15) * 8;
    const int t_lo = wq >> 1, t_hi = (32 * wq + 31 + 2 * W) >> 6;
    bf16x8 vs[4], ks[4];
#define SLOAD(t) do { const int tm = m0 - W + 64 * (t); if (tm + 63 >= 0 && tm < L) { _Pragma("unroll") for (int i_ = 0; i_ < 4; ++i_) { int k_ = tm + sr + 16 * i_; k_ = k_ < 0 ? 0 : (k_ > L - 1 ? L - 1 : k_); \
        const size_t tk_ = tok0 + (size_t)k_ * d; vs[i_] = *reinterpret_cast<const bf16x8*>(proj + ((size_t)(vcol >> 7) * T + tk_) * 128 + sc); ks[i_] = *reinterpret_cast<const bf16x8*>(proj + ((size_t)(kcol >> 7) * T + tk_) * 128 + sc); } } } while (0)
#define SWRITE(t) do { const int tm = m0 - W + 64 * (t); if (tm + 63 >= 0 && tm < L) { char* vb_ = hbase + ((t) & 1) * 32768; char* kb_ = vb_ + 16384; _Pragma("unroll") for (int i_ = 0; i_ < 4; ++i_) { \
        *(bf16x8*)(vb_ + v_st(sr + 16 * i_, sc)) = vs[i_]; *(bf16x8*)(kb_ + KSWZ(sr + 16 * i_, sc * 2)) = ks[i_]; } } } while (0)
    SLOAD(0);
#pragma unroll 1
    for (int t = 0; t < NT; ++t) {
        SWRITE(t);
        __syncthreads();
        if (t + 1 < NT) SLOAD(t + 1);
        const int tm0 = m0 - W + 64 * t;
        if (t >= t_lo && t <= t_hi && tm0 + 63 >= 0 && tm0 < L) {
            const char* V_lds = hbase + (t & 1) * 32768; const char* K_lds = V_lds + 16384;
            const int vb0 = (int)(uintptr_t)V_lds + v_rd_base(lane);
            f32x16 p0, p1; qkt(p0, p1, K_lds, qr, r32, hi);
            const int base = tm0 - qm + W;
            float pmax = -1e30f;
#pragma unroll
            for (int q = 0; q < 16; ++q) { const int key = crow(q, hi), idx = base + key, km = tm0 + key;
                const bool ok = (unsigned)idx <= (unsigned)(2 * W) && (unsigned)km < (unsigned)L;
                const float bv = btab[ok ? idx : 0]; const float s = ok ? fmaf(p0[q], SM_SCALE, bv) : -1e30f; p0[q] = s; pmax = fmaxf(pmax, s); }
#pragma unroll
            for (int q = 0; q < 16; ++q) { const int key = 32 + crow(q, hi), idx = base + key, km = tm0 + key;
                const bool ok = (unsigned)idx <= (unsigned)(2 * W) && (unsigned)km < (unsigned)L;
                const float bv = btab[ok ? idx : 0]; const float s = ok ? fmaf(p1[q], SM_SCALE, bv) : -1e30f; p1[q] = s; pmax = fmaxf(pmax, s); }
            { auto rr = __builtin_amdgcn_permlane32_swap(__float_as_uint(pmax), __float_as_uint(pmax), false, false);
              pmax = fmaxf(__uint_as_float(rr[0]), __uint_as_float(rr[1])); }
            const float mn = fmaxf(m_run, pmax), alpha = __builtin_amdgcn_exp2f((m_run - mn) * LOG2E); m_run = mn;
            const float mnc = -mn * LOG2E; float ps = 0.f;
#pragma unroll
            for (int q = 0; q < 16; ++q) { p0[q] = __builtin_amdgcn_exp2f(fmaf(p0[q], LOG2E, mnc)); ps += p0[q]; }
#pragma unroll
            for (int q = 0; q < 16; ++q) { p1[q] = __builtin_amdgcn_exp2f(fmaf(p1[q], LOG2E, mnc)); ps += p1[q]; }
            { auto rr = __builtin_amdgcn_permlane32_swap(__float_as_uint(ps), __float_as_uint(ps), false, false);
              ps = __uint_as_float(rr[0]) + __uint_as_float(rr[1]); }
            l_run = l_run * alpha + ps;
            if (__any(alpha < 1.f)) { if (hi == 0) al_l[r32] = alpha; asm volatile("s_waitcnt lgkmcnt(0)" ::: "memory");
#pragma unroll
                for (int dd = 0; dd < 4; ++dd)
#pragma unroll
                    for (int q = 0; q < 16; ++q) o[dd][q] *= al_l[crow(q, hi)]; }
            bf16x8 pa0, pa1, pa2, pa3;
#define PK4(P, BASE, OUT) do { unsigned a0 = cvtpk(P[BASE + 0], P[BASE + 1]), a1 = cvtpk(P[BASE + 2], P[BASE + 3]);   \
    unsigned b0 = cvtpk(P[BASE + 4], P[BASE + 5]), b1 = cvtpk(P[BASE + 6], P[BASE + 7]);                              \
    auto r0 = __builtin_amdgcn_permlane32_swap(a0, b0, false, false); auto r1 = __builtin_amdgcn_permlane32_swap(a1, b1, false, false); \
    v4u w = {r0[0], r1[0], r0[1], r1[1]}; OUT = *reinterpret_cast<bf16x8*>(&w); } while (0)
            PK4(p0, 0, pa0); PK4(p0, 8, pa1); PK4(p1, 0, pa2); PK4(p1, 8, pa3);
#undef PK4
            pv_d0(o, vb0, pa0, pa1, pa2, pa3);
        }
    }
#undef SLOAD
#undef SWRITE
    if (hi == 0) li_l[r32] = l_run; asm volatile("s_waitcnt lgkmcnt(0)" ::: "memory");
    if (!SINK && hi == 0) lse[(tok0 + (size_t)qm * d) * 4 + lse_j] = m_run + __logf(l_run);
    __syncthreads();
    if constexpr (SINK) {
      char* ost = lds + wid * 8704; unsigned char* O8 = (unsigned char*)O;
#pragma unroll
      for (int q = 0; q < 16; ++q) { const float rl = __builtin_amdgcn_rcpf(li_l[crow(q, hi)]) * A_SCALE; unsigned char* orow = (unsigned char*)(ost + crow(q, hi) * 144) + r32;
#pragma unroll
          for (int dd = 0; dd < 4; ++dd) { const float v = fminf(fmaxf(o[dd][q] * rl, -448.f), 448.f); orow[dd * 32] = (unsigned char)(__builtin_amdgcn_cvt_pk_fp8_f32(v, v, 0, false) & 0xff); } }
      asm volatile("s_waitcnt lgkmcnt(0)" ::: "memory");
      const int rr = lane >> 3, cc = lane & 7;
#pragma unroll
      for (int k = 0; k < 4; ++k) { const int row = rr + 8 * k; const v4u w = *(const v4u*)(ost + row * 144 + cc * 16);
          *(v4u*)(O8 + (tok0 + (size_t)(m0 + wq * 32 + row) * d) * ldo + ocol + cc * 16) = w; }
    } else {
      char* ost = lds + wid * 8704;
#pragma unroll
      for (int q = 0; q < 16; ++q) { const float rl = __builtin_amdgcn_rcpf(li_l[crow(q, hi)]); unsigned short* orow = (unsigned short*)(ost + crow(q, hi) * 272) + r32;
#pragma unroll
          for (int dd = 0; dd < 4; ++dd) { const float v = o[dd][q] * rl; orow[dd * 32] = (unsigned short)(cvtpk(v, v) & 0xffffu); } }
      asm volatile("s_waitcnt lgkmcnt(0)" ::: "memory");
      const int rr = lane >> 4, cc = lane & 15;
#pragma unroll
      for (int k = 0; k < 8; ++k) { const int row = rr + 4 * k; const v4u w = *(const v4u*)(ost + row * 272 + cc * 16);
          *(v4u*)(O + (tok0 + (size_t)(m0 + wq * 32 + row) * d) * ldo + ocol + cc * 8) = w; } }
}
}

__device__ __forceinline__ void p2_attention(Frame& F) {
    const bf16* proj = (const bf16*)(F.ws + WS_PROJ);
    bf16* attA = (bf16*)(F.ws + WS_ATTA); bf16* oB = (bf16*)(F.ws + WS_OB); float* lseB = (float*)(F.ws + WS_LSE);
    const int vcu = (F.G & 7) ? (int)blockIdx.x : (int)(blockIdx.x & 7) * (F.G >> 3) + (int)(blockIdx.x >> 3);
    const bool bal = F.G == 256; const int nmine = bal ? (vcu < 128 ? 2 : 3) : (640 - vcu + F.G - 1) / F.G;
    for (int ui = 0; ui < nmine; ++ui) { const int uid = bal ? (vcu < 128 ? 2 * vcu + ui : 256 + 3 * (vcu - 128) + ui) : vcu + ui * F.G;
        if (uid < 256) {
            const int b = uid >> 7, rem = uid & 127, blk = rem >> 3, hq = rem & 7, kvh = hq >> 2;
            att::attn_unit<128, true>(F.ldsg, proj, b, C_QA + hq * HD, C_KA + kvh * HD, C_VA + kvh * HD, 1, 0, blk * 256,
                                      F.rel_bias + hq, F.sink_a[hq], attA, AQW, hq * HD, nullptr, 0);
        } else {
            const int u2 = uid - 256, gi = u2 >> 7, rem = u2 & 127, b = rem >> 6, blk = (rem >> 2) & 15, j = rem & 3;
            const int d = gi == 0 ? 1 : (gi == 1 ? 4 : 16), nbr = 16 / d, r = blk / nbr, m0 = (blk % nbr) * 256, hb = gi * 4 + j;
            att::attn_unit<64, false>(F.ldsg, proj, b, C_QB + hb * HD, C_KB + hb * HD, C_VB + hb * HD, d, r, m0,
                                      F.rel_bias + 8 + hb, 0.f, oB + (size_t)gi * T * BOW, BOW, j * HD, lseB + (size_t)gi * T * 4, j);
        }
    }
}
__device__ __forceinline__ void p3_combine(Frame& F) {
    const Lane Ls = lane_state();
    const bf16* oB = (const bf16*)(F.ws + WS_OB); const float* lseB = (const float*)(F.ws + WS_LSE); bf16* attB = (bf16*)(F.ws + WS_ATTB);
    for (int t = Ls.gw; t < T; t += F.NGW) {
        const int j = Ls.lane >> 4;
        const float l0 = lseB[(size_t)t * 4 + j], l1 = lseB[(size_t)(T + t) * 4 + j], l2 = lseB[(size_t)(2 * T + t) * 4 + j];
        const float mx = fmaxf(l0, fmaxf(l1, l2)); const float e0 = __expf(l0 - mx), e1 = __expf(l1 - mx), e2 = __expf(l2 - mx); const float inv = 1.f / (e0 + e1 + e2);
        const float w0 = e0 * inv, w1 = e1 * inv, w2 = e2 * inv;
        const v4u a = *(const v4u*)(oB + (size_t)t * BOW + Ls.lane * 8), bq = *(const v4u*)(oB + ((size_t)T + t) * BOW + Ls.lane * 8), c = *(const v4u*)(oB + ((size_t)2 * T + t) * BOW + Ls.lane * 8);
        float cv[8];
#pragma unroll
        for (int k = 0; k < 4; ++k) { cv[2 * k] = (w0 * bflo(a[k]) + w1 * bflo(bq[k]) + w2 * bflo(c[k])) * A_SCALE; cv[2 * k + 1] = (w0 * bfhi(a[k]) + w1 * bfhi(bq[k]) + w2 * bfhi(c[k])) * A_SCALE; }
        v2u o; o.x = pk4_fp8(cv[0], cv[1], cv[2], cv[3]); o.y = pk4_fp8(cv[4], cv[5], cv[6], cv[7]);
        *(v2u*)((unsigned char*)attB + (size_t)t * BOW + Ls.lane * 8) = o;
    }
}

__device__ __forceinline__ float gelu_erf(float v) {
    const float av = fabsf(v), t = __builtin_amdgcn_rcpf(fmaf(av, 0.2316418882f, 1.0f));
    float q = fmaf(t, 0.5307027145f, -0.7265760135f); q = fmaf(q, t, 0.7107068705f); q = fmaf(q, t, -0.142248368f); q = fmaf(q, t, 0.127414796f); q = q * t;
    const float e = __builtin_amdgcn_exp2f(v * v * -0.72134752044f);
    const float m = v * (q * e);
    return v < 0.f ? m : v - m;
}
typedef float f32x2 __attribute__((ext_vector_type(2)));
template <int K> __device__ __forceinline__ float xor_lane(float x) {
    static_assert(K == 1 || K == 2 || K == 4 || K == 8, "xor distance");
    const int xi = __builtin_bit_cast(int, x);
    if constexpr (K == 1) return __builtin_bit_cast(float, __builtin_amdgcn_mov_dpp(xi, 0xB1, 0xf, 0xf, true));
    else if constexpr (K == 2) return __builtin_bit_cast(float, __builtin_amdgcn_mov_dpp(xi, 0x4E, 0xf, 0xf, true));
    else return __builtin_bit_cast(float, __builtin_amdgcn_ds_swizzle(xi, (K << 10) | 0x1f));
}
#define PIN16(A, B) asm volatile("" : "+v"(A[(B) + 0]), "+v"(A[(B) + 1]), "+v"(A[(B) + 2]), "+v"(A[(B) + 3]), "+v"(A[(B) + 4]), "+v"(A[(B) + 5]), "+v"(A[(B) + 6]), "+v"(A[(B) + 7]), \
    "+v"(A[(B) + 8]), "+v"(A[(B) + 9]), "+v"(A[(B) + 10]), "+v"(A[(B) + 11]), "+v"(A[(B) + 12]), "+v"(A[(B) + 13]), "+v"(A[(B) + 14]), "+v"(A[(B) + 15]) :: "memory")
#ifndef P8_PROBE
#define P8_PROBE 0
#endif
#ifndef P8_SYNCV
#define P8_SYNCV 0
#endif
#ifndef P8_DU
#define P8_DU 4
#endif
#ifndef P8_DV
#define P8_DV 4
#endif
constexpr int P8_CH = 3;
constexpr int P8_ST = 64;
constexpr int P8_PB = 768;
__device__ __forceinline__ v32f unpack_lo(const v4u (&b)[P8_CH]) { return __builtin_amdgcn_cvt_scalef32_pk32_f32_fp6((v6u){b[0][0], b[0][1], b[0][2], b[0][3], b[1][0], b[1][1]}, 1.0f); }
__device__ __forceinline__ v32f unpack_hi(const v4u (&b)[P8_CH]) { return __builtin_amdgcn_cvt_scalef32_pk32_f32_fp6((v6u){b[1][2], b[1][3], b[2][0], b[2][1], b[2][2], b[2][3]}, 1.0f); }
template <int D> __device__ __forceinline__ void issue_part(v4u (&buf)[P8_CH], const unsigned char* tab, unsigned e, int gl) {
    const unsigned char* p = tab + (size_t)e * P8_PB + 16 * gl;
#pragma unroll
    for (int jj = 0; jj < P8_CH; ++jj) buf[jj] = *(const v4u*)(p + 256 * jj);
}
template <int D> __device__ __forceinline__ void sweep_u(const unsigned char* tab, const LAS unsigned* entg, LAS float* awg, int gl, int part, const float (&hv)[P8_ST]) {
    static_assert(128 % D == 0 && D % 4 == 0 && D <= 16, "block size");
    v4u buf[D][P8_CH];
    tab += (size_t)part * ((size_t)NEXP * P8_PB);
    { v4u e4[D / 4];
#pragma unroll
      for (int q = 0; q < D / 4; ++q) e4[q] = *(const LAS v4u*)(entg + 4 * q);
#pragma unroll
      for (int j = 0; j < D; ++j) issue_part<D>(buf[j], tab, e4[j >> 2][j & 3], gl); }
#pragma unroll 1
    for (int k0 = 0; k0 < 128; k0 += D) {
        v4u e4[D / 4]; const int kb = (k0 + D < 128) ? k0 + D : 128 - D;
#pragma unroll
        for (int q = 0; q < D / 4; ++q) e4[q] = *(const LAS v4u*)(entg + kb + 4 * q);
#pragma unroll
        for (int q = 0; q < D / 4; ++q) asm volatile("" : "+v"(e4[q]));
        float racc[D];
#pragma unroll
        for (int j = 0; j < D; ++j) {
            float a0 = 0.f, a1 = 0.f;
            { const v32f r = unpack_lo(buf[j]);
#pragma unroll
              for (int i = 0; i < 32; i += 2) { a0 = fmaf(r[i], hv[i], a0); a1 = fmaf(r[i + 1], hv[i + 1], a1); } }
            { const v32f r = unpack_hi(buf[j]);
#pragma unroll
              for (int i = 0; i < 32; i += 2) { a0 = fmaf(r[i], hv[32 + i], a0); a1 = fmaf(r[i + 1], hv[33 + i], a1); } }
            racc[j] = a0 + a1; asm volatile("" : "+v"(racc[j]) :: "memory");
            SBAR();
            issue_part<D>(buf[j], tab, e4[j >> 2][j & 3], gl);
            SBAR();
        }
        static_assert(D == 4 || D == 8, "the butterfly below is written for blocks of 4 or 8 steps");
        if constexpr (D == 8) { const bool up_ = (gl & 4) != 0;
#pragma unroll
          for (int i = 0; i < 4; ++i) { const float keep = up_ ? racc[i + 4] : racc[i], send = up_ ? racc[i] : racc[i + 4]; racc[i] = keep + xor_lane<4>(send); } }
        { const bool up_ = (gl & 2) != 0;
#pragma unroll
          for (int i = 0; i < 2; ++i) { const float keep = up_ ? racc[i + 2] : racc[i], send = up_ ? racc[i] : racc[i + 2]; racc[i] = keep + xor_lane<2>(send); } }
        { const bool up_ = (gl & 1) != 0; const float keep = up_ ? racc[1] : racc[0], send = up_ ? racc[0] : racc[1]; racc[0] = keep + xor_lane<1>(send); }
        float r = racc[0];
        if constexpr (D == 4) r += xor_lane<4>(r);
        r += xor_lane<8>(r);
        if (gl < D) awg[part * 512 + k0 + gl] = r;
    }
}
template <int D> __device__ __forceinline__ void sweep_v(const unsigned char* tab, const LAS unsigned* entg, const LAS float* awg, int gl, int part, float (&po)[P8_ST]) {
    static_assert(128 % D == 0 && D % 4 == 0 && D <= 16, "block size");
    v4u buf[D][P8_CH];
    tab += (size_t)part * ((size_t)NEXP * P8_PB);
    { v4u e4[D / 4];
#pragma unroll
      for (int q = 0; q < D / 4; ++q) e4[q] = *(const LAS v4u*)(entg + 4 * q);
#pragma unroll
      for (int j = 0; j < D; ++j) issue_part<D>(buf[j], tab, e4[j >> 2][j & 3], gl); }
    SBAR();
#pragma unroll 1
    for (int k0 = 0; k0 < 128; k0 += D) {
        v4u e4[D / 4]; f32x4 w4[D / 4]; const int kb = (k0 + D < 128) ? k0 + D : 128 - D;
#pragma unroll
        for (int q = 0; q < D / 4; ++q) { e4[q] = *(const LAS v4u*)(entg + kb + 4 * q); w4[q] = *(const LAS f32x4*)(awg + k0 + 4 * q); }
#pragma unroll
        for (int q = 0; q < D / 4; ++q) asm volatile("" : "+v"(e4[q]), "+v"(w4[q]));
#pragma unroll
        for (int j = 0; j < D; ++j) {
            const float wk = w4[j >> 2][j & 3];
            { const v32f r = unpack_lo(buf[j]);
#pragma unroll
              for (int i = 0; i < 32; ++i) po[i] = fmaf(wk, r[i], po[i]);
              PIN16(po, 0); PIN16(po, 16); }
            { const v32f r = unpack_hi(buf[j]);
#pragma unroll
              for (int i = 0; i < 32; ++i) po[32 + i] = fmaf(wk, r[i], po[32 + i]);
              PIN16(po, 32); PIN16(po, 48); }
            SBAR();
            issue_part<D>(buf[j], tab, e4[j >> 2][j & 3], gl);
            SBAR();
        }
    }
}
__device__ __forceinline__ void p8_expert(Frame& F, const XcdBarrier& bar) {
    const Lane Ls = lane_state();
    const unsigned char* U8 = F.ws + WS_U; const unsigned char* V8 = F.ws + WS_V; const float* esc = (const float*)(F.ws + WS_ESC);
    const float* part = (const float*)(F.ws + WS_PART); const int* tki = (const int*)(F.ws + WS_TKI); const float* tkg = (const float*)(F.ws + WS_TKG);
    bf16* X1b = (bf16*)(F.ws + WS_X1B);
    LAS unsigned* key = (LAS unsigned*)(F.lds + RING_OFF + Ls.wave * 16384); LAS unsigned* ent = key + 512; LAS float* gsv = (LAS float*)(ent + 512); LAS float* sus = gsv + 512; LAS float* aw = sus + 512;
    const int vw0 = ((int)(blockIdx.x & 7) * (F.G >> 3) + (int)(blockIdx.x >> 3)) * NWAVES + Ls.wave;
    for (int run_ = 0; run_ < (P8_PROBE == 7 ? 2 : 1); ++run_)
    for (int v = (F.G & 7) ? Ls.gw : vw0; v < T / 4; v += F.NGW) {
        const bool live_ = !(P8_PROBE == 7 && run_ == 0);
        unsigned zz = 0u; asm volatile("" : "+s"(zz));
        int lane = (int)__builtin_amdgcn_mbcnt_hi(~0u, __builtin_amdgcn_mbcnt_lo(~0u, zz)); asm volatile("" : "+v"(lane));
        const int sg = lane >> 4, gl = lane & 15, tok = 4 * v + sg;
        LAS unsigned* keyg = key + sg * 128; LAS unsigned* entg = ent + sg * 128; LAS float* gsvg = gsv + sg * 128; LAS float* susg = sus + sg * 128; LAS float* awg = aw + sg * 128;
        for (int rp_ = 0; rp_ < (P8_PROBE == 3 ? 2 : 1); ++rp_)
        { unsigned mk[8]; float mg[8];
          for (int ra_ = 0; ra_ < (P8_PROBE == 8 ? 2 : 1); ++ra_) {
#pragma unroll
          for (int q = 0; q < 8; ++q) { const int j = gl + 16 * q; const int e = tki[(size_t)tok * 128 + j]; mg[q] = tkg[(size_t)tok * 128 + j]; mk[q] = ((unsigned)e << 7) | (unsigned)j; keyg[j] = mk[q]; }
          asm volatile("s_waitcnt lgkmcnt(0)" ::: "memory"); }
          int rk[8];
          for (int rb_ = 0; rb_ < (P8_PROBE == 9 ? 2 : 1); ++rb_) {
#pragma unroll
          for (int q = 0; q < 8; ++q) rk[q] = 0;
#pragma unroll 4
          for (int jj = 0; jj < 32; ++jj) { const v4u kk = *(const LAS v4u*)(keyg + 4 * jj);
#pragma unroll
              for (int c = 0; c < 4; ++c)
#pragma unroll
                  for (int q = 0; q < 8; ++q) rk[q] += (kk[c] < mk[q]) ? 1 : 0; } }
          for (int rc_ = 0; rc_ < (P8_PROBE == 10 ? 2 : 1); ++rc_)
#pragma unroll
          for (int q = 0; q < 8; ++q) { const int e = (int)(mk[q] >> 7); entg[rk[q]] = (unsigned)e; gsvg[rk[q]] = mg[q] * esc[NEXP + e]; susg[rk[q]] = esc[e]; }
          asm volatile("s_waitcnt lgkmcnt(0)" ::: "memory"); }
        float rstd;
        { float ps = part[(size_t)tok * 32 + gl] + part[(size_t)tok * 32 + 16 + gl];
          ps += xor_lane<1>(ps); ps += xor_lane<2>(ps); ps += xor_lane<4>(ps); ps += xor_lane<8>(ps);
          rstd = rsqrtf(ps * (1.f / DM) + EPS); }
#if P8_PROBE
        {
            float hv[P8_ST];
#pragma unroll
            for (int q = 0; q < P8_ST; ++q) { hv[q] = rstd; }
            if (P8_PROBE == 2) { for (int q = 0; q < 8; ++q) keyg[gl + 16 * q] = (unsigned)((gl + 16 * q) * 128 + 5 * sg); asm volatile("s_waitcnt lgkmcnt(0)" ::: "memory"); }
            sweep_u<P8_DU>(V8, P8_PROBE == 2 ? keyg : entg, awg, gl, P8_NP - 1, hv);
            asm volatile("s_waitcnt lgkmcnt(0)" ::: "memory");
        }
#endif
#pragma unroll
        for (int pt = 0; pt < P8_NP; ++pt) {
            float hv[P8_ST];
            { int tok2 = tok, gl2 = gl; asm volatile("" : "+v"(tok2), "+v"(gl2)); const bf16* xr = X1b + (size_t)tok2 * DM + 128 * pt + 8 * gl2; const float* gp = F.g_ffn + 128 * pt + 8 * gl2;
#pragma unroll
              for (int j = 0; j < 8; ++j) { const v4u a = *(const v4u*)(xr + 256 * j); const f32x4 g0 = *(const f32x4*)(gp + 256 * j), g1 = *(const f32x4*)(gp + 256 * j + 4);
                  hv[4 * j + 0] = bflo(a[0]) * rstd * g0[0]; hv[4 * j + 1] = bfhi(a[0]) * rstd * g0[1]; hv[4 * j + 2] = bflo(a[1]) * rstd * g0[2]; hv[4 * j + 3] = bfhi(a[1]) * rstd * g0[3];
                  hv[32 + 4 * j + 0] = bflo(a[2]) * rstd * g1[0]; hv[32 + 4 * j + 1] = bfhi(a[2]) * rstd * g1[1]; hv[32 + 4 * j + 2] = bflo(a[3]) * rstd * g1[2]; hv[32 + 4 * j + 3] = bfhi(a[3]) * rstd * g1[3];
                  if (j == 3) { PIN16(hv, 0); PIN16(hv, 32); } if (j == 7) { PIN16(hv, 16); PIN16(hv, 48); } } }
            sweep_u<P8_DU>(U8, entg, awg, gl, pt, hv);
            asm volatile("s_waitcnt lgkmcnt(0)" ::: "memory");
        }
#pragma unroll
        for (int q = 0; q < 8; ++q) { const int j = gl + 16 * q; const float x = (awg[j] + awg[512 + j]) * susg[j]; awg[j] = gsvg[j] * gelu_erf(x); }
        asm volatile("s_waitcnt lgkmcnt(0)" ::: "memory");
#if P8_SYNCV
        if (F.NGW == T / 4) { XcdBarrier b_ = bar; asm volatile("" : "+s"(b_.bar)); xcd_barrier(b_); }
#endif
        float s2 = 0.f;
#if P8_PROBE == 6
        {   float hv[P8_ST];
#pragma unroll
            for (int q = 0; q < P8_ST; ++q) { hv[q] = rstd; }
            sweep_u<P8_DU>(U8, entg, awg, gl, 1, hv);
            asm volatile("s_waitcnt lgkmcnt(0)" ::: "memory"); }
#endif
#if P8_PROBE == 5
        {   float po[P8_ST];
#pragma unroll
            for (int q = 0; q < P8_ST; ++q) po[q] = 0.f;
            sweep_v<P8_DV>(U8, entg, awg, gl, 0, po);
            float t = 0.f;
#pragma unroll
            for (int q = 0; q < P8_ST; ++q) t += po[q];
            asm volatile("" :: "v"(t)); }
#endif
#pragma unroll
        for (int pt = 0; pt < P8_NP; ++pt) {
            float po[P8_ST];
#pragma unroll
            for (int q = 0; q < P8_ST; ++q) po[q] = 0.f;
            sweep_v<P8_DV>(V8, entg, awg, gl, pt, po);
            { int tok2 = tok, gl2 = gl; asm volatile("" : "+v"(tok2), "+v"(gl2)); bf16* xb = X1b + (size_t)tok2 * DM + 128 * pt + 8 * gl2;
              v4u a[8];
#pragma unroll
              for (int j = 0; j < 8; ++j) a[j] = *(const v4u*)(xb + 256 * j);
#pragma unroll
              for (int j = 0; j < 8; ++j) { v4u o4;
#pragma unroll
                  for (int g = 0; g < 2; ++g) { const unsigned w0 = a[j][2 * g], w1 = a[j][2 * g + 1]; f32x4 o;
                      o[0] = bflo(w0) + po[32 * g + 4 * j + 0]; o[1] = bfhi(w0) + po[32 * g + 4 * j + 1]; o[2] = bflo(w1) + po[32 * g + 4 * j + 2]; o[3] = bfhi(w1) + po[32 * g + 4 * j + 3];
#pragma unroll
                      for (int e = 0; e < 4; ++e) s2 = fmaf(o[e], o[e], s2);
                      o4[2 * g] = cvtpk(o[0], o[1]); o4[2 * g + 1] = cvtpk(o[2], o[3]); }
                  if (live_) *(v4u*)(xb + 256 * j) = o4; }
              asm volatile("" : "+v"(s2) :: "memory"); }
        }
        { s2 += xor_lane<1>(s2); s2 += xor_lane<2>(s2); s2 += xor_lane<4>(s2); s2 += xor_lane<8>(s2);
          for (int rp_ = 0; rp_ < (P8_PROBE == 4 ? 2 : 1) && live_; ++rp_) {
          const float r2 = rsqrtf(s2 * (1.f / DM) + EPS);
          int tok2 = tok, gl2 = gl; asm volatile("" : "+v"(tok2), "+v"(gl2)); float* xr = F.out + (size_t)tok2 * DM + 4 * gl2; const float* gf = F.g_fin + 4 * gl2; const bf16* xb = X1b + (size_t)tok2 * DM + 4 * gl2;
          asm volatile("s_waitcnt vmcnt(0)" ::: "memory");
#pragma unroll
          for (int i0 = 0; i0 < 32; i0 += 8) { v2u a[8];
#pragma unroll
              for (int u = 0; u < 8; ++u) a[u] = *(const v2u*)(xb + 64 * (i0 + u));
#pragma unroll
              for (int u = 0; u < 8; ++u) { const f32x4 g = *(const f32x4*)(gf + 64 * (i0 + u)); const f32x4 v = {bflo(a[u][0]), bfhi(a[u][0]), bflo(a[u][1]), bfhi(a[u][1])};
                  *(f32x4*)(xr + 64 * (i0 + u)) = v * r2 * g; }
              asm volatile("" ::: "memory"); } } }
    }
}

constexpr int N_PHASES = 9;
struct Args { const float* in[14]; float* out; unsigned char* ws; int ph_lo, ph_hi; };
__global__ void __launch_bounds__(NWAVES * 64, 2) fwd_kernel(Args args) {
    extern __shared__ __attribute__((aligned(16))) unsigned char lds[];
    Frame F;
    F.lds = (LAS unsigned char*)lds; F.ldsg = (char*)lds;
    F.G = gridDim.x; F.NGW = F.G * NWAVES;
    F.x = args.in[0]; F.rel_bias = args.in[1]; F.g_mix = args.in[2]; F.w_in = args.in[3]; F.sink_a = args.in[4]; F.w_oa = args.in[5]; F.w_ob = args.in[6]; F.w_out = args.in[7];
    F.g_ffn = args.in[8]; F.w_pq = args.in[9]; F.keys = args.in[10]; F.eu = args.in[11]; F.ev = args.in[12]; F.g_fin = args.in[13];
    F.out = args.out; F.ws = args.ws;
    volatile LAS unsigned* MISC = (volatile LAS unsigned*)(F.lds + MISC_OFF);
    for (int u = threadIdx.x; u < (LDS_BYTES - LDSCTL_OFF) / 4; u += NWAVES * 64) ((LAS unsigned*)(F.lds + LDSCTL_OFF))[u] = 0u;
    __syncthreads();
    const int lo = args.ph_lo, hi = args.ph_hi;
    const bool multi = !MK_SPLIT || (hi - lo) > 1;
    XcdBarrier bar; bar.bar = (unsigned*)(F.ws + WS_CTL) + CW_BAR; bar.x = 0; bar.st = nullptr;
    if (multi) bar = xcd_barrier_post((unsigned*)(F.ws + WS_CTL) + CW_BAR, MISC + 8);
#ifndef PH_OFF
#define PH_OFF 0
#endif
#if MK_SPLIT
#define IN(k) (lo <= (k) && (k) < hi && !((PH_OFF >> (k)) & 1))
#else
#define IN(k) (!((PH_OFF >> (k)) & 1))
#endif
#define GRID_BAR() do { XcdBarrier b_ = bar; asm volatile("" : "+s"(b_.bar)); xcd_barrier(b_); } while (0)
#define SEAM(k) do { if (IN(k) && IN((k) + 1)) GRID_BAR(); } while (0)
#ifndef PH_REP
#define PH_REP 0
#endif
#define NREP(k) (IN(k) ? 1 + ((PH_REP >> (k)) & 1) : 0)
#define REPEAT(k) _Pragma("unroll") for (int r_ = 0; r_ < NREP(k); ++r_)
#define REBAR() do { if (r_) GRID_BAR(); } while (0)
    bf16* WinT = (bf16*)(F.ws + WS_WIN); bf16* WoaT = (bf16*)(F.ws + WS_WOA); bf16* WobT = (bf16*)(F.ws + WS_WOB); bf16* WoutT = (bf16*)(F.ws + WS_WOUT); bf16* W2T = (bf16*)(F.ws + WS_W2);
    bf16* proj = (bf16*)(F.ws + WS_PROJ); bf16* Hb = (bf16*)(F.ws + WS_H); bf16* mrg = (bf16*)(F.ws + WS_MRG);
    bf16* attA = (bf16*)(F.ws + WS_ATTA); bf16* attB = (bf16*)(F.ws + WS_ATTB); bf16* x1b = (bf16*)(F.ws + WS_X1B);
    float* part = (float*)(F.ws + WS_PART); float* scores = (float*)(F.ws + WS_SC);

    REPEAT(0) { REBAR(); p0_prologue(F); } SEAM(0);
    REPEAT(1) { REBAR();
        pg8::Gemm g{Hb, WinT, T, INW, DM / 2}; pg8::StaticOrder S; S.init(T, INW, F.G, (int)blockIdx.x);
        pg8::EpiProj E{proj, T, C_GA / 256, 1.f / W_SCALE};
        pg8::gemm_phase<pg8::EpiProj, pg8::StaticOrder, true, true, true>(F.lds + RING_OFF, g, S, E);
    } SEAM(1);
    REPEAT(2) { REBAR(); p2_attention(F); } SEAM(2);
    for (int r34 = 0; r34 < 1 + ((PH_REP >> 3) & 1); ++r34) {
    if (r34) GRID_BAR();
    if (IN(3)) {
        p3_combine(F);
        pg8::Gemm g{attA, WoaT, T, DM, AQW / 2}; pg8::StaticOrder S; S.init(T, DM, F.G, (int)blockIdx.x);
        pg8::EpiGate<false> E{proj + (size_t)(C_GA / 128) * T * 128, T, mrg, DM, 1.f / (A_SCALE * W_SCALE)};
        pg8::gemm_phase<pg8::EpiGate<false>, pg8::StaticOrder, false, true, true>(F.lds + RING_OFF, g, S, E);
    } SEAM(3);
    if (IN(4)) {
        pg8::Gemm g{attB, WobT, T, DM, BOW / 2}; pg8::StaticOrder S; S.init(T, DM, F.G, (int)blockIdx.x);
        pg8::EpiGateF8 E{proj + (size_t)(C_GB / 128) * T * 128, T, mrg, DM, F.ws + WS_MRG8, DM, M_SCALE, 1.f / (A_SCALE * W_SCALE)};
        pg8::gemm_phase<pg8::EpiGateF8, pg8::StaticOrder, false, true, true>(F.lds + RING_OFF, g, S, E);
    }
    }
    SEAM(4);
    REPEAT(5) { REBAR();
        pg8::Gemm g{(const bf16*)(F.ws + WS_MRG8), WoutT, T, DM, DM / 2}; pg8::StaticOrder S; S.init(T, DM, F.G, (int)blockIdx.x);
        pg8::EpiResid E{F.x, x1b, part, DM, 1.f / (M_SCALE * W_SCALE)};
        pg8::gemm_phase<pg8::EpiResid, pg8::StaticOrder, false, true, true>(F.lds + RING_OFF, g, S, E);
    } SEAM(5);
    const bool tab_first = ((blockIdx.x >> 3) & 1) == 0;
    if (IN(6) && tab_first) p6_tables(F);
    REPEAT(6) { REBAR();
        pg8::Gemm g{x1b, W2T, T, DM, DM}; pg8::StaticOrder S; S.init(T, DM, F.G, (int)blockIdx.x);
        LAS float* rs = (LAS float*)(F.lds + RSTD_OFF);
        const Lane Ls = lane_state();
        pg8::Unit u0; if (S.next(0, u0) && Ls.tid < 256) { const f32x4* pp = (const f32x4*)(part + (size_t)(u0.pm * 256 + Ls.tid) * 32); float s = 0.f;
#pragma unroll
            for (int i = 0; i < 8; ++i) { const f32x4 v = pp[i]; s += (v[0] + v[1]) + (v[2] + v[3]); }
            rs[Ls.tid] = rsqrtf(s * (1.f / DM) + EPS); }
        __syncthreads();
        pg8::EpiTopk E{rs, (int*)(F.ws + WS_TKI), (float*)(F.ws + WS_TKG), PHEADS, scores, DM};
        pg8::gemm_phase<pg8::EpiTopk, pg8::StaticOrder, false, true>(F.lds + RING_OFF, g, S, E);
    }
    if (IN(6) && !tab_first) p6_tables(F);
    if (IN(6) && IN(8)) GRID_BAR();
    if (IN(8)) { p8_expert(F, bar); }
#undef IN
#undef SEAM
}

extern "C" void kernel_launch(void* const* d_in, const int* in_sizes, int n_in, void* d_out, int out_size, void* d_ws, size_t ws_size, hipStream_t stream) {
    static int grid = 0;
    if (grid == 0) {
        if (n_in != 14 || in_sizes[0] != T * DM || out_size != T * DM || ws_size < WS_END) {
            fprintf(stderr, "kernel_launch: unexpected shapes: n_in %d in0 %d out %d ws %zu (need >= %zu); nothing launched\n", n_in, n_in > 0 ? in_sizes[0] : -1, out_size, ws_size, (size_t)WS_END); grid = -1; return; }
        int dev = 0, cus = 0, per_cu = 0;
        if (hipGetDevice(&dev) != hipSuccess || hipDeviceGetAttribute(&cus, hipDeviceAttributeMultiprocessorCount, dev) != hipSuccess) { grid = -1; return; }
        if (hipFuncSetAttribute((const void*)fwd_kernel, hipFuncAttributeMaxDynamicSharedMemorySize, LDS_BYTES) != hipSuccess) { fprintf(stderr, "kernel_launch: hipFuncSetAttribute failed\n"); grid = -1; return; }
        if (hipOccupancyMaxActiveBlocksPerMultiprocessor(&per_cu, (const void*)fwd_kernel, NWAVES * 64, LDS_BYTES) != hipSuccess || per_cu < 1)
            fprintf(stderr, "kernel_launch: note: occupancy query reports %d workgroups per CU\n", per_cu);
        (void)hipGetLastError();
        grid = cus;
        if (grid != 256) fprintf(stderr, "kernel_launch: note: %d CUs (built for 256)\n", grid);
    }
    if (grid < 0) return;
    (void)hipMemsetAsync((char*)d_ws + WS_CTL, 0, CTL_ZERO_BYTES, stream);
    Args a{};
    for (int i = 0; i < 14; ++i) a.in[i] = (const float*)d_in[i];
    a.out = (float*)d_out; a.ws = (unsigned char*)d_ws;
#if MK_SPLIT
    for (int p = 0; p < N_PHASES; ++p) { a.ph_lo = p; a.ph_hi = p + 1; hipLaunchKernelGGL(fwd_kernel, dim3(grid), dim3(NWAVES * 64), LDS_BYTES, stream, a); }
#else
    a.ph_lo = 0; a.ph_hi = N_PHASES; hipLaunchKernelGGL(fwd_kernel, dim3(grid), dim3(NWAVES * 64), LDS_BYTES, stream, a);
#endif
    const hipError_t le = hipPeekAtLastError();
    if (le != hipSuccess) fprintf(stderr, "kernel_launch: launch failed: %s\n", hipGetErrorName(le));
}
```

```cpp
#include <hip/hip_runtime.h>
#include <cstdio>
#include <cstdint>
namespace pg8 {
#define PG8_LAS __attribute__((address_space(3)))
typedef unsigned short bf16_t;
typedef short bf16x8 __attribute__((ext_vector_type(8)));
typedef float f32x4 __attribute__((ext_vector_type(4)));
typedef unsigned u32x4 __attribute__((ext_vector_type(4)));
typedef int v4i_t __attribute__((ext_vector_type(4)));
typedef int v8i_t __attribute__((ext_vector_type(8)));
constexpr int BM = 256, BK = 64, HALF = 128, HTB = HALF * BK * 2  , STAGE_BYTES = 8 * HTB, NXCD = 8, WGM = 8;

__host__ __device__ __forceinline__ int lds_byte(int r, int c) { const int st = (r >> 4) * 2 + (c >> 5), rr = r & 15, cc = c & 31, ob = rr * 64 + cc * 2; return st * 1024 + (ob ^ (((ob >> 9) & 1) << 5)); }
__host__ __device__ __forceinline__ void stage_rc(int b, int& R, int& C) { const int st = b / 1024, sb = b % 1024, swz = sb ^ (((sb >> 9) & 1) << 5); R = (st >> 1) * 16 + swz / 64; C = (st & 1) * 32 + (swz % 64) / 2; }
__host__ __device__ __forceinline__ int perm32(int rho) { const int n = rho >> 4, i = rho & 15; return 8 * (i >> 2) + 4 * n + (i & 3); }

struct Unit { int pm, pn; };
struct Gemm { const bf16_t* A; const bf16_t* Bt; int M, N, K; };

struct StaticOrder {
    int nM, nN, nwg, G, c;
    __host__ __device__ void init(int M, int N, int G_, int c_) { nM = M / BM; nN = N / BM; nwg = nM * nN; G = G_; c = c_; }
    __host__ __device__ bool next(int i, Unit& u) const {
        const long L = (long)i * G + c; if (L >= nwg) return false;
        int wgid = (int)L; { const int q = nwg / NXCD, r = nwg % NXCD, xcd = wgid % NXCD, off = wgid / NXCD; wgid = (xcd < r ? xcd * (q + 1) : r * (q + 1) + (xcd - r) * q) + off; }
        const int nig = WGM * nN, gid = wgid / nig, fm = gid * WGM, gsz = (nM - fm) < WGM ? (nM - fm) : WGM;
        u.pm = fm + ((wgid % nig) % gsz); u.pn = (wgid % nig) / gsz; return true;
    }
    __device__ __forceinline__ void a_ready(const Unit&) const {}
    __device__ __forceinline__ void done(const Unit&) const {}
};

typedef unsigned u32x2 __attribute__((ext_vector_type(2)));
__device__ __forceinline__ unsigned cvt_pk_bf16(float lo, float hi) { unsigned r; asm volatile("v_cvt_pk_bf16_f32 %0, %1, %2" : "=v"(r) : "v"(lo), "v"(hi)); return r; }
__device__ __forceinline__ float sigm(float v) { return __builtin_amdgcn_rcpf(1.0f + __builtin_amdgcn_exp2f(-1.4426950408889634f * v)); }
__device__ __forceinline__ float bflo(unsigned w) { return __builtin_bit_cast(float, w << 16); }
__device__ __forceinline__ float bfhi(unsigned w) { return __builtin_bit_cast(float, w & 0xffff0000u); }

struct EpiProj {
    static constexpr bool PERM = true, AFTER_DRAIN = false;
    bf16_t* O; int ldc; int gate_pn; float osc;
    __device__ __forceinline__ void operator()(const f32x4 (&acc)[2][2][4][2], const Unit& u, int wr, int wc, int fr_, int fq_) const {
        (void)fr_; (void)fq_; int ln_ = (int)__builtin_amdgcn_mbcnt_hi(~0u, __builtin_amdgcn_mbcnt_lo(~0u, 0u)); asm volatile("" : "+v"(ln_));
        const int fr = ln_ & 15, fq = ln_ >> 4;
        const int row0 = u.pm * BM + wr * 64 + fr, col0 = u.pn * BM + wc * 32 + 8 * fq; const bool gate = u.pn >= gate_pn;
#pragma unroll
        for (int ai = 0; ai < 2; ++ai)
#pragma unroll
            for (int m = 0; m < 4; ++m) { bf16_t* rowp = O + ((size_t)(2 * u.pn) * ldc + (row0 + ai * HALF + m * 16)) * 128 + wc * 32 + 8 * fq;
#pragma unroll
                for (int bj = 0; bj < 2; ++bj) { f32x4 v0 = acc[ai][bj][m][0] * osc, v1 = acc[ai][bj][m][1] * osc;
                    if (gate) {
#pragma unroll
                        for (int j = 0; j < 4; ++j) { v0[j] = sigm(v0[j]); v1[j] = sigm(v1[j]); } }
                    u32x4 w; w.x = cvt_pk_bf16(v0[0], v0[1]); w.y = cvt_pk_bf16(v0[2], v0[3]); w.z = cvt_pk_bf16(v1[0], v1[1]); w.w = cvt_pk_bf16(v1[2], v1[3]);
                    *(u32x4*)(rowp + (size_t)bj * ldc * 128) = w; } }
    }
};
template <bool ACCUM> struct EpiGate {
    static constexpr bool PERM = true, AFTER_DRAIN = false;
    const bf16_t* G; int ldg; bf16_t* O; int ldc; float osc;
    __device__ __forceinline__ void operator()(const f32x4 (&acc)[2][2][4][2], const Unit& u, int wr, int wc, int fr_, int fq_) const {
        (void)fr_; (void)fq_; int ln_ = (int)__builtin_amdgcn_mbcnt_hi(~0u, __builtin_amdgcn_mbcnt_lo(~0u, 0u)); asm volatile("" : "+v"(ln_));
        const int fr = ln_ & 15, fq = ln_ >> 4;
        const int row0 = u.pm * BM + wr * 64 + fr, col0 = u.pn * BM + wc * 32 + 8 * fq;
#pragma unroll
        for (int ai = 0; ai < 2; ++ai)
#pragma unroll
            for (int m = 0; m < 4; ++m) { const int row = row0 + ai * HALF + m * 16; const bf16_t* gp = G + ((size_t)(2 * u.pn) * ldg + row) * 128 + wc * 32 + 8 * fq; bf16_t* op = O + (size_t)row * ldc + col0;
#pragma unroll
                for (int bj = 0; bj < 2; ++bj) { const u32x4 gw = *(const u32x4*)(gp + (size_t)bj * ldg * 128);
                    f32x4 v0 = acc[ai][bj][m][0] * osc, v1 = acc[ai][bj][m][1] * osc;
                    v0[0] *= bflo(gw.x); v0[1] *= bfhi(gw.x); v0[2] *= bflo(gw.y); v0[3] *= bfhi(gw.y);
                    v1[0] *= bflo(gw.z); v1[1] *= bfhi(gw.z); v1[2] *= bflo(gw.w); v1[3] *= bfhi(gw.w);
                    if (ACCUM) { const u32x4 mw = *(const u32x4*)(op + bj * HALF);
                        v0[0] += bflo(mw.x); v0[1] += bfhi(mw.x); v0[2] += bflo(mw.y); v0[3] += bfhi(mw.y);
                        v1[0] += bflo(mw.z); v1[1] += bfhi(mw.z); v1[2] += bflo(mw.w); v1[3] += bfhi(mw.w); }
                    u32x4 w; w.x = cvt_pk_bf16(v0[0], v0[1]); w.y = cvt_pk_bf16(v0[2], v0[3]); w.z = cvt_pk_bf16(v1[0], v1[1]); w.w = cvt_pk_bf16(v1[2], v1[3]);
                    *(u32x4*)(op + bj * HALF) = w; } }
    }
};
__device__ __forceinline__ unsigned pk4_fp8e(float a, float b, float c, float d) { int p = __builtin_amdgcn_cvt_pk_fp8_f32(fminf(fmaxf(a, -448.f), 448.f), fminf(fmaxf(b, -448.f), 448.f), 0, false);
    return (unsigned)__builtin_amdgcn_cvt_pk_fp8_f32(fminf(fmaxf(c, -448.f), 448.f), fminf(fmaxf(d, -448.f), 448.f), p, true); }
struct EpiGateF8 {
    static constexpr bool PERM = true, AFTER_DRAIN = false;
    const bf16_t* G; int ldg; const bf16_t* M1; int ldm; unsigned char* O8; int ldc; float oscale; float osc;
    __device__ __forceinline__ void operator()(const f32x4 (&acc)[2][2][4][2], const Unit& u, int wr, int wc, int fr_, int fq_) const {
        (void)fr_; (void)fq_; int ln_ = (int)__builtin_amdgcn_mbcnt_hi(~0u, __builtin_amdgcn_mbcnt_lo(~0u, 0u)); asm volatile("" : "+v"(ln_));
        const int fr = ln_ & 15, fq = ln_ >> 4;
        const int row0 = u.pm * BM + wr * 64 + fr, col0 = u.pn * BM + wc * 32 + 8 * fq;
#pragma unroll
        for (int ai = 0; ai < 2; ++ai)
#pragma unroll
            for (int m = 0; m < 4; ++m) { const int row = row0 + ai * HALF + m * 16; const bf16_t* gp = G + ((size_t)(2 * u.pn) * ldg + row) * 128 + wc * 32 + 8 * fq; const bf16_t* mp = M1 + (size_t)row * ldm + col0; unsigned char* op = O8 + (size_t)row * ldc + col0;
#pragma unroll
                for (int bj = 0; bj < 2; ++bj) { const u32x4 gw = *(const u32x4*)(gp + (size_t)bj * ldg * 128), mw = *(const u32x4*)(mp + bj * HALF);
                    f32x4 v0 = acc[ai][bj][m][0] * osc, v1 = acc[ai][bj][m][1] * osc;
                    v0[0] = (v0[0] * bflo(gw.x) + bflo(mw.x)) * oscale; v0[1] = (v0[1] * bfhi(gw.x) + bfhi(mw.x)) * oscale; v0[2] = (v0[2] * bflo(gw.y) + bflo(mw.y)) * oscale; v0[3] = (v0[3] * bfhi(gw.y) + bfhi(mw.y)) * oscale;
                    v1[0] = (v1[0] * bflo(gw.z) + bflo(mw.z)) * oscale; v1[1] = (v1[1] * bfhi(gw.z) + bfhi(mw.z)) * oscale; v1[2] = (v1[2] * bflo(gw.w) + bflo(mw.w)) * oscale; v1[3] = (v1[3] * bfhi(gw.w) + bfhi(mw.w)) * oscale;
                    u32x2 w; w.x = pk4_fp8e(v0[0], v0[1], v0[2], v0[3]); w.y = pk4_fp8e(v1[0], v1[1], v1[2], v1[3]);
                    *(u32x2*)(op + bj * HALF) = w; } }
    }
};

struct EpiResid {
    static constexpr bool PERM = false, AFTER_DRAIN = false;
    const float* X; bf16_t* X1b; float* part; int ld; float osc;
    __device__ __forceinline__ void operator()(const f32x4 (&acc)[2][2][4][2], const Unit& u, int wr, int wc, int fr_, int fq_) const {
        (void)fr_; (void)fq_; int ln_ = (int)__builtin_amdgcn_mbcnt_hi(~0u, __builtin_amdgcn_mbcnt_lo(~0u, 0u)); asm volatile("" : "+v"(ln_));
        const int fr = ln_ & 15, fq = ln_ >> 4;
        const int row0 = u.pm * BM + wr * 64 + fr, col0 = u.pn * BM + wc * 32 + 4 * fq;
#pragma unroll
        for (int ai = 0; ai < 2; ++ai)
#pragma unroll
            for (int m = 0; m < 4; ++m) { const int row = row0 + ai * HALF + m * 16; float ss = 0.f;
#pragma unroll
                for (int bj = 0; bj < 2; ++bj)
#pragma unroll
                    for (int n = 0; n < 2; ++n) { const size_t off = (size_t)row * ld + col0 + bj * HALF + n * 16;
                        const f32x4 x = *(const f32x4*)(X + off); const f32x4 v = x + acc[ai][bj][m][n] * osc;
                        u32x2 w; w.x = cvt_pk_bf16(v[0], v[1]); w.y = cvt_pk_bf16(v[2], v[3]); *(u32x2*)(X1b + off) = w;
                        ss += (v[0] * v[0] + v[1] * v[1]) + (v[2] * v[2] + v[3] * v[3]); }
                ss += __shfl_xor(ss, 16); ss += __shfl_xor(ss, 32);
                if (fq == 0) part[(size_t)row * 32 + u.pn * 4 + wc] = ss; }
    }
};
__device__ __forceinline__ int tk_enc(float s) { const int b = __builtin_bit_cast(int, s); return b ^ ((b >> 31) & 0x7fffffff); }
__device__ __forceinline__ float tk_dec(int k) { return __builtin_bit_cast(float, k ^ ((k >> 31) & 0x7fffffff)); }
#define TK_INS16(Lst, X) do { int x_ = (X); _Pragma("unroll") for (int i_ = 0; i_ < 16; ++i_) { const int h_ = Lst[i_] > x_ ? Lst[i_] : x_; x_ = Lst[i_] > x_ ? x_ : Lst[i_]; Lst[i_] = h_; } } while (0)
__device__ __forceinline__ void tk_sort16(int (&v)[16]) {
#pragma unroll
    for (int k = 2; k <= 16; k <<= 1)
#pragma unroll
        for (int j = k >> 1; j > 0; j >>= 1)
#pragma unroll
            for (int i = 0; i < 16; ++i) { const int l = i ^ j; if (l > i) { const int a = v[i], b = v[l]; const int hi = a > b ? a : b, lo = a > b ? b : a; const bool desc = (i & k) == 0; v[i] = desc ? hi : lo; v[l] = desc ? lo : hi; } }
}
__device__ __forceinline__ void tk_merge16(int (&a)[16], const int (&b)[16]) {
#pragma unroll
    for (int i = 0; i < 16; ++i) a[i] = a[i] > b[15 - i] ? a[i] : b[15 - i];
#pragma unroll
    for (int j = 8; j > 0; j >>= 1)
#pragma unroll
        for (int i = 0; i < 16; ++i) { const int l = i ^ j; if (l > i) { const int x = a[i], y = a[l]; a[i] = x > y ? x : y; a[l] = x > y ? y : x; } }
}
#define TK_BAR() do { asm volatile("s_waitcnt lgkmcnt(0)" ::: "memory"); __builtin_amdgcn_s_barrier(); asm volatile("" ::: "memory"); } while (0)
struct EpiTopk {
    static constexpr bool PERM = false, AFTER_DRAIN = true;
    const PG8_LAS float* rs; int* tki; float* tkg; int nheads; float* S; int ld;
    __device__ __forceinline__ void fused(f32x4 (&acc)[2][2][4][2], const Unit& u, int wr, int wc, int fr_, int fq_, PG8_LAS unsigned char* lds, int wid, int lane_) const {
        (void)fr_; (void)fq_; (void)lane_; int lane = (int)__builtin_amdgcn_mbcnt_hi(~0u, __builtin_amdgcn_mbcnt_lo(~0u, 0u)); asm volatile("" : "+v"(lane));
        const int fr = lane & 15, fq = lane >> 4;
        PG8_LAS float* img = (PG8_LAS float*)lds;
        PG8_LAS int* lst = (PG8_LAS int*)lds;
        PG8_LAS int* mrg = (PG8_LAS int*)(lds + 32768);
        TK_BAR();
#pragma unroll
        for (int m = 0; m < 4; ++m) { const int row = wr * 64 + m * 16 + fr; const float s = rs[row];
#pragma unroll
            for (int bj = 0; bj < 2; ++bj)
#pragma unroll
                for (int n = 0; n < 2; ++n) { const int q = bj * 32 + wc * 8 + n * 4 + fq; *(PG8_LAS f32x4*)(img + row * 256 + ((q ^ (row & 63)) << 2)) = acc[0][bj][m][n] * s; } }
        asm volatile("s_waitcnt vmcnt(0) lgkmcnt(0)" ::: "memory");
        TK_BAR();
#ifndef TK_REP
#define TK_REP 0
#endif
#pragma unroll 1
        for (int ai_ = 0; ai_ < 2 * (1 + TK_REP); ++ai_) { const int ai = ai_ & 1;
            asm volatile("" : "+v"(lane) :: "memory");
            const int tid = wid * 64 + lane;
            if (ai) { const int fr2 = lane & 15, fq2 = lane >> 4;
#pragma unroll
              for (int m = 0; m < 4; ++m) { const int row = wr * 64 + m * 16 + fr2; const float s = rs[HALF + row];
#pragma unroll
                  for (int bj = 0; bj < 2; ++bj)
#pragma unroll
                      for (int n = 0; n < 2; ++n) { const int q = bj * 32 + wc * 8 + n * 4 + fq2; *(PG8_LAS f32x4*)(img + row * 256 + ((q ^ (row & 63)) << 2)) = acc[1][bj][m][n] * s; } }
              TK_BAR(); }
            const int row = tid & 127, c = (tid >> 7) & 1, kh = tid >> 8;
            int Lk[16];
#pragma unroll 1
            for (int g = 0; g < 4; ++g) {
                int Nk[16];
#pragma unroll
                for (int i = 0; i < 4; ++i) { const int q = 32 * c + 16 * kh + 4 * g + i; const f32x4 v = *(const PG8_LAS f32x4*)(img + row * 256 + ((q ^ (row & 63)) << 2));
#pragma unroll
                    for (int e = 0; e < 4; ++e) Nk[4 * i + e] = (tk_enc(v[e]) & ~127) | (127 - (64 * kh + 16 * g + 4 * i + e)); }
                tk_sort16(Nk);
                if (g == 0) {
#pragma unroll
                    for (int i = 0; i < 16; ++i) Lk[i] = Nk[i]; }
                else tk_merge16(Lk, Nk);
            }
            TK_BAR();
            { PG8_LAS int* d = lst + ((row * 2 + c) * 2 + kh) * 16;
#pragma unroll
              for (int i = 0; i < 4; ++i) *(PG8_LAS v4i_t*)(d + 4 * i) = (v4i_t){Lk[4 * i], Lk[4 * i + 1], Lk[4 * i + 2], Lk[4 * i + 3]}; }
            TK_BAR();
            if (kh == 0) {
                const PG8_LAS int* o = lst + ((row * 2 + c) * 2 + 1) * 16; int Ok[16];
#pragma unroll
                for (int i = 0; i < 4; ++i) { const v4i_t w = *(const PG8_LAS v4i_t*)(o + 4 * i); Ok[4 * i] = w[0]; Ok[4 * i + 1] = w[1]; Ok[4 * i + 2] = w[2]; Ok[4 * i + 3] = w[3]; }
                tk_merge16(Lk, Ok);
                PG8_LAS int* d = mrg + (row * 2 + c) * 16;
#pragma unroll
                for (int i = 0; i < 4; ++i) *(PG8_LAS v4i_t*)(d + 4 * i) = (v4i_t){Lk[4 * i], Lk[4 * i + 1], Lk[4 * i + 2], Lk[4 * i + 3]};
            }
            TK_BAR();
            if (tid < 128) {
                const PG8_LAS int* A = mrg + (tid * 2 + 0) * 16; const PG8_LAS int* B = mrg + (tid * 2 + 1) * 16;
                float s0[16], s1[16];
#pragma unroll
                for (int i = 0; i < 4; ++i) { const v4i_t a = *(const PG8_LAS v4i_t*)(A + 4 * i), b = *(const PG8_LAS v4i_t*)(B + 4 * i);
#pragma unroll
                    for (int e = 0; e < 4; ++e) { s0[4 * i + e] = tk_dec(a[e] & ~127); s1[4 * i + e] = tk_dec(b[e] & ~127); } }
                int Mk[16], Ck[16];
                int cnt = 0;
#pragma unroll
                for (int i = 0; i < 16; ++i)
#pragma unroll
                    for (int j = 0; j < 16; ++j) if ((i + 1) * (j + 1) <= 16) {
                        Ck[cnt & 15] = (tk_enc(s0[i] + s1[j]) & ~255) | (i << 4) | j; ++cnt;
                        if ((cnt & 15) == 0 || cnt == 50) {
                            if (cnt == 50) {
#pragma unroll
                                for (int z = 2; z < 16; ++z) Ck[z] = (int)0x80000000; }
                            tk_sort16(Ck);
                            if (cnt == 16) {
#pragma unroll
                                for (int z = 0; z < 16; ++z) Mk[z] = Ck[z]; }
                            else tk_merge16(Mk, Ck);
                        } }
                const float smax = tk_dec(Mk[0] & ~255); float ev[16], den = 0.f;
#pragma unroll
                for (int q = 0; q < 16; ++q) { ev[q] = __expf(tk_dec(Mk[q] & ~255) - smax); den += ev[q]; }
                const float inv = 1.f / den; const size_t ob = ((size_t)(u.pm * BM + ai * HALF + tid) * nheads + u.pn) * 16;
#pragma unroll
                for (int q4 = 0; q4 < 4; ++q4) { v4i_t ei; f32x4 gv;
#pragma unroll
                    for (int e = 0; e < 4; ++e) { const int k = Mk[4 * q4 + e]; ei[e] = (127 - (A[(k >> 4) & 15] & 127)) * 128 + (127 - (B[k & 15] & 127)); gv[e] = ev[4 * q4 + e] * inv; }
                    *(v4i_t*)(tki + ob + 4 * q4) = ei; *(f32x4*)(tkg + ob + 4 * q4) = gv; }
            }
            TK_BAR();
        }
    }
};

template <class Epi, class Sched, bool ALIGN_EPI = false, bool SP2 = false, bool F8 = false>
__device__ __forceinline__ void gemm_phase(PG8_LAS unsigned char* lds, const Gemm g, const Sched& S, const Epi& E) {
    int tid_ = threadIdx.x; asm volatile("" : "+v"(tid_));
    const int tid = tid_, wid = __builtin_amdgcn_readfirstlane(tid >> 6), lane = tid & 63, wr = wid >> 2, wc = wid & 3, fr = lane & 15, fq = lane >> 4;
    const int K = g.K, nt = K / BK;
    unsigned voffA[2], voffB[2];
#pragma unroll
    for (int i = 0; i < 2; ++i) { int R, C; stage_rc(tid * 16 + i * 8192, R, C); const int Rb = Epi::PERM ? ((R & ~31) + perm32(R & 31)) : R;
        voffA[i] = (unsigned)(R * K + C) * 2u; voffB[i] = (unsigned)(Rb * K + C) * 2u; }
    const size_t kstep = (size_t)(BK * 2);
    const size_t hstep = (size_t)HALF * K * 2;
    const size_t tstep = 2 * hstep;
    const unsigned ldsw = (unsigned)__builtin_amdgcn_readfirstlane((int)((unsigned)(__SIZE_TYPE__)lds + (unsigned)wid * 1024u));
    const int aoff = lds_byte(wr * 64 + fr, fq * 8), boff = lds_byte(wc * 32 + fr, fq * 8);
#define PG8_SA(b, h) (((b) * 2 + (h)) * HTB)
#define PG8_SB(b, h) ((4 + (b) * 2 + (h)) * HTB)
#define PG8_STAGE(bufoff, gbase, voff) do { _Pragma("unroll") for (int _i = 0; _i < 2; ++_i) \
        __builtin_amdgcn_global_load_lds((const unsigned*)((const char*)(gbase) + (voff)[_i]), (PG8_LAS unsigned*)(__SIZE_TYPE__)(ldsw + (unsigned)((bufoff) + _i * 8192)), 16, 0, 0); } while (0)
    PG8_LAS unsigned char* ldsA = lds + aoff; PG8_LAS unsigned char* ldsB = lds + 4 * HTB + boff; asm volatile("" : "+v"(ldsA), "+v"(ldsB));
#define PG8_LD8(p) __builtin_shufflevector(*(const PG8_LAS v4i_t*)(p), *(const PG8_LAS v4i_t*)((p) + 1024), 0, 1, 2, 3, 4, 5, 6, 7)
#define PG8_LDA(dst, b, h) do { _Pragma("unroll") for (int m = 0; m < 4; ++m) dst[m] = PG8_LD8(ldsA + ((b) * 2 + (h)) * HTB + m * 2048); } while (0)
#define PG8_LDB(dst, b, h) do { _Pragma("unroll") for (int n = 0; n < 2; ++n) dst[n] = PG8_LD8(ldsB + ((b) * 2 + (h)) * HTB + n * 2048); } while (0)
#define PG8_H(X, k) __builtin_bit_cast(bf16x8, __builtin_shufflevector(X, X, 4 * (k), 4 * (k) + 1, 4 * (k) + 2, 4 * (k) + 3))
#define PG8_MMA(ai, bj, At, Bt) do { __builtin_amdgcn_s_setprio(1); _Pragma("unroll") for (int m = 0; m < 4; ++m) _Pragma("unroll") for (int n = 0; n < 2; ++n) { \
        if constexpr (F8) asm volatile("v_mfma_scale_f32_16x16x128_f8f6f4 %0, %1, %2, %0, %3, %3 op_sel_hi:[0,0,0]" : "+v"(acc[ai][bj][m][n]) : "v"(Bt[n]), "v"(At[m]), "v"(mxs));   \
        else { acc[ai][bj][m][n] = __builtin_amdgcn_mfma_f32_16x16x32_bf16(PG8_H(Bt[n], 0), PG8_H(At[m], 0), acc[ai][bj][m][n], 0, 0, 0); \
               acc[ai][bj][m][n] = __builtin_amdgcn_mfma_f32_16x16x32_bf16(PG8_H(Bt[n], 1), PG8_H(At[m], 1), acc[ai][bj][m][n], 0, 0, 0); } } __builtin_amdgcn_s_setprio(0); } while (0)
#define PG8_WAIT_V(n) asm volatile("s_waitcnt vmcnt(" #n ")" ::: "memory")
#define PG8_WAIT_L(n) asm volatile("s_waitcnt lgkmcnt(" #n ")" ::: "memory")
#define PG8_BAR __builtin_amdgcn_s_barrier()
#define PG8_SCHED __builtin_amdgcn_sched_barrier(0)
    Unit cur, nxt; int ui = 0;
    if (!S.next(0, cur)) return;
    f32x4 acc[2][2][4][2];
#pragma unroll
    for (int a = 0; a < 2; ++a)
#pragma unroll
        for (int b = 0; b < 2; ++b)
#pragma unroll
            for (int m = 0; m < 4; ++m)
#pragma unroll
                for (int n = 0; n < 2; ++n) acc[a][b][m][n] = (f32x4){0.f, 0.f, 0.f, 0.f};
    int mxs = 0x7f7f7f7f; asm volatile("" : "+v"(mxs));
    v8i_t At[4], B0[2], B1[2];
    const char* cA = (const char*)g.A + (size_t)cur.pm * tstep; const char* cB = (const char*)g.Bt + (size_t)cur.pn * tstep;
    S.a_ready(cur);
    if constexpr (SP2) {
        PG8_STAGE(PG8_SB(0, 0), cB, voffB); PG8_STAGE(PG8_SB(0, 1), cB + hstep, voffB); PG8_STAGE(PG8_SA(0, 0), cA, voffA); PG8_STAGE(PG8_SA(0, 1), cA + hstep, voffA);
        if (wr == 1) PG8_BAR;
        PG8_WAIT_V(2); PG8_BAR;
        PG8_STAGE(PG8_SB(1, 0), cB + kstep, voffB); PG8_STAGE(PG8_SA(1, 0), cA + kstep, voffA); PG8_STAGE(PG8_SB(1, 1), cB + hstep + kstep, voffB);
        PG8_WAIT_V(6); PG8_BAR;
    } else {
        PG8_STAGE(PG8_SB(0, 0), cB, voffB); PG8_STAGE(PG8_SA(0, 0), cA, voffA); PG8_STAGE(PG8_SB(0, 1), cB + hstep, voffB); PG8_STAGE(PG8_SA(0, 1), cA + hstep, voffA);
        if (wr == 1) PG8_BAR;
        PG8_WAIT_V(4); PG8_BAR;
        PG8_STAGE(PG8_SB(1, 0), cB + kstep, voffB); PG8_STAGE(PG8_SA(1, 0), cA + kstep, voffA); PG8_STAGE(PG8_SB(1, 1), cB + hstep + kstep, voffB);
        PG8_WAIT_V(6); PG8_BAR;
    }
    for (;;) {
        const bool has_next = S.next(ui + 1, nxt);
        const char* nA = has_next ? (const char*)g.A + (size_t)nxt.pm * tstep : cA; const char* nB = has_next ? (const char*)g.Bt + (size_t)nxt.pn * tstep : cB;
        for (int t = 0; t < nt; t += 2) {
            const bool last = (t == nt - 2);
            const char* a1 = cA + (size_t)(t + 1) * kstep;
            const char* a2 = last ? nA : cA + (size_t)(t + 2) * kstep; const char* b2 = last ? nB : cB + (size_t)(t + 2) * kstep;
            const char* a3 = a2 + kstep; const char* b3 = b2 + kstep;
            if (last && has_next) S.a_ready(nxt);
            if constexpr (SP2) {
            PG8_LDB(B0, 0, 0); PG8_LDB(B1, 0, 1); PG8_SCHED; PG8_LDA(At, 0, 0); PG8_STAGE(PG8_SA(1, 1), a1 + hstep, voffA);
            PG8_WAIT_V(8); PG8_WAIT_L(0); PG8_BAR; PG8_MMA(0, 0, At, B0); PG8_MMA(0, 1, At, B1); PG8_BAR; PG8_SCHED;
            PG8_LDA(At, 0, 1); PG8_STAGE(PG8_SB(0, 0), b2, voffB); PG8_STAGE(PG8_SB(0, 1), b2 + hstep, voffB); PG8_STAGE(PG8_SA(0, 0), a2, voffA);
            PG8_WAIT_V(8); PG8_WAIT_L(0); PG8_BAR; PG8_MMA(1, 0, At, B0); PG8_MMA(1, 1, At, B1); PG8_BAR; PG8_SCHED;
            PG8_LDB(B0, 1, 0); PG8_LDB(B1, 1, 1); PG8_SCHED; PG8_LDA(At, 1, 0); PG8_STAGE(PG8_SA(0, 1), a2 + hstep, voffA);
            PG8_WAIT_V(8); PG8_WAIT_L(0); PG8_BAR; PG8_MMA(0, 0, At, B0); PG8_MMA(0, 1, At, B1); PG8_BAR; PG8_SCHED;
            PG8_LDA(At, 1, 1); PG8_STAGE(PG8_SB(1, 0), b3, voffB); PG8_STAGE(PG8_SB(1, 1), b3 + hstep, voffB); PG8_STAGE(PG8_SA(1, 0), a3, voffA);
            PG8_WAIT_V(8); PG8_WAIT_L(0); PG8_BAR; PG8_MMA(1, 0, At, B0); PG8_MMA(1, 1, At, B1); PG8_BAR; PG8_SCHED;
            } else {
            PG8_LDB(B0, 0, 0); PG8_SCHED; PG8_LDA(At, 0, 0); PG8_STAGE(PG8_SA(1, 1), a1 + hstep, voffA);
            PG8_WAIT_L(8); PG8_BAR; PG8_WAIT_L(0); PG8_MMA(0, 0, At, B0); PG8_BAR; PG8_SCHED;
            PG8_LDB(B1, 0, 1); PG8_STAGE(PG8_SB(0, 0), b2, voffB);
            PG8_BAR; PG8_WAIT_L(0); PG8_MMA(0, 1, At, B1); PG8_BAR;
            PG8_LDA(At, 0, 1); PG8_STAGE(PG8_SA(0, 0), a2, voffA);
            PG8_BAR; PG8_WAIT_L(0); PG8_MMA(1, 0, At, B0); PG8_BAR; PG8_SCHED;
            PG8_STAGE(PG8_SB(0, 1), b2 + hstep, voffB);
            PG8_WAIT_V(6); PG8_BAR; PG8_MMA(1, 1, At, B1); PG8_BAR;
            PG8_LDB(B0, 1, 0); PG8_SCHED; PG8_LDA(At, 1, 0); PG8_STAGE(PG8_SA(0, 1), a2 + hstep, voffA);
            PG8_WAIT_L(8); PG8_BAR; PG8_WAIT_L(0); PG8_MMA(0, 0, At, B0); PG8_BAR; PG8_SCHED;
            PG8_LDB(B1, 1, 1); PG8_STAGE(PG8_SB(1, 0), b3, voffB);
            PG8_BAR; PG8_WAIT_L(0); PG8_MMA(0, 1, At, B1); PG8_BAR;
            PG8_LDA(At, 1, 1); PG8_STAGE(PG8_SA(1, 0), a3, voffA);
            PG8_BAR; PG8_WAIT_L(0); PG8_MMA(1, 0, At, B0); PG8_BAR; PG8_SCHED;
            PG8_STAGE(PG8_SB(1, 1), b3 + hstep, voffB);
            PG8_WAIT_V(6); PG8_BAR; PG8_MMA(1, 1, At, B1); PG8_BAR;
            }
        }
        if constexpr (F8) asm volatile("s_nop 15\n\ts_nop 7" ::: "memory");
        if constexpr (ALIGN_EPI) { if (wr == 0) PG8_BAR; }
        if constexpr (!Epi::AFTER_DRAIN) { E(acc, cur, wr, wc, fr, fq); S.done(cur); }
        if (!has_next) break;
#pragma unroll
        for (int a = 0; a < 2; ++a)
#pragma unroll
            for (int b = 0; b < 2; ++b)
#pragma unroll
                for (int m = 0; m < 4; ++m)
#pragma unroll
                    for (int n = 0; n < 2; ++n) acc[a][b][m][n] = (f32x4){0.f, 0.f, 0.f, 0.f};
        cur = nxt; cA = nA; cB = nB; ++ui;
        if constexpr (ALIGN_EPI) { if (wr == 1) PG8_BAR; }
    }
    PG8_WAIT_V(0);
    if constexpr (!ALIGN_EPI) { if (wr == 0) PG8_BAR; }
    PG8_BAR;
    if constexpr (Epi::AFTER_DRAIN) { E.fused(acc, cur, wr, wc, fr, fq, lds, wid, lane); S.done(cur); }
#undef PG8_SA
#undef PG8_SB
#undef PG8_STAGE
#undef PG8_LDA
#undef PG8_LDB
#undef PG8_MMA
#undef PG8_H
#undef PG8_LD8
#undef PG8_WAIT_V
#undef PG8_WAIT_L
#undef PG8_BAR
#undef PG8_SCHED
}
}
#define GAS __attribute__((address_space(1)))
#define LAS __attribute__((address_space(3)))
#define XB_TMO      128
#define XB_XCNT(j)  (256  + 64 * (j))
#define XB_XSUB(j)  (1280 + 64 * (j))
#define XB_XGEN(j)  (2304 + 64 * (j))
#define XB_TOP      3328
#define XB_TOPGEN   3392
#define XCD_BAR_WORDS 3456
#define XB_SPIN_CAP (1u << 18)

__device__ __forceinline__ unsigned xb_ld(unsigned* p)              { return __hip_atomic_load(p, __ATOMIC_RELAXED, __HIP_MEMORY_SCOPE_AGENT); }
__device__ __forceinline__ unsigned xb_add(unsigned* p, unsigned v) { return __hip_atomic_fetch_add(p, v, __ATOMIC_RELAXED, __HIP_MEMORY_SCOPE_AGENT); }
__device__ __forceinline__ unsigned xb_xcc_id() { return (unsigned)__builtin_amdgcn_s_getreg((3 << 11) | 20) & 0xFu; }
#define XB_SPIN(cond, bar) do { unsigned _sp = 0; while (cond) { __builtin_amdgcn_s_sleep(1); \
    if ((++_sp & 255u) == 0u) { if (xb_ld(&(bar)[XB_TMO])) break; if (_sp > XB_SPIN_CAP) { atomicAdd(&(bar)[XB_TMO], 1u); break; } } } } while (0)

struct XcdBarrier {
    unsigned* bar; unsigned x;
    volatile LAS unsigned* st;
};

__device__ __forceinline__ XcdBarrier xcd_barrier_post(unsigned* bar, volatile LAS unsigned* st) {
    XcdBarrier b; b.bar = bar; b.x = xb_xcc_id(); b.st = st;
    if (threadIdx.x == 0) (void)xb_add(&bar[XB_XCNT(b.x)], 1u);
    return b;
}
__device__ __forceinline__ void xcd_barrier_complete(unsigned* bar, unsigned x, unsigned& nloc, unsigned& nx) {
    const unsigned G = gridDim.x * gridDim.y * gridDim.z;
    unsigned sum, cnt, mine, sp = 0u;
    for (;;) {
        sum = 0u; cnt = 0u; mine = 0u;
#pragma unroll
        for (unsigned j = 0; j < 16; ++j) { const unsigned c = xb_ld(&bar[XB_XCNT(j)]); sum += c; cnt += (c > 0u) ? 1u : 0u; mine = (j == x) ? c : mine; }
        if (sum == G) break;
        __builtin_amdgcn_s_sleep(1);
        if ((++sp & 255u) == 0u) { if (xb_ld(&bar[XB_TMO])) break; if (sp > XB_SPIN_CAP) { atomicAdd(&bar[XB_TMO], 1u); break; } }
    }
    nloc = mine > 0u ? mine : 1u; nx = cnt > 0u ? cnt : 1u;
}

__device__ __forceinline__ void xcd_barrier(const XcdBarrier& b) {
    asm volatile("s_waitcnt vmcnt(0)" ::: "memory");
    __syncthreads();
    if (threadIdx.x == 0) {
        unsigned* bar = b.bar;
        __builtin_amdgcn_s_waitcnt(0);
        unsigned nloc = b.st[0], nx = b.st[1];
        if (nloc == 0u) { xcd_barrier_complete(bar, b.x, nloc, nx); b.st[0] = nloc; b.st[1] = nx; }
        const unsigned old = xb_add(&bar[XB_XSUB(b.x)], 1u);
        const unsigned gen = old / nloc;
        if (old + 1u == (gen + 1u) * nloc) {
            __builtin_amdgcn_fence(__ATOMIC_RELEASE, "agent");
            asm volatile("s_waitcnt vmcnt(0)" ::: "memory");
            const unsigned og = xb_add(&bar[XB_TOP], 1u);
            const unsigned tg = og / nx;
            if (og + 1u == (tg + 1u) * nx) xb_add(&bar[XB_TOPGEN], 1u);
            else XB_SPIN(xb_ld(&bar[XB_TOPGEN]) == tg, bar);
            __builtin_amdgcn_fence(__ATOMIC_ACQUIRE, "agent");
            xb_add(&bar[XB_XGEN(b.x)], 1u);
            asm volatile("s_waitcnt vmcnt(0)" ::: "memory");
        } else {
            XB_SPIN(xb_ld(&bar[XB_XGEN(b.x)]) == gen, bar);
            __builtin_amdgcn_fence(__ATOMIC_ACQUIRE, "agent");
            asm volatile("s_waitcnt vmcnt(0)" ::: "memory");
        }
    }
    __syncthreads();
}

#ifndef MK_SPLIT
#define MK_SPLIT 0
#endif
#ifndef P8_NP
#define P8_NP 2
#endif
constexpr int NWAVES = 8;
constexpr int NB = 2, SEQ = 4096, DM = 2048, T = NB * SEQ, HD = 128;
constexpr int INW = 10240;
constexpr int C_QA = 0, C_KA = 1024, C_VA = 1280, C_QB = 1536, C_KB = 3072, C_VB = 4608, C_GA = 6144, C_GB = 8192;
constexpr int AQW = 1024, BOW = 512;
constexpr int NEXP = 16384, PHEADS = 8, NKEYS = 128, TOPK = 16;
constexpr int NBIAS = 20;
constexpr float EPS = 1e-6f;
constexpr float SM_SCALE = 0.088388347648318440f;
constexpr float LOG2E = 1.4426950408889634f;
constexpr float A_SCALE = 16.f;
constexpr float M_SCALE = 64.f;
constexpr float W_SCALE = 512.f;

constexpr size_t MiB = 1u << 20;
constexpr size_t WS_CTL = 0, CTL_ZERO_BYTES = 16384;
constexpr size_t WS_WIN = 1 * MiB;
constexpr size_t WS_WOA = 41 * MiB;
constexpr size_t WS_WOB = 45 * MiB;
constexpr size_t WS_WOUT = 47 * MiB;
constexpr size_t WS_W2 = 55 * MiB;
constexpr size_t WS_U = 63 * MiB;
constexpr size_t WS_V = 79 * MiB;
constexpr size_t WS_ESC = 127 * MiB;
constexpr size_t WS_PROJ = 191 * MiB;
constexpr size_t WS_SC = WS_PROJ;
constexpr size_t WS_H = 351 * MiB;
constexpr size_t WS_MRG = WS_H;
constexpr size_t WS_ATTA = 383 * MiB;
constexpr size_t WS_OB = 399 * MiB;
constexpr size_t WS_X1B = WS_ATTA;
constexpr size_t WS_ATTB = 423 * MiB;
constexpr size_t WS_LSE = 431 * MiB;
constexpr size_t WS_PART = 432 * MiB;
constexpr size_t WS_TKI = 433 * MiB;
constexpr size_t WS_TKG = 437 * MiB;
constexpr size_t WS_MRG8 = 441 * MiB;
constexpr size_t WS_END = 457 * MiB;
constexpr int CW_BAR = 0;

constexpr int RING_OFF = 0, RING_BYTES = 131072;
constexpr int LDSCTL_OFF = RING_BYTES, MISC_OFF = LDSCTL_OFF + 320;
constexpr int RSTD_OFF = RING_BYTES + 1024;
constexpr int LDS_BYTES = 147456;
static_assert(RSTD_OFF + 1024 <= LDS_BYTES && XCD_BAR_WORDS * 4 <= (int)CTL_ZERO_BYTES, "maps");

typedef unsigned short bf16;
typedef unsigned v4u __attribute__((ext_vector_type(4)));
typedef unsigned v2u __attribute__((ext_vector_type(2)));
typedef float f32x4 __attribute__((ext_vector_type(4)));
typedef float f32x16 __attribute__((ext_vector_type(16)));
typedef short bf16x8 __attribute__((ext_vector_type(8)));
typedef short s16x4 __attribute__((ext_vector_type(4)));
typedef __bf16 bf16x2 __attribute__((ext_vector_type(2)));
#define LDS_WAIT() asm volatile("s_waitcnt lgkmcnt(0)" ::: "memory")
#define VM_WAIT() asm volatile("s_waitcnt vmcnt(0)" ::: "memory")
#define SBAR() __builtin_amdgcn_sched_barrier(0)
__device__ __forceinline__ unsigned cvtpk(float lo, float hi) { unsigned r; asm volatile("v_cvt_pk_bf16_f32 %0, %1, %2" : "=v"(r) : "v"(lo), "v"(hi)); return r; }
__device__ __forceinline__ float bflo(unsigned w) { return __builtin_bit_cast(float, w << 16); }
__device__ __forceinline__ float bfhi(unsigned w) { return __builtin_bit_cast(float, w & 0xffff0000u); }
__device__ __forceinline__ float dot2_bf16(unsigned w, unsigned x, float acc) { return __builtin_amdgcn_fdot2_f32_bf16(__builtin_bit_cast(bf16x2, w), __builtin_bit_cast(bf16x2, x), acc, false); }
__device__ __forceinline__ float wave_sum(float v) {
#pragma unroll
    for (int o = 1; o < 64; o <<= 1) v += __shfl_xor(v, o);
    return v;
}

struct Lane { int tid, lane, wave, gw; };
__device__ __forceinline__ Lane lane_state() { int t = threadIdx.x; asm volatile("" : "+v"(t)); Lane L; L.tid = t; L.lane = t & 63; L.wave = __builtin_amdgcn_readfirstlane(t >> 6); L.gw = blockIdx.x * 8 + L.wave; return L; }
struct Frame {
    LAS unsigned char* lds; char* ldsg;
    int G, NGW;
    const float *x, *rel_bias, *g_mix, *w_in, *sink_a, *w_oa, *w_ob, *w_out, *g_ffn, *w_pq, *keys, *eu, *ev, *g_fin;
    float* out; unsigned char* ws;
};

__device__ __forceinline__ unsigned pk4_fp8(float a, float b, float c, float d) { int p = __builtin_amdgcn_cvt_pk_fp8_f32(fminf(fmaxf(a, -448.f), 448.f), fminf(fmaxf(b, -448.f), 448.f), 0, false);
    return (unsigned)__builtin_amdgcn_cvt_pk_fp8_f32(fminf(fmaxf(c, -448.f), 448.f), fminf(fmaxf(d, -448.f), 448.f), p, true); }
__device__ __forceinline__ void p0_transpose_item_f8(const float* W, int K, int N, unsigned char* WT, float scale, LAS float* scr, int item, int lane) {
    const int nblk = N / 32, kb = item / nblk, nb = item % nblk, k0 = 64 * kb, n0 = 32 * nb;
    { f32x4 v[8];
#pragma unroll
      for (int i = 0; i < 8; ++i) v[i] = *(const f32x4*)(W + (size_t)(k0 + 8 * i + (lane >> 3)) * N + n0 + 4 * (lane & 7));
#pragma unroll
      for (int i = 0; i < 8; ++i) { LAS float* d = scr + (8 * i + (lane >> 3)) * 33 + 4 * (lane & 7); d[0] = v[i][0] * scale; d[1] = v[i][1] * scale; d[2] = v[i][2] * scale; d[3] = v[i][3] * scale; } }
    LDS_WAIT(); asm volatile("" ::: "memory");
    const int c = lane & 7;
#pragma unroll
    for (int j = 0; j < 4; ++j) { const int n = (lane >> 3) + 8 * j; const LAS float* s = scr + (8 * c) * 33 + n;
        v2u o; o.x = pk4_fp8(s[0 * 33], s[1 * 33], s[2 * 33], s[3 * 33]); o.y = pk4_fp8(s[4 * 33], s[5 * 33], s[6 * 33], s[7 * 33]);
        *(v2u*)(WT + (size_t)(n0 + n) * K + k0 + 8 * c) = o; }
    LDS_WAIT(); asm volatile("" ::: "memory");
}
__device__ __forceinline__ void p0_transpose_item(const float* W, int K, int N, bf16* WT, LAS float* scr, int item, int lane) {
    const int nblk = N / 32, kb = item / nblk, nb = item % nblk, k0 = 64 * kb, n0 = 32 * nb;
    { f32x4 v[8];
#pragma unroll
      for (int i = 0; i < 8; ++i) v[i] = *(const f32x4*)(W + (size_t)(k0 + 8 * i + (lane >> 3)) * N + n0 + 4 * (lane & 7));
#pragma unroll
      for (int i = 0; i < 8; ++i) { LAS float* d = scr + (8 * i + (lane >> 3)) * 33 + 4 * (lane & 7); d[0] = v[i][0]; d[1] = v[i][1]; d[2] = v[i][2]; d[3] = v[i][3]; } }
    LDS_WAIT(); asm volatile("" ::: "memory");
    const int c = lane & 7;
#pragma unroll
    for (int j = 0; j < 4; ++j) { const int n = (lane >> 3) + 8 * j; const LAS float* s = scr + (8 * c) * 33 + n;
        v4u o; o.x = cvtpk(s[0 * 33], s[1 * 33]); o.y = cvtpk(s[2 * 33], s[3 * 33]); o.z = cvtpk(s[4 * 33], s[5 * 33]); o.w = cvtpk(s[6 * 33], s[7 * 33]);
        *(v4u*)(WT + (size_t)(n0 + n) * K + k0 + 8 * c) = o; }
    LDS_WAIT(); asm volatile("" ::: "memory");
}
__device__ __forceinline__ void p0_w2_item(Frame& F, bf16* W2T, int item, int tid) {
    const int hc = item >> 5, j0 = (item & 31) * 64;
    LAS float* Ks = (LAS float*)F.lds; LAS float* Ws = Ks + 128 * 129;
    const f32x4* kp = (const f32x4*)(F.keys + (size_t)hc * 16384);
#pragma unroll
    for (int q = 0; q < 8; ++q) { const int idx = tid + 512 * q, row = idx >> 5, c4 = idx & 31; const f32x4 v = kp[idx];
        LAS float* d = Ks + row * 129 + c4 * 4; d[0] = v[0]; d[1] = v[1]; d[2] = v[2]; d[3] = v[3]; }
#pragma unroll
    for (int q = 0; q < 4; ++q) { const int idx = tid + 512 * q, row = idx >> 5, c4 = idx & 31; const f32x4 v = *(const f32x4*)(F.w_pq + (size_t)(j0 + row) * DM + hc * 128 + c4 * 4);
        LAS float* d = Ws + row * 129 + c4 * 4; d[0] = v[0]; d[1] = v[1]; d[2] = v[2]; d[3] = v[3]; }
    __syncthreads();
    { const int wv = tid >> 6, ln = tid & 63, kt = wv & 3, jt = wv >> 2, r = ln & 31, h2 = ln >> 5;
      const LAS float* ap = Ks + (kt * 32 + r) * 129 + h2; const LAS float* bp = Ws + (jt * 32 + r) * 129 + h2;
      f32x16 acc = {};
#pragma unroll 8
      for (int d0 = 0; d0 < 128; d0 += 2) acc = __builtin_amdgcn_mfma_f32_32x32x2f32(ap[d0], bp[d0], acc, 0, 0, 0);
      const int j = j0 + jt * 32 + r; const float g = F.g_ffn[j];
#pragma unroll
      for (int q = 0; q < 16; ++q) { const int k = kt * 32 + (q & 3) + 8 * (q >> 2) + 4 * h2; const float v = acc[q] * g;
          W2T[(size_t)(hc * 128 + k) * DM + j] = (bf16)(cvtpk(v, v) & 0xffffu); } }
    __syncthreads();
}
__device__ __forceinline__ void tab_issue(const Frame& F, int row, int lane, f32x4 (&v)[8]) {
    const float* src = (row < NEXP ? F.eu + (size_t)row * DM : F.ev + (size_t)(row - NEXP) * DM) + 4 * lane;
#pragma unroll
    for (int j = 0; j < 8; ++j) v[j] = *(const f32x4*)(src + 256 * j);
}
__device__ __forceinline__ void tab_finish(const Frame& F, int row, int lane, const f32x4 (&v)[8]) {
    static_assert(P8_NP == 2 && WS_V == WS_U + (size_t)NEXP * 1024, "table layout");
    float am = 0.f;
#pragma unroll
    for (int j = 0; j < 8; ++j) am = fmaxf(am, fmaxf(fmaxf(fabsf(v[j][0]), fabsf(v[j][1])), fmaxf(fabsf(v[j][2]), fabsf(v[j][3]))));
#pragma unroll
    for (int o = 1; o < 64; o <<= 1) am = fmaxf(am, __shfl_xor(am, o));
    const float inv = am > 0.f ? 6.f / am : 0.f;
    v4u pk = {0u, 0u, 0u, 0u};
#pragma unroll
    for (int j = 0; j < 8; ++j) {
        unsigned w = pk[j >> 1];
        if (j & 1) { w = __builtin_amdgcn_cvt_scalef32_pk_fp4_f32(w, v[j][0] * inv, v[j][1] * inv, 1.0f, 2); w = __builtin_amdgcn_cvt_scalef32_pk_fp4_f32(w, v[j][2] * inv, v[j][3] * inv, 1.0f, 3); }
        else       { w = __builtin_amdgcn_cvt_scalef32_pk_fp4_f32(w, v[j][0] * inv, v[j][1] * inv, 1.0f, 0); w = __builtin_amdgcn_cvt_scalef32_pk_fp4_f32(w, v[j][2] * inv, v[j][3] * inv, 1.0f, 1); }
        pk[j >> 1] = w; }
    const int p = lane >> 5, gl = (lane >> 1) & 15, g = lane & 1;
    unsigned char* dst = F.ws + WS_U + (size_t)(row >= NEXP) * ((size_t)NEXP * 1024) + (size_t)p * ((size_t)NEXP * 512) + (size_t)(row & (NEXP - 1)) * 512 + 256 * g + 16 * gl;
    *(v4u*)dst = pk;
    if (lane == 0) ((float*)(F.ws + WS_ESC))[2 * (row & (NEXP - 1)) + (row >= NEXP)] = am * (1.f / 6.f);
}
__device__ __forceinline__ void p6_tables(Frame& F) {
    const Lane Ls = lane_state();
    for (int row = Ls.gw; row < 2 * NEXP; row += 2 * F.NGW) { f32x4 v0[8], v1[8]; const int row1 = row + F.NGW;
        tab_issue(F, row, Ls.lane, v0); if (row1 < 2 * NEXP) tab_issue(F, row1, Ls.lane, v1);
        tab_finish(F, row, Ls.lane, v0); if (row1 < 2 * NEXP) tab_finish(F, row1, Ls.lane, v1); }
}
struct TItem { const float* W; unsigned char* WT; int K, N, r; };
__device__ __forceinline__ TItem t_decode(const Frame& F, int it) {
    constexpr int I_IN = (DM / 64) * (INW / 32), I_OA = (AQW / 64) * (DM / 32), I_OB = (BOW / 64) * (DM / 32);
    if (it < I_IN) return TItem{F.w_in, F.ws + WS_WIN, DM, INW, it}; it -= I_IN;
    if (it < I_OA) return TItem{F.w_oa, F.ws + WS_WOA, AQW, DM, it}; it -= I_OA;
    if (it < I_OB) return TItem{F.w_ob, F.ws + WS_WOB, BOW, DM, it}; it -= I_OB;
    return TItem{F.w_out, F.ws + WS_WOUT, DM, DM, it};
}
__device__ __forceinline__ void t_issue(const Frame& F, int it, int lane, f32x4 (&v)[8]) {
    const TItem t = t_decode(F, it); const int nblk = t.N / 32, k0 = 64 * (t.r / nblk), n0 = 32 * (t.r % nblk);
#pragma unroll
    for (int i = 0; i < 8; ++i) v[i] = *(const f32x4*)(t.W + (size_t)(k0 + 8 * i + (lane >> 3)) * t.N + n0 + 4 * (lane & 7));
}
__device__ __forceinline__ void t_finish(const Frame& F, int it, int lane, const f32x4 (&v)[8], LAS float* scr) {
    const TItem t = t_decode(F, it); const int nblk = t.N / 32, k0 = 64 * (t.r / nblk), n0 = 32 * (t.r % nblk);
#pragma unroll
    for (int i = 0; i < 8; ++i) { LAS float* d = scr + (8 * i + (lane >> 3)) * 33 + 4 * (lane & 7); d[0] = v[i][0] * W_SCALE; d[1] = v[i][1] * W_SCALE; d[2] = v[i][2] * W_SCALE; d[3] = v[i][3] * W_SCALE; }
    LDS_WAIT(); asm volatile("" ::: "memory");
    const int c = lane & 7;
#pragma unroll
    for (int j = 0; j < 4; ++j) { const int n = (lane >> 3) + 8 * j; const LAS float* q = scr + (8 * c) * 33 + n;
        v2u o; o.x = pk4_fp8(q[0 * 33], q[1 * 33], q[2 * 33], q[3 * 33]); o.y = pk4_fp8(q[4 * 33], q[5 * 33], q[6 * 33], q[7 * 33]);
        *(v2u*)(t.WT + (size_t)(n0 + n) * t.K + k0 + 8 * c) = o; }
    LDS_WAIT(); asm volatile("" ::: "memory");
}
__device__ __forceinline__ void p0_prologue(Frame& F) {
    const Lane Ls = lane_state();
    LAS float* scr = (LAS float*)(F.lds + RING_OFF + Ls.wave * 16384);
    constexpr int NITEMS = (DM / 64) * (INW / 32) + (AQW / 64) * (DM / 32) + (BOW / 64) * (DM / 32) + (DM / 64) * (DM / 32);
    { f32x4 va[8], vb[8]; int it = Ls.gw;
      if (it < NITEMS) t_issue(F, it, Ls.lane, va);
      while (it < NITEMS) {
          const int i1 = it + F.NGW; if (i1 < NITEMS) t_issue(F, i1, Ls.lane, vb);
          t_finish(F, it, Ls.lane, va, scr);
          if (i1 >= NITEMS) break;
          const int i2 = i1 + F.NGW; if (i2 < NITEMS) t_issue(F, i2, Ls.lane, va);
          t_finish(F, i1, Ls.lane, vb, scr);
          it = i2; } }
    __syncthreads();
    for (int it = blockIdx.x; it < 512; it += F.G) p0_w2_item(F, (bf16*)(F.ws + WS_W2), it, Ls.tid);
    { unsigned char* Hb = F.ws + WS_H;
      for (int m = Ls.gw; m < T; m += 2 * F.NGW) { const int m1 = m + F.NGW; const bool two = m1 < T;
          const f32x4* xr0 = (const f32x4*)(F.x + (size_t)m * DM) + Ls.lane; const f32x4* xr1 = (const f32x4*)(F.x + (size_t)(two ? m1 : m) * DM) + Ls.lane; f32x4 v0[8], v1[8]; float s0 = 0.f, s1 = 0.f;
#pragma unroll
          for (int j = 0; j < 8; ++j) v0[j] = xr0[64 * j];
#pragma unroll
          for (int j = 0; j < 8; ++j) v1[j] = xr1[64 * j];
#pragma unroll
          for (int j = 0; j < 8; ++j) s0 += (v0[j][0] * v0[j][0] + v0[j][1] * v0[j][1]) + (v0[j][2] * v0[j][2] + v0[j][3] * v0[j][3]);
#pragma unroll
          for (int j = 0; j < 8; ++j) s1 += (v1[j][0] * v1[j][0] + v1[j][1] * v1[j][1]) + (v1[j][2] * v1[j][2] + v1[j][3] * v1[j][3]);
          const float r0 = rsqrtf(wave_sum(s0) * (1.f / DM) + EPS), r1 = rsqrtf(wave_sum(s1) * (1.f / DM) + EPS);
          unsigned* o0 = (unsigned*)(Hb + (size_t)m * DM) + Ls.lane; unsigned* o1 = (unsigned*)(Hb + (size_t)m1 * DM) + Ls.lane;
#pragma unroll
          for (int j = 0; j < 8; ++j) { const f32x4 g = ((const f32x4*)F.g_mix)[Ls.lane + 64 * j];
              o0[64 * j] = pk4_fp8(v0[j][0] * r0 * g[0], v0[j][1] * r0 * g[1], v0[j][2] * r0 * g[2], v0[j][3] * r0 * g[3]);
              if (two) o1[64 * j] = pk4_fp8(v1[j][0] * r1 * g[0], v1[j][1] * r1 * g[1], v1[j][2] * r1 * g[2], v1[j][3] * r1 * g[3]); } } }
}

namespace att {
#define KSWZ(row, colB) ((row) * 256 + ((colB) ^ (((row) & 7) << 4)))
__device__ __forceinline__ int crow(int r, int hi) { return (r & 3) + 8 * (r >> 2) + 4 * hi; }
__device__ __forceinline__ void qkt(f32x16& p0, f32x16& p1, const char* Ks, const bf16x8* qr, int r32, int hi) {
    p0 = f32x16{}; p1 = f32x16{};
#pragma unroll
    for (int d0 = 0; d0 < 8; ++d0) { const int cb = (d0 * 16 + hi * 8) * 2;
        const bf16x8 b0 = *reinterpret_cast<const bf16x8*>(Ks + KSWZ(r32, cb));
        const bf16x8 b1 = *reinterpret_cast<const bf16x8*>(Ks + KSWZ(32 + r32, cb));
        p0 = __builtin_amdgcn_mfma_f32_32x32x16_bf16(b0, qr[d0], p0, 0, 0, 0);
        p1 = __builtin_amdgcn_mfma_f32_32x32x16_bf16(b1, qr[d0], p1, 0, 0, 0); }
}
__device__ __forceinline__ int v_st(int k, int c) { const int kk = (k & ~0xC) | ((k & 4) << 1) | ((k & 8) >> 1); return ((kk >> 3) * 4 + (c >> 5)) * 512 + ((kk & 7) * 32 + (c & 31)) * 2; }
__device__ __forceinline__ int v_rd_base(int lane) { return ((lane & 3) << 3) | (((lane >> 2) & 3) << 6) | (((lane >> 4) & 1) << 5) | (((lane >> 5) & 1) << 8); }
constexpr int v_rd_off(int d0, int ks, int half) { return d0 * 512 + ks * 4096 + half * 2048; }
template <int OFF> __device__ __forceinline__ s16x4 tr_read(int vb) {
    s16x4 r; asm volatile("ds_read_b64_tr_b16 %0, %1 offset:%2" : "=&v"(r) : "v"(vb), "i"(OFF) : "memory"); return r;
}
template <int D0> __device__ __forceinline__ void pv_one(f32x16& od, int vb, bf16x8 pa0, bf16x8 pa1, bf16x8 pa2, bf16x8 pa3) {
    const s16x4 l0 = tr_read<v_rd_off(D0, 0, 0)>(vb), h0 = tr_read<v_rd_off(D0, 0, 1)>(vb), l1 = tr_read<v_rd_off(D0, 1, 0)>(vb), h1 = tr_read<v_rd_off(D0, 1, 1)>(vb);
    const s16x4 l2 = tr_read<v_rd_off(D0, 2, 0)>(vb), h2 = tr_read<v_rd_off(D0, 2, 1)>(vb), l3 = tr_read<v_rd_off(D0, 3, 0)>(vb), h3 = tr_read<v_rd_off(D0, 3, 1)>(vb);
    asm volatile("s_waitcnt lgkmcnt(0)" ::: "memory"); SBAR();
#define PK(L, H) (bf16x8){L[0], L[1], L[2], L[3], H[0], H[1], H[2], H[3]}
    od = __builtin_amdgcn_mfma_f32_32x32x16_bf16(pa0, PK(l0, h0), od, 0, 0, 0);
    od = __builtin_amdgcn_mfma_f32_32x32x16_bf16(pa1, PK(l1, h1), od, 0, 0, 0);
    od = __builtin_amdgcn_mfma_f32_32x32x16_bf16(pa2, PK(l2, h2), od, 0, 0, 0);
    od = __builtin_amdgcn_mfma_f32_32x32x16_bf16(pa3, PK(l3, h3), od, 0, 0, 0);
#undef PK
}
__device__ __forceinline__ void pv_d0(f32x16* o, int vb, bf16x8 pa0, bf16x8 pa1, bf16x8 pa2, bf16x8 pa3) {
    pv_one<0>(o[0], vb, pa0, pa1, pa2, pa3); pv_one<1>(o[1], vb, pa0, pa1, pa2, pa3); pv_one<2>(o[2], vb, pa0, pa1, pa2, pa3); pv_one<3>(o[3], vb, pa0, pa1, pa2, pa3);
}
__device__ __forceinline__ int t5_bucket(int rel) {
    const int n = rel < 0 ? -rel : rel; int b;
    if (n < 8) b = n; else { b = 8 + (n >= 15) + (n >= 27) + (n >= 50) + (n >= 91) + (n >= 166) + (n >= 305) + (n >= 559); b = b > 15 ? 15 : b; }
    return b + (rel > 0 ? 16 : 0);
}
constexpr int ATT_WS_OFF = RSTD_OFF + 1024, ATT_BT_OFF = ATT_WS_OFF + 2048;
static_assert(ATT_BT_OFF + 2 * 1040 <= LDS_BYTES, "attention scratch above the stage region");
template <int W, bool SINK>
__device__ __forceinline__ void attn_unit(char* lds, const bf16* proj, int b, int qcol, int kcol, int vcol, int d, int r, int m0u,
                                          const float* bias_col, float sinkv, bf16* O, int ldo, int ocol, float* lse, int lse_j) {
    int tid_ = threadIdx.x; asm volatile("" : "+v"(tid_));
    const int tid = tid_, wid = __builtin_amdgcn_readfirstlane(tid >> 6), lane = tid & 63, r32 = lane & 31, hi = lane >> 5;
    const int hh = wid >> 2, wq = wid & 3, htid = tid & 255;
    constexpr int NT = (128 + 2 * W) / 64;
    const int L = SEQ / d, m0 = m0u + 128 * hh;
    char* hbase = lds + hh * 65536;
    float* ws = (float*)(lds + ATT_WS_OFF) + wid * 64; float* li_l = ws; float* al_l = ws + 32;
    float* btab = (float*)(lds + ATT_BT_OFF + hh * 1040);
    __syncthreads();
    for (int i = htid; i <= 2 * W; i += 256) btab[i] = bias_col[t5_bucket((i - W) * d) * NBIAS];
    const int qm = m0 + wq * 32 + r32;
    const size_t tok0 = (size_t)b * SEQ + r;
    bf16x8 qr[8];
    { const bf16* Qw = proj + ((size_t)(qcol >> 7) * T + tok0 + (size_t)qm * d) * 128 + hi * 8;
#pragma unroll
      for (int d0 = 0; d0 < 8; ++d0) qr[d0] = *reinterpret_cast<const bf16x8*>(Qw + d0 * 16); }
    float m_run = SINK ? sinkv : -1e29f, l_run = SINK ? 1.f : 0.f;
    f32x16 o[4] = {};
    const int sr = htid >> 4, sc = (htid & 15) * 8;
    const int t_lo = wq >> 1, t_hi = (32 * wq + 31 + 2 * W) >> 6;
    bf16x8 vs[4], ks[4];
#define SLOAD(t) do { const int tm = m0 - W + 64 * (t); if (tm + 63 >= 0 && tm < L) { _Pragma("unroll") for (int i_ = 0; i_ < 4; ++i_) { int k_ = tm + sr + 16 * i_; k_ = k_ < 0 ? 0 : (k_ > L - 1 ? L - 1 : k_); \
        const size_t tk_ = tok0 + (size_t)k_ * d; vs[i_] = *reinterpret_cast<const bf16x8*>(proj + ((size_t)(vcol >> 7) * T + tk_) * 128 + sc); ks[i_] = *reinterpret_cast<const bf16x8*>(proj + ((size_t)(kcol >> 7) * T + tk_) * 128 + sc); } } } while (0)
#define SWRITE(t) do { const int tm = m0 - W + 64 * (t); if (tm + 63 >= 0 && tm < L) { char* vb_ = hbase + ((t) & 1) * 32768; char* kb_ = vb_ + 16384; _Pragma("unroll") for (int i_ = 0; i_ < 4; ++i_) { \
        *(bf16x8*)(vb_ + v_st(sr + 16 * i_, sc)) = vs[i_]; *(bf16x8*)(kb_ + KSWZ(sr + 16 * i_, sc * 2)) = ks[i_]; } } } while (0)
    SLOAD(0);
#pragma unroll 1
    for (int t = 0; t < NT; ++t) {
        SWRITE(t);
        __syncthreads();
        if (t + 1 < NT) SLOAD(t + 1);
        const int tm0 = m0 - W + 64 * t;
        if (t >= t_lo && t <= t_hi && tm0 + 63 >= 0 && tm0 < L) {
            const char* V_lds = hbase + (t & 1) * 32768; const char* K_lds = V_lds + 16384;
            const int vb0 = (int)(uintptr_t)V_lds + v_rd_base(lane);
            f32x16 p0, p1; qkt(p0, p1, K_lds, qr, r32, hi);
            const int base = tm0 - qm + W;
            float pmax = -1e30f;
            const int qw0 = m0 + wq * 32;
            if (tm0 >= qw0 + 31 - W && tm0 + 63 <= qw0 + W && tm0 >= 0 && tm0 + 63 < L) {
#pragma unroll
                for (int q = 0; q < 16; ++q) { const float s = fmaf(p0[q], SM_SCALE, btab[base + crow(q, hi)]); p0[q] = s; pmax = fmaxf(pmax, s); }
#pragma unroll
                for (int q = 0; q < 16; ++q) { const float s = fmaf(p1[q], SM_SCALE, btab[base + 32 + crow(q, hi)]); p1[q] = s; pmax = fmaxf(pmax, s); }
            } else {
#pragma unroll
            for (int q = 0; q < 16; ++q) { const int key = crow(q, hi), idx = base + key, km = tm0 + key;
                const bool ok = (unsigned)idx <= (unsigned)(2 * W) && (unsigned)km < (unsigned)L;
                const float bv = btab[ok ? idx : 0]; const float s = ok ? fmaf(p0[q], SM_SCALE, bv) : -1e30f; p0[q] = s; pmax = fmaxf(pmax, s); }
#pragma unroll
            for (int q = 0; q < 16; ++q) { const int key = 32 + crow(q, hi), idx = base + key, km = tm0 + key;
                const bool ok = (unsigned)idx <= (unsigned)(2 * W) && (unsigned)km < (unsigned)L;
                const float bv = btab[ok ? idx : 0]; const float s = ok ? fmaf(p1[q], SM_SCALE, bv) : -1e30f; p1[q] = s; pmax = fmaxf(pmax, s); }
            }
            { auto rr = __builtin_amdgcn_permlane32_swap(__float_as_uint(pmax), __float_as_uint(pmax), false, false);
              pmax = fmaxf(__uint_as_float(rr[0]), __uint_as_float(rr[1])); }
            const float mn = fmaxf(m_run, pmax), alpha = __builtin_amdgcn_exp2f((m_run - mn) * LOG2E); m_run = mn;
            const float mnc = -mn * LOG2E; float ps = 0.f;
#pragma unroll
            for (int q = 0; q < 16; ++q) { p0[q] = __builtin_amdgcn_exp2f(fmaf(p0[q], LOG2E, mnc)); ps += p0[q]; }
#pragma unroll
            for (int q = 0; q < 16; ++q) { p1[q] = __builtin_amdgcn_exp2f(fmaf(p1[q], LOG2E, mnc)); ps += p1[q]; }
            { auto rr = __builtin_amdgcn_permlane32_swap(__float_as_uint(ps), __float_as_uint(ps), false, false);
              ps = __uint_as_float(rr[0]) + __uint_as_float(rr[1]); }
            l_run = l_run * alpha + ps;
            if (__any(alpha < 1.f)) { if (hi == 0) al_l[r32] = alpha; asm volatile("s_waitcnt lgkmcnt(0)" ::: "memory");
#pragma unroll
                for (int dd = 0; dd < 4; ++dd)
#pragma unroll
                    for (int q = 0; q < 16; ++q) o[dd][q] *= al_l[crow(q, hi)]; }
            bf16x8 pa0, pa1, pa2, pa3;
#define PK4(P, BASE, OUT) do { unsigned a0 = cvtpk(P[BASE + 0], P[BASE + 1]), a1 = cvtpk(P[BASE + 2], P[BASE + 3]);   \
    unsigned b0 = cvtpk(P[BASE + 4], P[BASE + 5]), b1 = cvtpk(P[BASE + 6], P[BASE + 7]);                              \
    auto r0 = __builtin_amdgcn_permlane32_swap(a0, b0, false, false); auto r1 = __builtin_amdgcn_permlane32_swap(a1, b1, false, false); \
    v4u w = {r0[0], r1[0], r0[1], r1[1]}; OUT = *reinterpret_cast<bf16x8*>(&w); } while (0)
            PK4(p0, 0, pa0); PK4(p0, 8, pa1); PK4(p1, 0, pa2); PK4(p1, 8, pa3);
#undef PK4
            pv_d0(o, vb0, pa0, pa1, pa2, pa3);
        }
    }
#undef SLOAD
#undef SWRITE
    if (hi == 0) li_l[r32] = l_run; asm volatile("s_waitcnt lgkmcnt(0)" ::: "memory");
    if (!SINK && hi == 0) lse[(tok0 + (size_t)qm * d) * 4 + lse_j] = m_run + __logf(l_run);
    __syncthreads();
    if constexpr (SINK) {
      char* ost = lds + wid * 8704; unsigned char* O8 = (unsigned char*)O;
#pragma unroll
      for (int q = 0; q < 16; ++q) { const float rl = __builtin_amdgcn_rcpf(li_l[crow(q, hi)]) * A_SCALE; unsigned char* orow = (unsigned char*)(ost + crow(q, hi) * 144) + r32;
#pragma unroll
          for (int dd = 0; dd < 4; ++dd) { const float v = fminf(fmaxf(o[dd][q] * rl, -448.f), 448.f); orow[dd * 32] = (unsigned char)(__builtin_amdgcn_cvt_pk_fp8_f32(v, v, 0, false) & 0xff); } }
      asm volatile("s_waitcnt lgkmcnt(0)" ::: "memory");
      const int rr = lane >> 3, cc = lane & 7;
#pragma unroll
      for (int k = 0; k < 4; ++k) { const int row = rr + 8 * k; const v4u w = *(const v4u*)(ost + row * 144 + cc * 16);
          *(v4u*)(O8 + (tok0 + (size_t)(m0 + wq * 32 + row) * d) * ldo + ocol + cc * 16) = w; }
    } else {
      char* ost = lds + wid * 8704;
#pragma unroll
      for (int q = 0; q < 16; ++q) { const float rl = __builtin_amdgcn_rcpf(li_l[crow(q, hi)]); unsigned short* orow = (unsigned short*)(ost + crow(q, hi) * 272) + r32;
#pragma unroll
          for (int dd = 0; dd < 4; ++dd) { const float v = o[dd][q] * rl; orow[dd * 32] = (unsigned short)(cvtpk(v, v) & 0xffffu); } }
      asm volatile("s_waitcnt lgkmcnt(0)" ::: "memory");
      const int rr = lane >> 4, cc = lane & 15;
#pragma unroll
      for (int k = 0; k < 8; ++k) { const int row = rr + 4 * k; const v4u w = *(const v4u*)(ost + row * 272 + cc * 16);
          *(v4u*)(O + (tok0 + (size_t)(m0 + wq * 32 + row) * d) * ldo + ocol + cc * 8) = w; } }
}
}

__device__ __forceinline__ void p2_attention(Frame& F) {
    const bf16* proj = (const bf16*)(F.ws + WS_PROJ);
    bf16* attA = (bf16*)(F.ws + WS_ATTA); bf16* oB = (bf16*)(F.ws + WS_OB); float* lseB = (float*)(F.ws + WS_LSE);
    const int vcu = (F.G & 7) ? (int)blockIdx.x : (int)(blockIdx.x & 7) * (F.G >> 3) + (int)(blockIdx.x >> 3);
    const bool bal = F.G == 256; const int nmine = bal ? (vcu < 128 ? 2 : 3) : (640 - vcu + F.G - 1) / F.G;
    for (int ui = 0; ui < nmine; ++ui) { const int uid = bal ? (vcu < 128 ? 2 * vcu + ui : 256 + 3 * (vcu - 128) + ui) : vcu + ui * F.G;
        if (uid < 256) {
            const int b = uid >> 7, rem = uid & 127, blk = rem >> 3, hq = rem & 7, kvh = hq >> 2;
            att::attn_unit<128, true>(F.ldsg, proj, b, C_QA + hq * HD, C_KA + kvh * HD, C_VA + kvh * HD, 1, 0, blk * 256,
                                      F.rel_bias + hq, F.sink_a[hq], attA, AQW, hq * HD, nullptr, 0);
        } else {
            const int u2 = uid - 256, gi = u2 >> 7, rem = u2 & 127, b = rem >> 6, blk = (rem >> 2) & 15, j = rem & 3;
            const int d = gi == 0 ? 1 : (gi == 1 ? 4 : 16), nbr = 16 / d, r = blk / nbr, m0 = (blk % nbr) * 256, hb = gi * 4 + j;
            att::attn_unit<64, false>(F.ldsg, proj, b, C_QB + hb * HD, C_KB + hb * HD, C_VB + hb * HD, d, r, m0,
                                      F.rel_bias + 8 + hb, 0.f, oB + (size_t)gi * T * BOW, BOW, j * HD, lseB + (size_t)gi * T * 4, j);
        }
    }
}
__device__ __forceinline__ void p3_combine(Frame& F) {
    const Lane Ls = lane_state();
    const bf16* oB = (const bf16*)(F.ws + WS_OB); const float* lseB = (const float*)(F.ws + WS_LSE); bf16* attB = (bf16*)(F.ws + WS_ATTB);
    for (int t = Ls.gw; t < T; t += F.NGW) {
        const int j = Ls.lane >> 4;
        const float l0 = lseB[(size_t)t * 4 + j], l1 = lseB[(size_t)(T + t) * 4 + j], l2 = lseB[(size_t)(2 * T + t) * 4 + j];
        const float mx = fmaxf(l0, fmaxf(l1, l2)); const float e0 = __expf(l0 - mx), e1 = __expf(l1 - mx), e2 = __expf(l2 - mx); const float inv = 1.f / (e0 + e1 + e2);
        const float w0 = e0 * inv, w1 = e1 * inv, w2 = e2 * inv;
        const v4u a = *(const v4u*)(oB + (size_t)t * BOW + Ls.lane * 8), bq = *(const v4u*)(oB + ((size_t)T + t) * BOW + Ls.lane * 8), c = *(const v4u*)(oB + ((size_t)2 * T + t) * BOW + Ls.lane * 8);
        float cv[8];
#pragma unroll
        for (int k = 0; k < 4; ++k) { cv[2 * k] = (w0 * bflo(a[k]) + w1 * bflo(bq[k]) + w2 * bflo(c[k])) * A_SCALE; cv[2 * k + 1] = (w0 * bfhi(a[k]) + w1 * bfhi(bq[k]) + w2 * bfhi(c[k])) * A_SCALE; }
        v2u o; o.x = pk4_fp8(cv[0], cv[1], cv[2], cv[3]); o.y = pk4_fp8(cv[4], cv[5], cv[6], cv[7]);
        *(v2u*)((unsigned char*)attB + (size_t)t * BOW + Ls.lane * 8) = o;
    }
}

__device__ __forceinline__ float gelu_erf(float v) {
    const float av = fabsf(v), t = __builtin_amdgcn_rcpf(fmaf(av, 0.2316418882f, 1.0f));
    float q = fmaf(t, 0.5307027145f, -0.7265760135f); q = fmaf(q, t, 0.7107068705f); q = fmaf(q, t, -0.142248368f); q = fmaf(q, t, 0.127414796f); q = q * t;
    const float e = __builtin_amdgcn_exp2f(v * v * -0.72134752044f);
    const float m = v * (q * e);
    return v < 0.f ? m : v - m;
}
typedef float f32x2 __attribute__((ext_vector_type(2)));
template <int K> __device__ __forceinline__ float xor_lane(float x) {
    static_assert(K == 1 || K == 2 || K == 4 || K == 8, "xor distance");
    const int xi = __builtin_bit_cast(int, x);
    if constexpr (K == 1) return __builtin_bit_cast(float, __builtin_amdgcn_mov_dpp(xi, 0xB1, 0xf, 0xf, true));
    else if constexpr (K == 2) return __builtin_bit_cast(float, __builtin_amdgcn_mov_dpp(xi, 0x4E, 0xf, 0xf, true));
    else return __builtin_bit_cast(float, __builtin_amdgcn_ds_swizzle(xi, (K << 10) | 0x1f));
}
#define PIN16(A, B) asm volatile("" : "+v"(A[(B) + 0]), "+v"(A[(B) + 1]), "+v"(A[(B) + 2]), "+v"(A[(B) + 3]), "+v"(A[(B) + 4]), "+v"(A[(B) + 5]), "+v"(A[(B) + 6]), "+v"(A[(B) + 7]), \
    "+v"(A[(B) + 8]), "+v"(A[(B) + 9]), "+v"(A[(B) + 10]), "+v"(A[(B) + 11]), "+v"(A[(B) + 12]), "+v"(A[(B) + 13]), "+v"(A[(B) + 14]), "+v"(A[(B) + 15]) :: "memory")
#ifndef P8_DU
#define P8_DU 4
#endif
#ifndef P8_DV
#define P8_DV 4
#endif
constexpr int P8_CH = 2;
constexpr int P8_ST = 64;
constexpr int P8_PB = 512;
#define PIN8X2(A, B) asm volatile("" : "+v"(A[(B) + 0]), "+v"(A[(B) + 1]), "+v"(A[(B) + 2]), "+v"(A[(B) + 3]), "+v"(A[(B) + 4]), "+v"(A[(B) + 5]), "+v"(A[(B) + 6]), "+v"(A[(B) + 7]) :: "memory")
#define FP4X2(w, B) __builtin_amdgcn_cvt_scalef32_pk_f32_fp4((w), 1.0f, (B))
typedef __bf16 v2bf_t __attribute__((ext_vector_type(2)));
#define FP4B2(w, B) __builtin_amdgcn_cvt_scalef32_pk_bf16_fp4((w), 1.0f, (B))
template <int D> __device__ __forceinline__ void issue_part(v4u (&buf)[P8_CH], const unsigned char* tab, unsigned e, int gl) {
    const unsigned char* p = tab + (size_t)e * P8_PB + 16 * gl;
#pragma unroll
    for (int jj = 0; jj < P8_CH; ++jj) buf[jj] = *(const v4u*)(p + 256 * jj);
}
template <int D> __device__ __forceinline__ void sweep_u(const unsigned char* tab, const LAS unsigned* entg, LAS float* awg, int gl, int part, const unsigned (&hv)[P8_ST / 2]) {
    static_assert(128 % D == 0 && D % 4 == 0 && D <= 16, "block size");
    v4u buf[D][P8_CH];
    tab += (size_t)part * ((size_t)NEXP * P8_PB);
    { v4u e4[D / 4];
#pragma unroll
      for (int q = 0; q < D / 4; ++q) e4[q] = *(const LAS v4u*)(entg + 4 * q);
#pragma unroll
      for (int j = 0; j < D; ++j) issue_part<D>(buf[j], tab, e4[j >> 2][j & 3], gl); }
#pragma unroll 1
    for (int k0 = 0; k0 < 128; k0 += D) {
        v4u e4[D / 4]; const int kb = (k0 + D < 128) ? k0 + D : 128 - D;
#pragma unroll
        for (int q = 0; q < D / 4; ++q) e4[q] = *(const LAS v4u*)(entg + kb + 4 * q);
#pragma unroll
        for (int q = 0; q < D / 4; ++q) asm volatile("" : "+v"(e4[q]));
        float racc[D];
#pragma unroll
        for (int j = 0; j < D; ++j) {
            float a0 = 0.f, a1 = 0.f;
#pragma unroll
            for (int g = 0; g < P8_CH; ++g)
#pragma unroll
                for (int w = 0; w < 4; ++w) { const unsigned d = buf[j][g][w];
                    a0 = __builtin_amdgcn_fdot2_f32_bf16(FP4B2(d, 0), __builtin_bit_cast(v2bf_t, hv[16 * g + 4 * w + 0]), a0, false); a1 = __builtin_amdgcn_fdot2_f32_bf16(FP4B2(d, 1), __builtin_bit_cast(v2bf_t, hv[16 * g + 4 * w + 1]), a1, false);
                    a0 = __builtin_amdgcn_fdot2_f32_bf16(FP4B2(d, 2), __builtin_bit_cast(v2bf_t, hv[16 * g + 4 * w + 2]), a0, false); a1 = __builtin_amdgcn_fdot2_f32_bf16(FP4B2(d, 3), __builtin_bit_cast(v2bf_t, hv[16 * g + 4 * w + 3]), a1, false); }
            racc[j] = a0 + a1; asm volatile("" : "+v"(racc[j]) :: "memory");
            SBAR();
            issue_part<D>(buf[j], tab, e4[j >> 2][j & 3], gl);
            SBAR();
        }
        static_assert(D == 4 || D == 8, "the butterfly below is written for blocks of 4 or 8 steps");
        if constexpr (D == 8) { const bool up_ = (gl & 4) != 0;
#pragma unroll
          for (int i = 0; i < 4; ++i) { const float keep = up_ ? racc[i + 4] : racc[i], send = up_ ? racc[i] : racc[i + 4]; racc[i] = keep + xor_lane<4>(send); } }
        { const bool up_ = (gl & 2) != 0;
#pragma unroll
          for (int i = 0; i < 2; ++i) { const float keep = up_ ? racc[i + 2] : racc[i], send = up_ ? racc[i] : racc[i + 2]; racc[i] = keep + xor_lane<2>(send); } }
        { const bool up_ = (gl & 1) != 0; const float keep = up_ ? racc[1] : racc[0], send = up_ ? racc[0] : racc[1]; racc[0] = keep + xor_lane<1>(send); }
        float r = racc[0];
        if constexpr (D == 4) r += xor_lane<4>(r);
        r += xor_lane<8>(r);
        if (gl < D) awg[part * 512 + k0 + gl] = r;
    }
}
template <int D> __device__ __forceinline__ void sweep_v(const unsigned char* tab, const LAS unsigned* entg, const LAS float* awg, int gl, int part, f32x2 (&po)[P8_ST / 2]) {
    static_assert(128 % D == 0 && D % 4 == 0 && D <= 16, "block size");
    v4u buf[D][P8_CH];
    tab += (size_t)part * ((size_t)NEXP * P8_PB);
    { v4u e4[D / 4];
#pragma unroll
      for (int q = 0; q < D / 4; ++q) e4[q] = *(const LAS v4u*)(entg + 4 * q);
#pragma unroll
      for (int j = 0; j < D; ++j) issue_part<D>(buf[j], tab, e4[j >> 2][j & 3], gl); }
    SBAR();
#pragma unroll 1
    for (int k0 = 0; k0 < 128; k0 += D) {
        v4u e4[D / 4]; f32x4 w4[D / 4]; const int kb = (k0 + D < 128) ? k0 + D : 128 - D;
#pragma unroll
        for (int q = 0; q < D / 4; ++q) { e4[q] = *(const LAS v4u*)(entg + kb + 4 * q); w4[q] = *(const LAS f32x4*)(awg + k0 + 4 * q); }
#pragma unroll
        for (int q = 0; q < D / 4; ++q) asm volatile("" : "+v"(e4[q]), "+v"(w4[q]));
#pragma unroll
        for (int j = 0; j < D; ++j) {
            const float wk = w4[j >> 2][j & 3];
            const f32x2 w2 = {wk, wk};
#pragma unroll
            for (int g = 0; g < P8_CH; ++g) {
#pragma unroll
                for (int w = 0; w < 4; ++w) { const unsigned d = buf[j][g][w];
                    po[16 * g + 4 * w + 0] = __builtin_elementwise_fma(w2, FP4X2(d, 0), po[16 * g + 4 * w + 0]); po[16 * g + 4 * w + 1] = __builtin_elementwise_fma(w2, FP4X2(d, 1), po[16 * g + 4 * w + 1]);
                    po[16 * g + 4 * w + 2] = __builtin_elementwise_fma(w2, FP4X2(d, 2), po[16 * g + 4 * w + 2]); po[16 * g + 4 * w + 3] = __builtin_elementwise_fma(w2, FP4X2(d, 3), po[16 * g + 4 * w + 3]); }
                PIN8X2(po, 16 * g); PIN8X2(po, 16 * g + 8); }
            SBAR();
            issue_part<D>(buf[j], tab, e4[j >> 2][j & 3], gl);
            SBAR();
        }
    }
}
__device__ __forceinline__ void p8_expert(Frame& F, const XcdBarrier& bar) {
    const Lane Ls = lane_state();
    const unsigned char* U8 = F.ws + WS_U; const unsigned char* V8 = F.ws + WS_V; const float* esc = (const float*)(F.ws + WS_ESC);
    const float* part = (const float*)(F.ws + WS_PART); const int* tki = (const int*)(F.ws + WS_TKI); const float* tkg = (const float*)(F.ws + WS_TKG);
    bf16* X1b = (bf16*)(F.ws + WS_X1B);
    LAS unsigned* key = (LAS unsigned*)(F.lds + RING_OFF + Ls.wave * 16384); LAS unsigned* ent = key + 512; LAS float* gsv = (LAS float*)(ent + 512); LAS float* sus = gsv + 512; LAS float* aw = sus + 512;
    const int vw0 = ((int)(blockIdx.x & 7) * (F.G >> 3) + (int)(blockIdx.x >> 3)) * NWAVES + Ls.wave;
    for (int v = (F.G & 7) ? Ls.gw : vw0; v < T / 4; v += F.NGW) {
        unsigned zz = 0u; asm volatile("" : "+s"(zz));
        int lane = (int)__builtin_amdgcn_mbcnt_hi(~0u, __builtin_amdgcn_mbcnt_lo(~0u, zz)); asm volatile("" : "+v"(lane));
        const int sg = lane >> 4, gl = lane & 15, tok = 4 * v + sg;
        LAS unsigned* keyg = key + sg * 128; LAS unsigned* entg = ent + sg * 128; LAS float* gsvg = gsv + sg * 128; LAS float* susg = sus + sg * 128; LAS float* awg = aw + sg * 128;
        { unsigned mk[8]; float mg[8];
#pragma unroll
          for (int q = 0; q < 8; ++q) { const int j = gl + 16 * q; const int e = tki[(size_t)tok * 128 + j]; mg[q] = tkg[(size_t)tok * 128 + j]; mk[q] = ((unsigned)e << 7) | (unsigned)j; keyg[j] = mk[q]; }
          asm volatile("s_waitcnt lgkmcnt(0)" ::: "memory");
          int rk[8];
#pragma unroll
          for (int q = 0; q < 8; ++q) rk[q] = 0;
#pragma unroll 4
          for (int jj = 0; jj < 32; ++jj) { const v4u kk = *(const LAS v4u*)(keyg + 4 * jj);
#pragma unroll
              for (int c = 0; c < 4; ++c)
#pragma unroll
                  for (int q = 0; q < 8; ++q) rk[q] += (kk[c] < mk[q]) ? 1 : 0; }
#pragma unroll
          for (int q = 0; q < 8; ++q) { const int e = (int)(mk[q] >> 7); const f32x2 sc = *(const f32x2*)(esc + 2 * e); entg[rk[q]] = (unsigned)e; gsvg[rk[q]] = mg[q] * sc.y; susg[rk[q]] = sc.x; }
          asm volatile("s_waitcnt lgkmcnt(0)" ::: "memory"); }
        float rstd;
        { float ps = part[(size_t)tok * 32 + gl] + part[(size_t)tok * 32 + 16 + gl];
          ps += xor_lane<1>(ps); ps += xor_lane<2>(ps); ps += xor_lane<4>(ps); ps += xor_lane<8>(ps);
          rstd = rsqrtf(ps * (1.f / DM) + EPS); }
#pragma unroll
        for (int pt = 0; pt < P8_NP; ++pt) {
            unsigned hv[P8_ST / 2];
            { int tok2 = tok, gl2 = gl; asm volatile("" : "+v"(tok2), "+v"(gl2)); const bf16* xr = X1b + (size_t)tok2 * DM + 128 * pt + 8 * gl2; const float* gp = F.g_ffn + 128 * pt + 8 * gl2;
#pragma unroll
              for (int j = 0; j < 8; ++j) { const v4u a = *(const v4u*)(xr + 256 * j); const f32x4 g0 = *(const f32x4*)(gp + 256 * j), g1 = *(const f32x4*)(gp + 256 * j + 4);
                  hv[2 * j + 0] = cvtpk(bflo(a[0]) * rstd * g0[0], bfhi(a[0]) * rstd * g0[1]); hv[2 * j + 1] = cvtpk(bflo(a[1]) * rstd * g0[2], bfhi(a[1]) * rstd * g0[3]);
                  hv[16 + 2 * j + 0] = cvtpk(bflo(a[2]) * rstd * g1[0], bfhi(a[2]) * rstd * g1[1]); hv[16 + 2 * j + 1] = cvtpk(bflo(a[3]) * rstd * g1[2], bfhi(a[3]) * rstd * g1[3]);
                  if (j == 3) { PIN8X2(hv, 0); PIN8X2(hv, 16); } if (j == 7) { PIN8X2(hv, 8); PIN8X2(hv, 24); } } }
            sweep_u<P8_DU>(U8, entg, awg, gl, pt, hv);
            asm volatile("s_waitcnt lgkmcnt(0)" ::: "memory");
        }
#pragma unroll
        for (int q = 0; q < 8; ++q) { const int j = gl + 16 * q; const float x = (awg[j] + awg[512 + j]) * susg[j]; awg[j] = gsvg[j] * gelu_erf(x); }
        asm volatile("s_waitcnt lgkmcnt(0)" ::: "memory");
        float s2 = 0.f;
#pragma unroll
        for (int pt = 0; pt < P8_NP; ++pt) {
            f32x2 po[P8_ST / 2];
#pragma unroll
            for (int q = 0; q < P8_ST / 2; ++q) po[q] = (f32x2){0.f, 0.f};
            sweep_v<P8_DV>(V8, entg, awg, gl, pt, po);
            { int tok2 = tok, gl2 = gl; asm volatile("" : "+v"(tok2), "+v"(gl2)); bf16* xb = X1b + (size_t)tok2 * DM + 128 * pt + 8 * gl2;
              v4u a[8];
#pragma unroll
              for (int j = 0; j < 8; ++j) a[j] = *(const v4u*)(xb + 256 * j);
#pragma unroll
              for (int j = 0; j < 8; ++j) { v4u o4;
#pragma unroll
                  for (int g = 0; g < 2; ++g) { const unsigned w0 = a[j][2 * g], w1 = a[j][2 * g + 1]; f32x4 o;
                      o[0] = bflo(w0) + po[16 * g + 2 * j][0]; o[1] = bfhi(w0) + po[16 * g + 2 * j][1]; o[2] = bflo(w1) + po[16 * g + 2 * j + 1][0]; o[3] = bfhi(w1) + po[16 * g + 2 * j + 1][1];
#pragma unroll
                      for (int e = 0; e < 4; ++e) s2 = fmaf(o[e], o[e], s2);
                      o4[2 * g] = cvtpk(o[0], o[1]); o4[2 * g + 1] = cvtpk(o[2], o[3]); }
                  *(v4u*)(xb + 256 * j) = o4; }
              asm volatile("" : "+v"(s2) :: "memory"); }
        }
        { s2 += xor_lane<1>(s2); s2 += xor_lane<2>(s2); s2 += xor_lane<4>(s2); s2 += xor_lane<8>(s2);
          {
          const float r2 = rsqrtf(s2 * (1.f / DM) + EPS);
          int tok2 = tok, gl2 = gl; asm volatile("" : "+v"(tok2), "+v"(gl2)); float* xr = F.out + (size_t)tok2 * DM + 4 * gl2; const float* gf = F.g_fin + 4 * gl2; const bf16* xb = X1b + (size_t)tok2 * DM + 4 * gl2;
          asm volatile("s_waitcnt vmcnt(0)" ::: "memory");
#pragma unroll
          for (int i0 = 0; i0 < 32; i0 += 8) { v2u a[8];
#pragma unroll
              for (int u = 0; u < 8; ++u) a[u] = *(const v2u*)(xb + 64 * (i0 + u));
#pragma unroll
              for (int u = 0; u < 8; ++u) { const f32x4 g = *(const f32x4*)(gf + 64 * (i0 + u)); const f32x4 v = {bflo(a[u][0]), bfhi(a[u][0]), bflo(a[u][1]), bfhi(a[u][1])};
                  *(f32x4*)(xr + 64 * (i0 + u)) = v * r2 * g; }
              asm volatile("" ::: "memory"); } } }
    }
}

constexpr int N_PHASES = 9;
struct Args { const float* in[14]; float* out; unsigned char* ws; int ph_lo, ph_hi; };
__global__ void __launch_bounds__(NWAVES * 64, 2) fwd_kernel(Args args) {
    extern __shared__ __attribute__((aligned(16))) unsigned char lds[];
    Frame F;
    F.lds = (LAS unsigned char*)lds; F.ldsg = (char*)lds;
    F.G = gridDim.x; F.NGW = F.G * NWAVES;
    F.x = args.in[0]; F.rel_bias = args.in[1]; F.g_mix = args.in[2]; F.w_in = args.in[3]; F.sink_a = args.in[4]; F.w_oa = args.in[5]; F.w_ob = args.in[6]; F.w_out = args.in[7];
    F.g_ffn = args.in[8]; F.w_pq = args.in[9]; F.keys = args.in[10]; F.eu = args.in[11]; F.ev = args.in[12]; F.g_fin = args.in[13];
    F.out = args.out; F.ws = args.ws;
    volatile LAS unsigned* MISC = (volatile LAS unsigned*)(F.lds + MISC_OFF);
    for (int u = threadIdx.x; u < (LDS_BYTES - LDSCTL_OFF) / 4; u += NWAVES * 64) ((LAS unsigned*)(F.lds + LDSCTL_OFF))[u] = 0u;
    __syncthreads();
    const int lo = args.ph_lo, hi = args.ph_hi;
    const bool multi = !MK_SPLIT || (hi - lo) > 1;
    XcdBarrier bar; bar.bar = (unsigned*)(F.ws + WS_CTL) + CW_BAR; bar.x = 0; bar.st = nullptr;
    if (multi) bar = xcd_barrier_post((unsigned*)(F.ws + WS_CTL) + CW_BAR, MISC + 8);
#ifndef PH_OFF
#define PH_OFF 0
#endif
#if MK_SPLIT
#define IN(k) (lo <= (k) && (k) < hi && !((PH_OFF >> (k)) & 1))
#else
#define IN(k) (!((PH_OFF >> (k)) & 1))
#endif
#define GRID_BAR() do { XcdBarrier b_ = bar; asm volatile("" : "+s"(b_.bar)); xcd_barrier(b_); } while (0)
#define SEAM(k) do { if (IN(k) && IN((k) + 1)) GRID_BAR(); } while (0)
#ifndef PH_REP
#define PH_REP 0
#endif
#define NREP(k) (IN(k) ? 1 + ((PH_REP >> (k)) & 1) : 0)
#define REPEAT(k) _Pragma("unroll") for (int r_ = 0; r_ < NREP(k); ++r_)
#define REBAR() do { if (r_) GRID_BAR(); } while (0)
    bf16* WinT = (bf16*)(F.ws + WS_WIN); bf16* WoaT = (bf16*)(F.ws + WS_WOA); bf16* WobT = (bf16*)(F.ws + WS_WOB); bf16* WoutT = (bf16*)(F.ws + WS_WOUT); bf16* W2T = (bf16*)(F.ws + WS_W2);
    bf16* proj = (bf16*)(F.ws + WS_PROJ); bf16* Hb = (bf16*)(F.ws + WS_H); bf16* mrg = (bf16*)(F.ws + WS_MRG);
    bf16* attA = (bf16*)(F.ws + WS_ATTA); bf16* attB = (bf16*)(F.ws + WS_ATTB); bf16* x1b = (bf16*)(F.ws + WS_X1B);
    float* part = (float*)(F.ws + WS_PART); float* scores = (float*)(F.ws + WS_SC);

    REPEAT(0) { REBAR(); p0_prologue(F); } SEAM(0);
    REPEAT(1) { REBAR();
        pg8::Gemm g{Hb, WinT, T, INW, DM / 2}; pg8::StaticOrder S; S.init(T, INW, F.G, (int)blockIdx.x);
        pg8::EpiProj E{proj, T, C_GA / 256, 1.f / W_SCALE};
        pg8::gemm_phase<pg8::EpiProj, pg8::StaticOrder, true, true, true>(F.lds + RING_OFF, g, S, E);
    } SEAM(1);
    REPEAT(2) { REBAR(); p2_attention(F); } SEAM(2);
    for (int r34 = 0; r34 < 1 + ((PH_REP >> 3) & 1); ++r34) {
    if (r34) GRID_BAR();
    if (IN(3)) {
        p3_combine(F);
        pg8::Gemm g{attA, WoaT, T, DM, AQW / 2}; pg8::StaticOrder S; S.init(T, DM, F.G, (int)blockIdx.x);
        pg8::EpiGate<false> E{proj + (size_t)(C_GA / 128) * T * 128, T, mrg, DM, 1.f / (A_SCALE * W_SCALE)};
        pg8::gemm_phase<pg8::EpiGate<false>, pg8::StaticOrder, false, true, true>(F.lds + RING_OFF, g, S, E);
    } SEAM(3);
    if (IN(4)) {
        pg8::Gemm g{attB, WobT, T, DM, BOW / 2}; pg8::StaticOrder S; S.init(T, DM, F.G, (int)blockIdx.x);
        pg8::EpiGateF8 E{proj + (size_t)(C_GB / 128) * T * 128, T, mrg, DM, F.ws + WS_MRG8, DM, M_SCALE, 1.f / (A_SCALE * W_SCALE)};
        pg8::gemm_phase<pg8::EpiGateF8, pg8::StaticOrder, false, true, true>(F.lds + RING_OFF, g, S, E);
    }
    }
    SEAM(4);
    REPEAT(5) { REBAR();
        pg8::Gemm g{(const bf16*)(F.ws + WS_MRG8), WoutT, T, DM, DM / 2}; pg8::StaticOrder S; S.init(T, DM, F.G, (int)blockIdx.x);
        pg8::EpiResid E{F.x, x1b, part, DM, 1.f / (M_SCALE * W_SCALE)};
        pg8::gemm_phase<pg8::EpiResid, pg8::StaticOrder, false, true, true>(F.lds + RING_OFF, g, S, E);
    } SEAM(5);
    const bool tab_first = ((blockIdx.x >> 3) & 1) == 0;
    if (IN(6) && tab_first) p6_tables(F);
    REPEAT(6) { REBAR();
        pg8::Gemm g{x1b, W2T, T, DM, DM}; pg8::StaticOrder S; S.init(T, DM, F.G, (int)blockIdx.x);
        LAS float* rs = (LAS float*)(F.lds + RSTD_OFF);
        const Lane Ls = lane_state();
        pg8::Unit u0; if (S.next(0, u0) && Ls.tid < 256) { const f32x4* pp = (const f32x4*)(part + (size_t)(u0.pm * 256 + Ls.tid) * 32); float s = 0.f;
#pragma unroll
            for (int i = 0; i < 8; ++i) { const f32x4 v = pp[i]; s += (v[0] + v[1]) + (v[2] + v[3]); }
            rs[Ls.tid] = rsqrtf(s * (1.f / DM) + EPS); }
        __syncthreads();
        pg8::EpiTopk E{rs, (int*)(F.ws + WS_TKI), (float*)(F.ws + WS_TKG), PHEADS, scores, DM};
        pg8::gemm_phase<pg8::EpiTopk, pg8::StaticOrder, false, true>(F.lds + RING_OFF, g, S, E);
    }
    if (IN(6) && !tab_first) p6_tables(F);
    if (IN(6) && IN(8)) GRID_BAR();
    if (IN(8)) { p8_expert(F, bar); }
#undef IN
#undef SEAM
}

extern "C" void kernel_launch(void* const* d_in, const int* in_sizes, int n_in, void* d_out, int out_size, void* d_ws, size_t ws_size, hipStream_t stream) {
    static int grid = 0;
    if (grid == 0) {
        if (n_in != 14 || in_sizes[0] != T * DM || out_size != T * DM || ws_size < WS_END) {
            fprintf(stderr, "kernel_launch: unexpected shapes: n_in %d in0 %d out %d ws %zu (need >= %zu); nothing launched\n", n_in, n_in > 0 ? in_sizes[0] : -1, out_size, ws_size, (size_t)WS_END); grid = -1; return; }
        int dev = 0, cus = 0, per_cu = 0;
        if (hipGetDevice(&dev) != hipSuccess || hipDeviceGetAttribute(&cus, hipDeviceAttributeMultiprocessorCount, dev) != hipSuccess) { grid = -1; return; }
        if (hipFuncSetAttribute((const void*)fwd_kernel, hipFuncAttributeMaxDynamicSharedMemorySize, LDS_BYTES) != hipSuccess) { fprintf(stderr, "kernel_launch: hipFuncSetAttribute failed\n"); grid = -1; return; }
        if (hipOccupancyMaxActiveBlocksPerMultiprocessor(&per_cu, (const void*)fwd_kernel, NWAVES * 64, LDS_BYTES) != hipSuccess || per_cu < 1)
            fprintf(stderr, "kernel_launch: note: occupancy query reports %d workgroups per CU\n", per_cu);
        (void)hipGetLastError();
        grid = cus;
        if (grid != 256) fprintf(stderr, "kernel_launch: note: %d CUs (built for 256)\n", grid);
    }
    if (grid < 0) return;
    (void)hipMemsetAsync((char*)d_ws + WS_CTL, 0, CTL_ZERO_BYTES, stream);
    Args a{};
    for (int i = 0; i < 14; ++i) a.in[i] = (const float*)d_in[i];
    a.out = (float*)d_out; a.ws = (unsigned char*)d_ws;
#if MK_SPLIT
    for (int p = 0; p < N_PHASES; ++p) { a.ph_lo = p; a.ph_hi = p + 1; hipLaunchKernelGGL(fwd_kernel, dim3(grid), dim3(NWAVES * 64), LDS_BYTES, stream, a); }
#else
    a.ph_lo = 0; a.ph_hi = N_PHASES; hipLaunchKernelGGL(fwd_kernel, dim3(grid), dim3(NWAVES * 64), LDS_BYTES, stream, a);
#endif
    const hipError_t le = hipPeekAtLastError();
    if (le != hipSuccess) fprintf(stderr, "kernel_launch: launch failed: %s\n", hipGetErrorName(le));
}
```
